# Optimizing an MI355X kernel written in HIP

```python
import jax, jax.numpy as jnp
from jax import lax
import numpy as np

D_MODEL = 1024
BATCH = 16
SEQ = 4096
DEPTH = 2

GRID_W = 64
CTX_LEN = 256
N_MIXERS = 2
N_NA_LAYERS = (DEPTH + 1) // 2
N_HG_LAYERS = DEPTH // 2
BRANCH = D_MODEL
NA_HEADS = 16
NA_HEAD_DIM = BRANCH // NA_HEADS
NA_WIN_H = 8
NA_WIN_W = 16
NA_QCOL_BLOCK = 16
NA_BAND_W = NA_QCOL_BLOCK + NA_WIN_W - 1
HG_HEADS = 8
HG_HEAD_DIM = BRANCH // HG_HEADS
HG_CHUNK = 64
EPS = 1e-6

kernel_name = "hybrid_natten_hgrn2_diffusion_block"


def rms_norm(x, w):
    xf = x.astype(jnp.float32)
    y = xf * lax.rsqrt(jnp.mean(xf * xf, axis=-1, keepdims=True) + EPS)
    return (y * w.astype(jnp.float32)).astype(x.dtype)


def adaln_params(cond, w, b):
    m = jax.nn.silu(cond) @ w + b
    return jnp.split(m, 3, axis=-1)


def modulate(x, norm_w, shift, scale):
    return rms_norm(x, norm_w) * (1 + scale) + shift


def split_heads(t, n_heads):
    return t.reshape(t.shape[:-1] + (n_heads, t.shape[-1] // n_heads))


def _na_column_tables():
    cols = np.arange(GRID_W)
    col_start = np.clip(cols - NA_WIN_W // 2, 0, GRID_W - NA_WIN_W)
    n_cb = GRID_W // NA_QCOL_BLOCK
    band_start = np.minimum(col_start[np.arange(n_cb) * NA_QCOL_BLOCK], GRID_W - NA_BAND_W)
    band_cols = band_start[:, None] + np.arange(NA_BAND_W)[None, :]
    q_cols = cols.reshape(n_cb, NA_QCOL_BLOCK)
    q_start = col_start.reshape(n_cb, NA_QCOL_BLOCK)
    kcol = band_cols[:, None, :]
    in_window = (kcol >= q_start[..., None]) & (kcol < q_start[..., None] + NA_WIN_W)
    dc_index = np.clip(kcol - q_cols[..., None] + NA_WIN_W - 1, 0, 2 * NA_WIN_W - 2)
    return band_cols, in_window, dc_index


def na_attend(q, k, v, k_ctx, v_ctx, rpb):
    B, L, H, dh = q.shape
    rows = L // GRID_W
    kh = min(NA_WIN_H, rows)
    n_cb = GRID_W // NA_QCOL_BLOCK
    band_cols, in_window, dc_index = _na_column_tables()
    col_mask = jnp.asarray(in_window)[:, :, None, :]
    dc_idx = jnp.asarray(dc_index)[:, :, None, :]
    scale = dh ** -0.5
    qg = q.reshape(B, rows, n_cb, NA_QCOL_BLOCK, H, dh)
    kg = k.reshape(B, rows, GRID_W, H, dh)
    vg = v.reshape(B, rows, GRID_W, H, dh)
    n_loc = kh * NA_BAND_W

    def one_row(r):
        r0 = jnp.clip(r - kh // 2, 0, rows - kh)
        q_r = lax.dynamic_index_in_dim(qg, r, axis=1, keepdims=False)
        k_band = lax.dynamic_slice_in_dim(kg, r0, kh, axis=1)[:, :, band_cols]
        v_band = lax.dynamic_slice_in_dim(vg, r0, kh, axis=1)[:, :, band_cols]
        s_loc = jnp.einsum('bjqhd,bkjwhd->bhjqkw', q_r, k_band).astype(jnp.float32) * scale
        dr_idx = (r0 + jnp.arange(kh) - r + (NA_WIN_H - 1))[None, None, :, None]
        bias = rpb[:, dr_idx, dc_idx].astype(jnp.float32)
        s_loc = jnp.where(col_mask, s_loc + bias[None], -jnp.inf)
        s_loc = s_loc.reshape(B, H, n_cb, NA_QCOL_BLOCK, n_loc)
        s_ctx = jnp.einsum('bjqhd,bmhd->bhjqm', q_r, k_ctx).astype(jnp.float32) * scale
        p = jax.nn.softmax(jnp.concatenate([s_loc, s_ctx], axis=-1), axis=-1).astype(v.dtype)
        p_loc = p[..., :n_loc].reshape(B, H, n_cb, NA_QCOL_BLOCK, kh, NA_BAND_W)
        o = (jnp.einsum('bhjqkw,bkjwhd->bjqhd', p_loc, v_band)
             + jnp.einsum('bhjqm,bmhd->bjqhd', p[..., n_loc:], v_ctx))
        return o.reshape(B, GRID_W, H, dh)

    o = lax.map(one_row, jnp.arange(rows))
    return jnp.moveaxis(o, 0, 1).reshape(B, L, H, dh)


def dense_attention(q, k, v):
    s = jnp.einsum('bqhd,bkhd->bhqk', q, k).astype(jnp.float32) * (q.shape[-1] ** -0.5)
    p = jax.nn.softmax(s, axis=-1).astype(v.dtype)
    return jnp.einsum('bhqk,bkhd->bqhd', p, v)


def na_layer(x, xc, mod, mod_c, norm_w, w_in, rpb, w_out, need_ctx):
    shift, scale, gate = mod
    shift_c, scale_c, gate_c = mod_c
    B, L, _ = x.shape
    h = modulate(x, norm_w, shift, scale)
    q, k, v, z = jnp.split(h @ w_in, 4, axis=-1)
    hc = modulate(xc, norm_w, shift_c, scale_c)
    if need_ctx:
        qc, kc, vc, zc = jnp.split(hc @ w_in, 4, axis=-1)
    else:
        kc, vc = jnp.split(hc @ w_in[:, BRANCH:3 * BRANCH], 2, axis=-1)
    kc_h, vc_h = split_heads(kc, NA_HEADS), split_heads(vc, NA_HEADS)
    o = na_attend(split_heads(q, NA_HEADS), split_heads(k, NA_HEADS), split_heads(v, NA_HEADS), kc_h, vc_h, rpb)
    o = o.reshape(B, L, BRANCH) * jax.nn.silu(z)
    x = x + gate * (o @ w_out)
    if need_ctx:
        oc = dense_attention(split_heads(qc, NA_HEADS), kc_h, vc_h).reshape(xc.shape[:2] + (BRANCH,))
        xc = xc + gate_c * ((oc * jax.nn.silu(zc)) @ w_out)
    return x, xc


def hg_heads(t):
    return jnp.swapaxes(split_heads(t, HG_HEADS), 1, 2)


def hgrn_query(t):
    return hg_heads(jax.nn.silu(t.astype(jnp.float32)) * (HG_HEAD_DIM ** -0.5))


def hgrn_decay(raw, lb):
    raw = raw.astype(jnp.float32)
    log_f = jnp.logaddexp(jnp.log(lb), jnp.log1p(-lb) + jax.nn.log_sigmoid(raw))
    k = (1 - lb) * jax.nn.sigmoid(-raw)
    return hg_heads(log_f), hg_heads(k)


def hgrn_chunk_scan(q, k, v, log_f, s0):
    B, H, T, _ = q.shape
    n = T // HG_CHUNK
    causal = jnp.tril(jnp.ones((HG_CHUNK, HG_CHUNK), dtype=bool))[:, :, None]

    def to_chunks(a):
        return jnp.moveaxis(a.reshape(B, H, n, HG_CHUNK, a.shape[-1]), 2, 0)

    def step(S, inp):
        qc, kc, vc, ac = inp
        A = jnp.cumsum(ac, axis=2)
        o_inter = jnp.einsum('bhtk,bhkv->bhtv', qc * jnp.exp(A), S)
        rel = jnp.where(causal, A[:, :, :, None, :] - A[:, :, None, :, :], -jnp.inf)
        scores = jnp.einsum('bhtk,bhsk,bhtsk->bhts', qc, kc, jnp.exp(rel))
        o_intra = jnp.einsum('bhts,bhsv->bhtv', scores, vc)
        A_last = A[:, :, -1:, :]
        S_new = (jnp.exp(A_last[:, :, 0, :])[..., None] * S
                 + jnp.einsum('bhsk,bhsv->bhkv', kc * jnp.exp(A_last - A), vc))
        return S_new, o_inter + o_intra

    S_fin, o = lax.scan(step, s0, (to_chunks(q), to_chunks(k), to_chunks(v), to_chunks(log_f)))
    return jnp.moveaxis(o, 0, 2).reshape(B, H, T, v.shape[-1]), S_fin


def hgrn_final_state(k, v, log_f):
    A = jnp.cumsum(log_f, axis=2)
    return jnp.einsum('bhsk,bhsv->bhkv', k * jnp.exp(A[:, :, -1:, :] - A), v)


def hgrn_direction(q, q_c, v, v_c, raw_lat, raw_ctx, lb, reverse):
    log_f, k = hgrn_decay(raw_lat, lb)
    log_fc, k_c = hgrn_decay(raw_ctx, lb)
    order = (lambda t: jnp.flip(t, axis=2)) if reverse else (lambda t: t)
    if q_c is not None:
        s0 = jnp.zeros(k_c.shape[:2] + (HG_HEAD_DIM, HG_HEAD_DIM), jnp.float32)
        o_c, s_ctx = hgrn_chunk_scan(order(q_c), order(k_c), order(v_c), order(log_fc), s0)
        o_c = order(o_c)
    else:
        o_c = None
        s_ctx = hgrn_final_state(order(k_c), order(v_c), order(log_fc))
    o, _ = hgrn_chunk_scan(order(q), order(k), order(v), order(log_f), s_ctx)
    return order(o), o_c


def hgrn_readout(o, g, head_norm_w, w_out):
    o = rms_norm(jnp.swapaxes(o, 1, 2), head_norm_w)
    o = o.reshape(o.shape[:2] + (BRANCH,)).astype(g.dtype) * jax.nn.silu(g)
    return o @ w_out


def hgrn_layer(x, xc, mod, mod_c, norm_w, w_in, lb, head_norm_w, w_out, need_ctx):
    shift, scale, gate = mod
    shift_c, scale_c, gate_c = mod_c
    h = modulate(x, norm_w, shift, scale)
    q, i_lat, f_fwd, f_bwd, g = jnp.split(h @ w_in, 5, axis=-1)
    hc = modulate(xc, norm_w, shift_c, scale_c)
    if need_ctx:
        qc, i_ctx, fc_fwd, fc_bwd, gc = jnp.split(hc @ w_in, 5, axis=-1)
        q_c = hgrn_query(qc)
    else:
        i_ctx, fc_fwd, fc_bwd = jnp.split(hc @ w_in[:, BRANCH:4 * BRANCH], 3, axis=-1)
        q_c = None
    q_h = hgrn_query(q)
    v_h = hg_heads(i_lat.astype(jnp.float32))
    v_c = hg_heads(i_ctx.astype(jnp.float32))
    o_f, oc_f = hgrn_direction(q_h, q_c, v_h, v_c, f_fwd, fc_fwd, lb, False)
    o_b, oc_b = hgrn_direction(q_h, q_c, v_h, v_c, f_bwd, fc_bwd, lb, True)
    x = x + gate * hgrn_readout(o_f + o_b, g, head_norm_w, w_out)
    if need_ctx:
        xc = xc + gate_c * hgrn_readout(oc_f + oc_b, gc, head_norm_w, w_out)
    return x, xc


def setup_inputs(seed: int = 0) -> dict:
    key = jax.random.key(seed)
    ks = jax.random.split(key, 15)
    D, E = D_MODEL, BRANCH
    nrm = jax.random.normal
    return {
        "x": nrm(ks[0], (BATCH, SEQ, D), jnp.float32),
        "c": nrm(ks[1], (BATCH, D), jnp.float32),
        "ctx": nrm(ks[2], (BATCH, CTX_LEN, D), jnp.float32),
        "c_ctx": nrm(ks[3], (D,), jnp.float32),
        "ada_w": nrm(ks[4], (DEPTH, D, 3 * D), jnp.float32) * (0.5 * D ** -0.5),
        "ada_b": nrm(ks[5], (DEPTH, 3 * D), jnp.float32) * 0.02,
        "norm_w": 1.0 + 0.02 * nrm(ks[6], (DEPTH, D), jnp.float32),
        "na_w_in": nrm(ks[7], (N_NA_LAYERS, D, 4 * E), jnp.float32) * D ** -0.5,
        "na_rpb": nrm(ks[8], (N_NA_LAYERS, NA_HEADS, 2 * NA_WIN_H - 1, 2 * NA_WIN_W - 1), jnp.float32) * 0.5,
        "na_w_out": nrm(ks[9], (N_NA_LAYERS, E, D), jnp.float32) * E ** -0.5,
        "hg_w_in": nrm(ks[10], (N_HG_LAYERS, D, 5 * E), jnp.float32) * D ** -0.5,
        "hg_lower": nrm(ks[11], (DEPTH, E), jnp.float32) * 0.5,
        "hg_norm_w": 1.0 + 0.02 * nrm(ks[12], (N_HG_LAYERS, HG_HEAD_DIM), jnp.float32),
        "hg_w_out": nrm(ks[13], (N_HG_LAYERS, E, D), jnp.float32) * E ** -0.5,
        "final_norm_w": 1.0 + 0.02 * nrm(ks[14], (D,), jnp.float32),
    }


def reference(x, c, ctx, c_ctx, ada_w, ada_b, norm_w, na_w_in, na_rpb, na_w_out,
              hg_w_in, hg_lower, hg_norm_w, hg_w_out, final_norm_w):
    lb_all = jnp.cumsum(jax.nn.softmax(hg_lower.astype(jnp.float32), axis=0), axis=0)
    lb_all = lb_all - lb_all[0:1]
    xc = ctx
    for i in range(DEPTH):
        shift, scale, gate = adaln_params(c, ada_w[i], ada_b[i])
        mod = (shift[:, None, :], scale[:, None, :], gate[:, None, :])
        shift_c, scale_c, gate_c = adaln_params(c_ctx, ada_w[i], ada_b[i])
        mod_c = (shift_c, scale_c, gate_c)
        need_ctx = i < DEPTH - 1
        j = i // N_MIXERS
        if i % N_MIXERS == 0:
            x, xc = na_layer(x, xc, mod, mod_c, norm_w[i], na_w_in[j], na_rpb[j], na_w_out[j], need_ctx)
        else:
            x, xc = hgrn_layer(x, xc, mod, mod_c, norm_w[i], hg_w_in[j], lb_all[i], hg_norm_w[j], hg_w_out[j], need_ctx)
    return rms_norm(x, final_norm_w)
```

```cpp
#include <hip/hip_runtime.h>
#include <hip/hip_cooperative_groups.h>
#include <cstdio>
#include <cstdint>
namespace cg = cooperative_groups;

typedef unsigned short bf16_t;
typedef float f32x4 __attribute__((ext_vector_type(4)));
typedef unsigned u32x4 __attribute__((ext_vector_type(4)));
typedef unsigned u32x2 __attribute__((ext_vector_type(2)));

constexpr int D = 1024, NB = 16, SEQ = 4096, CTX = 256;
constexpr int NLAT = NB * SEQ;
constexpr int NCTX = NB * CTX;
constexpr int MTOT = NLAT + NCTX;
constexpr int N0 = 4096, N1 = 5120;
constexpr float EPS = 1e-6f;
constexpr float LOG2E = 1.4426950408889634f;
constexpr float QSCALE0 = 0.125f * LOG2E;
constexpr float QSCALE1 = 0.08838834764831845f;
constexpr int NTHREADS = 512, NWAVES = 8;

constexpr size_t MiB = 1u << 20;
constexpr size_t WS_MOD = 1 * MiB;
constexpr size_t WS_LB = 1 * MiB + 512 * 1024;
constexpr size_t WS_W0T = 2 * MiB, WS_WO0T = 10 * MiB, WS_W1T = 12 * MiB, WS_WO1T = 22 * MiB;
constexpr size_t WS_X1 = 32 * MiB;
constexpr size_t WS_R1 = 304 * MiB;
constexpr size_t WS_END = 984 * MiB;
static_assert(WS_X1 + (size_t)MTOT * D * 4 <= WS_R1 && WS_R1 + (size_t)MTOT * N1 * 2 <= WS_END, "ws map");

constexpr int LDS_BYTES = 147456;

struct Params {
    const float *x, *c, *ctx, *c_ctx, *ada_w, *ada_b, *norm_w, *na_w_in, *na_rpb, *na_w_out, *hg_w_in, *hg_lower, *hg_norm_w, *hg_w_out, *final_norm_w;
    float* out; unsigned char* ws; int ph_lo, ph_hi;
};

__device__ __forceinline__ float bf2f(bf16_t v) { return __uint_as_float((unsigned)v << 16); }
__device__ __forceinline__ unsigned f2bf(float f) { unsigned u = __float_as_uint(f); return (u + 0x7fffu + ((u >> 16) & 1u)) >> 16; }
__device__ __forceinline__ unsigned pk2(float lo, float hi) { return f2bf(lo) | (f2bf(hi) << 16); }
__device__ __forceinline__ float h2f(unsigned short v) { return (float)__builtin_bit_cast(_Float16, v); }
__device__ __forceinline__ unsigned short f2h(float f) { return __builtin_bit_cast(unsigned short, (_Float16)f); }
__device__ __forceinline__ float siluf(float v) { return v / (1.f + __expf(-v)); }
__device__ __forceinline__ float wave_sum(float v) {
#pragma unroll
    for (int o = 1; o < 64; o <<= 1) v += __shfl_xor(v, o);
    return v;
}
__device__ __forceinline__ void unpack8(const u32x4 w, float* f) {
    f[0] = __uint_as_float(w.x << 16); f[1] = __uint_as_float(w.x & 0xffff0000u);
    f[2] = __uint_as_float(w.y << 16); f[3] = __uint_as_float(w.y & 0xffff0000u);
    f[4] = __uint_as_float(w.z << 16); f[5] = __uint_as_float(w.z & 0xffff0000u);
    f[6] = __uint_as_float(w.w << 16); f[7] = __uint_as_float(w.w & 0xffff0000u);
}

__device__ __forceinline__ void transpose_item(const float* W, int K, int N, bf16_t* WT, float* scr, int item, int lane) {
    const int nblk = N / 32, kb = item / nblk, nb = item % nblk, k0 = 64 * kb, n0 = 32 * nb;
#pragma unroll 8
    for (int i = 0; i < 32; ++i) { const int kk = 2 * i + (lane >> 5); scr[kk * 33 + (lane & 31)] = W[(size_t)(k0 + kk) * N + n0 + (lane & 31)]; }
    __builtin_amdgcn_wave_barrier();
    const int c = lane & 7;
#pragma unroll
    for (int j = 0; j < 4; ++j) { const int n = (lane >> 3) + 8 * j; const float* s = scr + (8 * c) * 33 + n;
        u32x4 o; o.x = pk2(s[0 * 33], s[1 * 33]); o.y = pk2(s[2 * 33], s[3 * 33]); o.z = pk2(s[4 * 33], s[5 * 33]); o.w = pk2(s[6 * 33], s[7 * 33]);
        *(u32x4*)(WT + (size_t)(n0 + n) * K + k0 + 8 * c) = o; }
    __builtin_amdgcn_wave_barrier();
}

__device__ __forceinline__ void phase_prologue(const Params& P, unsigned char* lds) {
    const int tid = threadIdx.x, lane = tid & 63, wave = tid >> 6;
    unsigned char* ws = P.ws;
    {
        float* scr = (float*)(lds) + wave * (64 * 33);
        const int gw = blockIdx.x * NWAVES + wave, NGW = gridDim.x * NWAVES;
        constexpr int I0 = (D / 64) * (N0 / 32), IO = (D / 64) * (D / 32), I1 = (D / 64) * (N1 / 32);
        constexpr int NIT = I0 + IO + I1 + IO;
        for (int it = gw; it < NIT; it += NGW) {
            int r = it;
            if (r < I0) { transpose_item(P.na_w_in, D, N0, (bf16_t*)(ws + WS_W0T), scr, r, lane); continue; } r -= I0;
            if (r < IO) { transpose_item(P.na_w_out, D, D, (bf16_t*)(ws + WS_WO0T), scr, r, lane); continue; } r -= IO;
            if (r < I1) { transpose_item(P.hg_w_in, D, N1, (bf16_t*)(ws + WS_W1T), scr, r, lane); continue; } r -= I1;
            transpose_item(P.hg_w_out, D, D, (bf16_t*)(ws + WS_WO1T), scr, r, lane);
        }
    }
    __syncthreads();
    {
        float* sc = (float*)lds;
        float* red = (float*)(lds + 17 * 1024 * 4);
        for (int e = tid; e < 17 * 1024; e += NTHREADS) { const int r = e >> 10, k = e & 1023; const float v = (r < 16) ? P.c[r * 1024 + k] : P.c_ctx[k]; sc[e] = siluf(v); }
        __syncthreads();
        float* mod = (float*)(ws + WS_MOD);
        for (int it = blockIdx.x; it < 2 * 48; it += gridDim.x) {
            const int l = it / 48, n0 = (it % 48) * 64;
            const float* W = P.ada_w + (size_t)l * 1024 * 3072 + n0 + lane;
            float acc[17];
#pragma unroll
            for (int r = 0; r < 17; ++r) acc[r] = 0.f;
            const int kb = wave * 128;
#pragma unroll 4
            for (int k = 0; k < 128; ++k) { const float w = W[(size_t)(kb + k) * 3072];
#pragma unroll
                for (int r = 0; r < 17; ++r) acc[r] += sc[r * 1024 + kb + k] * w; }
#pragma unroll
            for (int r = 0; r < 17; ++r) red[(wave * 17 + r) * 64 + lane] = acc[r];
            __syncthreads();
            for (int e = tid; e < 17 * 64; e += NTHREADS) { const int r = e >> 6, n = e & 63; float s = P.ada_b[l * 3072 + n0 + n];
#pragma unroll
                for (int w = 0; w < 8; ++w) s += red[(w * 17 + r) * 64 + n];
                mod[(size_t)(l * 17 + r) * 3072 + n0 + n] = s; }
            __syncthreads();
        }
    }
    if (blockIdx.x == gridDim.x - 1) {
        float* lb = (float*)(ws + WS_LB);
        for (int cidx = tid; cidx < 1024; cidx += NTHREADS) { const float l0 = P.hg_lower[cidx], l1 = P.hg_lower[1024 + cidx]; const float mx = fmaxf(l0, l1);
            const float e0 = __expf(l0 - mx), e1 = __expf(l1 - mx); const float p0 = e0 / (e0 + e1), p1 = e1 / (e0 + e1); lb[cidx] = (p0 + p1) - p0; }
    }
}

__device__ __forceinline__ void phase_modulate(const Params& P, int layer, const float* xlat, const float* xctx, bf16_t* H) {
    const int tid = threadIdx.x, lane = tid & 63, wave = tid >> 6;
    const int gw = blockIdx.x * NWAVES + wave, NGW = gridDim.x * NWAVES;
    const float* mod = (const float*)(P.ws + WS_MOD) + (size_t)layer * 17 * 3072;
    const float* nw = P.norm_w + layer * 1024;
    for (int row = gw; row < MTOT; row += NGW) {
        const float* src = (row < NLAT) ? xlat + (size_t)row * D : xctx + (size_t)(row - NLAT) * D;
        const int br = (row < NLAT) ? (row >> 12) : 16;
        const float* sh = mod + (size_t)br * 3072; const float* scl = sh + 1024;
        f32x4 v[4]; float ss = 0.f;
#pragma unroll
        for (int j = 0; j < 4; ++j) { v[j] = *(const f32x4*)(src + lane * 4 + 256 * j); ss += (v[j].x * v[j].x + v[j].y * v[j].y) + (v[j].z * v[j].z + v[j].w * v[j].w); }
        const float rstd = 1.f / sqrtf(wave_sum(ss) * (1.f / D) + EPS);
#pragma unroll
        for (int j = 0; j < 4; ++j) { const int c0 = lane * 4 + 256 * j; const f32x4 w = *(const f32x4*)(nw + c0), s1 = *(const f32x4*)(scl + c0), s0 = *(const f32x4*)(sh + c0);
            const f32x4 h = (v[j] * rstd) * w * (s1 + 1.f) + s0;
            u32x2 o; o.x = pk2(h.x, h.y); o.y = pk2(h.z, h.w); *(u32x2*)(H + (size_t)row * D + c0) = o; }
    }
}

template <int MODE> __device__ __forceinline__ void epi_elem(const Params& P, int row, int col, float acc) {
    unsigned char* ws = P.ws;
    if (MODE == 0) {
        bf16_t* O = (bf16_t*)(ws + WS_R1);
        O[(size_t)row * N0 + col] = (bf16_t)f2bf(col < 1024 ? acc * QSCALE0 : acc);
    } else if (MODE == 1) {
        float* X1 = (float*)(ws + WS_X1);
        const float* mod = (const float*)(ws + WS_MOD);
        const int br = (row < NLAT) ? (row >> 12) : 16;
        const float xin = (row < NLAT) ? P.x[(size_t)row * D + col] : P.ctx[(size_t)(row - NLAT) * D + col];
        X1[(size_t)row * D + col] = xin + mod[(size_t)br * 3072 + 2048 + col] * acc;
    } else if (MODE == 2) {
        bf16_t* O = (bf16_t*)(ws + WS_R1);
        const int grp = col >> 10;
        unsigned short o;
        if (grp == 0) o = (unsigned short)f2bf(siluf(acc) * QSCALE1);
        else if (grp == 2 || grp == 3) { const float lb = ((const float*)(ws + WS_LB))[col & 1023]; const float f = lb + (1.f - lb) / (1.f + __expf(-acc)); o = f2h(__log2f(f)); }
        else o = (unsigned short)f2bf(acc);
        O[(size_t)row * N1 + col] = o;
    } else {
        float* X1 = (float*)(ws + WS_X1);
        const float* mod = (const float*)(ws + WS_MOD) + (size_t)17 * 3072;
        const int br = row >> 12;
        X1[(size_t)row * D + col] += mod[(size_t)br * 3072 + 2048 + col] * acc;
    }
}

template <int MODE> __device__ __forceinline__ void gemm_naive(const Params& P, const bf16_t* A, const bf16_t* Bt, int M, int N, int K, unsigned char* lds) {
    float* As = (float*)lds;
    float* Bs = As + 32 * 132;
    const int tid = threadIdx.x, ty = tid >> 5, tx = tid & 31;
    const int nTn = N / 128, ntiles = (M / 128) * nTn;
    for (int t = blockIdx.x; t < ntiles; t += gridDim.x) {
        const int tm = t / nTn, tn = t % nTn;
        float acc[8][4];
#pragma unroll
        for (int i = 0; i < 8; ++i)
#pragma unroll
            for (int j = 0; j < 4; ++j) acc[i][j] = 0.f;
        for (int k0 = 0; k0 < K; k0 += 32) {
            {
                const int r = tid >> 2, kc = (tid & 3) * 8;
                float f[8];
                unpack8(*(const u32x4*)(A + (size_t)(tm * 128 + r) * K + k0 + kc), f);
#pragma unroll
                for (int i = 0; i < 8; ++i) As[(kc + i) * 132 + r] = f[i];
                unpack8(*(const u32x4*)(Bt + (size_t)(tn * 128 + r) * K + k0 + kc), f);
#pragma unroll
                for (int i = 0; i < 8; ++i) Bs[(kc + i) * 132 + r] = f[i];
            }
            __syncthreads();
#pragma unroll 8
            for (int k = 0; k < 32; ++k) {
                const f32x4 a0 = *(const f32x4*)(As + k * 132 + ty * 8), a1 = *(const f32x4*)(As + k * 132 + ty * 8 + 4), b = *(const f32x4*)(Bs + k * 132 + tx * 4);
                const float a[8] = {a0.x, a0.y, a0.z, a0.w, a1.x, a1.y, a1.z, a1.w}; const float bb[4] = {b.x, b.y, b.z, b.w};
#pragma unroll
                for (int i = 0; i < 8; ++i)
#pragma unroll
                    for (int j = 0; j < 4; ++j) acc[i][j] += a[i] * bb[j];
            }
            __syncthreads();
        }
#pragma unroll
        for (int i = 0; i < 8; ++i)
#pragma unroll
            for (int j = 0; j < 4; ++j) epi_elem<MODE>(P, tm * 128 + ty * 8 + i, tn * 128 + tx * 4 + j, acc[i][j]);
    }
}

__device__ __forceinline__ void phase_na_naive(const Params& P, unsigned char* lds, bf16_t* Y) {
    const int tid = threadIdx.x, lane = tid & 63, wave = tid >> 6;
    float* rpbL = (float*)lds;
    for (int e = tid; e < 16 * 15 * 31; e += NTHREADS) rpbL[e] = P.na_rpb[e] * LOG2E;
    __syncthreads();
    const bf16_t* R = (const bf16_t*)(P.ws + WS_R1);
    const int gw = blockIdx.x * NWAVES + wave, NGW = gridDim.x * NWAVES;
    for (int u = gw; u < 16384 + 1024; u += NGW) {
        int b, h, r = 0, qtok, nloc, r0 = 0, cs = 0;
        if (u < 16384) { r = u & 63; h = (u >> 6) & 15; b = u >> 10; qtok = b * SEQ + r * 64 + lane; nloc = 128;
            r0 = min(max(r - 4, 0), 56); cs = min(max(lane - 8, 0), 48); }
        else { const int v = u - 16384; const int qb = v & 3; h = (v >> 2) & 15; b = v >> 6; qtok = NLAT + b * CTX + qb * 64 + lane; nloc = 0; }
        float q[64], O[64];
        {
            const bf16_t* qp = R + (size_t)qtok * N0 + h * 64;
#pragma unroll
            for (int i = 0; i < 8; ++i) unpack8(*(const u32x4*)(qp + 8 * i), q + 8 * i);
        }
#pragma unroll
        for (int d = 0; d < 64; ++d) O[d] = 0.f;
        float m = -1e30f, l = 0.f;
        const int nk = nloc + CTX;
        for (int kk = 0; kk < nk; ++kk) {
            int ktok; float s;
            if (kk < nloc) { const int kr = kk >> 4, j = kk & 15; ktok = b * SEQ + (r0 + kr) * 64 + cs + j; s = rpbL[h * 465 + (r0 + kr - r + 7) * 31 + (cs + j - lane + 15)]; }
            else { ktok = NLAT + b * CTX + (kk - nloc); s = 0.f; }
            const bf16_t* kp = R + (size_t)ktok * N0 + 1024 + h * 64;
#pragma unroll
            for (int i = 0; i < 8; ++i) { float f[8]; unpack8(*(const u32x4*)(kp + 8 * i), f);
#pragma unroll
                for (int j2 = 0; j2 < 8; ++j2) s += q[8 * i + j2] * f[j2]; }
            const float mn = fmaxf(m, s), alpha = exp2f(m - mn), p = exp2f(s - mn);
            l = l * alpha + p; m = mn;
            const bf16_t* vp = kp + 1024;
#pragma unroll
            for (int i = 0; i < 8; ++i) { float f[8]; unpack8(*(const u32x4*)(vp + 8 * i), f);
#pragma unroll
                for (int j2 = 0; j2 < 8; ++j2) O[8 * i + j2] = O[8 * i + j2] * alpha + p * f[j2]; }
        }
        const float rl = 1.f / l;
        const bf16_t* zp = R + (size_t)qtok * N0 + 3072 + h * 64;
        bf16_t* yp = Y + (size_t)qtok * D + h * 64;
#pragma unroll
        for (int i = 0; i < 8; ++i) { float z[8]; unpack8(*(const u32x4*)(zp + 8 * i), z);
            u32x4 o;
            o.x = pk2(O[8 * i + 0] * rl * siluf(z[0]), O[8 * i + 1] * rl * siluf(z[1]));
            o.y = pk2(O[8 * i + 2] * rl * siluf(z[2]), O[8 * i + 3] * rl * siluf(z[3]));
            o.z = pk2(O[8 * i + 4] * rl * siluf(z[4]), O[8 * i + 5] * rl * siluf(z[5]));
            o.w = pk2(O[8 * i + 6] * rl * siluf(z[6]), O[8 * i + 7] * rl * siluf(z[7]));
            *(u32x4*)(yp + 8 * i) = o; }
    }
}

__device__ __forceinline__ void phase_hgrn_naive(const Params& P, unsigned char* lds, bf16_t* OF, bf16_t* OB) {
    const int tid = threadIdx.x, lane = tid & 63, wave = tid >> 6, l16 = lane & 15, q4 = lane >> 4;
    float* fT = (float*)lds;
    float* kT = fT + 32 * 128; float* qT = kT + 32 * 128; float* vT = qT + 32 * 128; float* oT = vT + 32 * 128;
    const unsigned short* R = (const unsigned short*)(P.ws + WS_R1);
    for (int it = blockIdx.x; it < 256; it += gridDim.x) {
        const int b = it >> 4, h = (it >> 1) & 7, dir = it & 1;
        bf16_t* Odst = dir ? OB : OF;
        float S[32];
#pragma unroll
        for (int i = 0; i < 32; ++i) S[i] = 0.f;
        for (int ci = 0; ci < 8 + 128; ++ci) {
            const bool is_ctx = ci < 8;
            const int len = is_ctx ? CTX : SEQ, sp0 = is_ctx ? ci * 32 : (ci - 8) * 32;
            const size_t rowbase = is_ctx ? (size_t)(NLAT + b * CTX) : (size_t)b * SEQ;
#pragma unroll
            for (int j = 0; j < 8; ++j) {
                const int e = tid + NTHREADS * j, p = e >> 7, c = e & 127;
                const int sp = sp0 + p, ti = dir ? (len - 1 - sp) : sp;
                const unsigned short* rp = R + (rowbase + ti) * N1 + h * 128 + c;
                const float lf2 = h2f(rp[(2 + dir) * 1024]);
                fT[e] = exp2f(lf2); kT[e] = -expm1f(lf2 * 0.6931471805599453f);
                vT[e] = bf2f(rp[1024]); qT[e] = is_ctx ? 0.f : bf2f(rp[0]);
            }
            __syncthreads();
            for (int t = 0; t < 32; ++t) {
                const float v = vT[t * 128 + wave * 16 + l16];
                float o = 0.f;
#pragma unroll
                for (int i4 = 0; i4 < 8; ++i4) {
                    const f32x4 f = *(const f32x4*)(fT + t * 128 + q4 * 32 + i4 * 4), k = *(const f32x4*)(kT + t * 128 + q4 * 32 + i4 * 4), qq = *(const f32x4*)(qT + t * 128 + q4 * 32 + i4 * 4);
                    S[i4 * 4 + 0] = f.x * S[i4 * 4 + 0] + k.x * v; o += S[i4 * 4 + 0] * qq.x;
                    S[i4 * 4 + 1] = f.y * S[i4 * 4 + 1] + k.y * v; o += S[i4 * 4 + 1] * qq.y;
                    S[i4 * 4 + 2] = f.z * S[i4 * 4 + 2] + k.z * v; o += S[i4 * 4 + 2] * qq.z;
                    S[i4 * 4 + 3] = f.w * S[i4 * 4 + 3] + k.w * v; o += S[i4 * 4 + 3] * qq.w;
                }
                o += __shfl_xor(o, 16); o += __shfl_xor(o, 32);
                if (q4 == 0) oT[t * 128 + wave * 16 + l16] = o;
            }
            __syncthreads();
            if (!is_ctx) {
#pragma unroll
                for (int j = 0; j < 8; ++j) {
                    const int e = tid + NTHREADS * j, p = e >> 7, c = e & 127;
                    const int sp = sp0 + p, ti = dir ? (len - 1 - sp) : sp;
                    Odst[(rowbase + ti) * D + h * 128 + c] = (bf16_t)f2bf(oT[e]);
                }
            }
        }
        __syncthreads();
    }
}

__device__ __forceinline__ void phase_readout(const Params& P, bf16_t* OF, const bf16_t* OB) {
    const int tid = threadIdx.x, lane = tid & 63, wave = tid >> 6;
    const int gw = blockIdx.x * NWAVES + wave, NGW = gridDim.x * NWAVES;
    const bf16_t* R = (const bf16_t*)(P.ws + WS_R1);
    float hw[16];
#pragma unroll
    for (int i = 0; i < 16; ++i) hw[i] = P.hg_norm_w[(lane * 16 + i) & 127];
    for (int row = gw; row < NLAT; row += NGW) {
        float o[16], g[16], t[8];
        unpack8(*(const u32x4*)(OF + (size_t)row * D + lane * 16), o); unpack8(*(const u32x4*)(OF + (size_t)row * D + lane * 16 + 8), o + 8);
        unpack8(*(const u32x4*)(OB + (size_t)row * D + lane * 16), t);
#pragma unroll
        for (int i = 0; i < 8; ++i) o[i] += t[i];
        unpack8(*(const u32x4*)(OB + (size_t)row * D + lane * 16 + 8), t);
#pragma unroll
        for (int i = 0; i < 8; ++i) o[8 + i] += t[i];
        unpack8(*(const u32x4*)(R + (size_t)row * N1 + 4096 + lane * 16), g); unpack8(*(const u32x4*)(R + (size_t)row * N1 + 4096 + lane * 16 + 8), g + 8);
        float ss = 0.f;
#pragma unroll
        for (int i = 0; i < 16; ++i) ss += o[i] * o[i];
        ss += __shfl_xor(ss, 1); ss += __shfl_xor(ss, 2); ss += __shfl_xor(ss, 4);
        const float rstd = 1.f / sqrtf(ss * (1.f / 128.f) + EPS);
        float y[16];
#pragma unroll
        for (int i = 0; i < 16; ++i) y[i] = o[i] * rstd * hw[i] * siluf(g[i]);
        u32x4 w0, w1;
        w0.x = pk2(y[0], y[1]); w0.y = pk2(y[2], y[3]); w0.z = pk2(y[4], y[5]); w0.w = pk2(y[6], y[7]);
        w1.x = pk2(y[8], y[9]); w1.y = pk2(y[10], y[11]); w1.z = pk2(y[12], y[13]); w1.w = pk2(y[14], y[15]);
        *(u32x4*)(OF + (size_t)row * D + lane * 16) = w0; *(u32x4*)(OF + (size_t)row * D + lane * 16 + 8) = w1;
    }
}

__device__ __forceinline__ void phase_final(const Params& P) {
    const int tid = threadIdx.x, lane = tid & 63, wave = tid >> 6;
    const int gw = blockIdx.x * NWAVES + wave, NGW = gridDim.x * NWAVES;
    const float* X1 = (const float*)(P.ws + WS_X1);
    for (int row = gw; row < NLAT; row += NGW) {
        f32x4 v[4]; float ss = 0.f;
#pragma unroll
        for (int j = 0; j < 4; ++j) { v[j] = *(const f32x4*)(X1 + (size_t)row * D + lane * 4 + 256 * j); ss += (v[j].x * v[j].x + v[j].y * v[j].y) + (v[j].z * v[j].z + v[j].w * v[j].w); }
        const float rstd = 1.f / sqrtf(wave_sum(ss) * (1.f / D) + EPS);
#pragma unroll
        for (int j = 0; j < 4; ++j) { const f32x4 w = *(const f32x4*)(P.final_norm_w + lane * 4 + 256 * j); *(f32x4*)(P.out + (size_t)row * D + lane * 4 + 256 * j) = (v[j] * rstd) * w; }
    }
}

constexpr int NPHASE = 11;
__global__ void __launch_bounds__(NTHREADS, 2) fwd_megakernel(Params P) {
    extern __shared__ __attribute__((aligned(16))) unsigned char lds[];
    cg::grid_group grid = cg::this_grid();
    unsigned char* ws = P.ws;
    bf16_t* H = (bf16_t*)P.out;
    bf16_t* OF = (bf16_t*)P.out;
    bf16_t* OB = (bf16_t*)P.out + (size_t)NLAT * D;
    float* X1 = (float*)(ws + WS_X1);
    const int lo = P.ph_lo, hi = P.ph_hi;
#define IN(k) (lo <= (k) && (k) < hi)
#define SEAM(k) do { if (IN(k) && IN((k) + 1)) grid.sync(); } while (0)
    if (IN(0)) phase_prologue(P, lds);
    SEAM(0);
    if (IN(1)) phase_modulate(P, 0, P.x, P.ctx, H);
    SEAM(1);
    if (IN(2)) gemm_naive<0>(P, H, (const bf16_t*)(ws + WS_W0T), MTOT, N0, D, lds);
    SEAM(2);
    if (IN(3)) phase_na_naive(P, lds, H);
    SEAM(3);
    if (IN(4)) gemm_naive<1>(P, H, (const bf16_t*)(ws + WS_WO0T), MTOT, D, D, lds);
    SEAM(4);
    if (IN(5)) phase_modulate(P, 1, X1, X1 + (size_t)NLAT * D, H);
    SEAM(5);
    if (IN(6)) gemm_naive<2>(P, H, (const bf16_t*)(ws + WS_W1T), MTOT, N1, D, lds);
    SEAM(6);
    if (IN(7)) phase_hgrn_naive(P, lds, OF, OB);
    SEAM(7);
    if (IN(8)) phase_readout(P, OF, OB);
    SEAM(8);
    if (IN(9)) gemm_naive<3>(P, OF, (const bf16_t*)(ws + WS_WO1T), NLAT, D, D, lds);
    SEAM(9);
    if (IN(10)) phase_final(P);
#undef IN
#undef SEAM
}

extern "C" void kernel_launch(void* const* d_in, const int* in_sizes, int n_in, void* d_out, int out_size, void* d_ws, size_t ws_size, hipStream_t stream) {
    static int grid = 0;
    if (grid == 0) {
        if (n_in != 15 || out_size != NLAT * D || ws_size < WS_END) { fprintf(stderr, "kernel_launch: unexpected sizes n_in %d out %d ws %zu\n", n_in, out_size, ws_size); grid = -1; return; }
        int dev = 0, cus = 0, per_cu = 0;
        (void)hipGetDevice(&dev);
        (void)hipDeviceGetAttribute(&cus, hipDeviceAttributeMultiprocessorCount, dev);
        (void)hipFuncSetAttribute((const void*)fwd_megakernel, hipFuncAttributeMaxDynamicSharedMemorySize, LDS_BYTES);
        (void)hipOccupancyMaxActiveBlocksPerMultiprocessor(&per_cu, (const void*)fwd_megakernel, NTHREADS, LDS_BYTES);
        if (per_cu < 1) per_cu = 1;
        (void)hipGetLastError();
        grid = cus * per_cu;
    }
    if (grid < 0) return;
    Params p{};
    p.x = (const float*)d_in[0]; p.c = (const float*)d_in[1]; p.ctx = (const float*)d_in[2]; p.c_ctx = (const float*)d_in[3];
    p.ada_w = (const float*)d_in[4]; p.ada_b = (const float*)d_in[5]; p.norm_w = (const float*)d_in[6]; p.na_w_in = (const float*)d_in[7];
    p.na_rpb = (const float*)d_in[8]; p.na_w_out = (const float*)d_in[9]; p.hg_w_in = (const float*)d_in[10]; p.hg_lower = (const float*)d_in[11];
    p.hg_norm_w = (const float*)d_in[12]; p.hg_w_out = (const float*)d_in[13]; p.final_norm_w = (const float*)d_in[14];
    p.out = (float*)d_out; p.ws = (unsigned char*)d_ws; p.ph_lo = 0; p.ph_hi = NPHASE;
    void* args[] = {&p};
    hipError_t e = hipLaunchCooperativeKernel((const void*)fwd_megakernel, dim3(grid), dim3(NTHREADS), args, LDS_BYTES, stream);
    if (e != hipSuccess) fprintf(stderr, "cooperative launch failed: %s (grid %d)\n", hipGetErrorString(e), grid);
}
```

```cpp
#include <hip/hip_runtime.h>
#include <hip/hip_cooperative_groups.h>
#include <cstdio>
#include <cstdint>
namespace cg = cooperative_groups;

typedef unsigned short bf16_t;
typedef float f32x4 __attribute__((ext_vector_type(4)));
typedef unsigned u32x4 __attribute__((ext_vector_type(4)));
typedef unsigned u32x2 __attribute__((ext_vector_type(2)));

constexpr int D = 1024, NB = 16, SEQ = 4096, CTX = 256;
constexpr int NLAT = NB * SEQ;
constexpr int NCTX = NB * CTX;
constexpr int MTOT = NLAT + NCTX;
constexpr int N0 = 4096, N1 = 5120;
constexpr float EPS = 1e-6f;
constexpr float LOG2E = 1.4426950408889634f;
constexpr float QSCALE0 = 0.125f * LOG2E;
constexpr float QSCALE1 = 0.08838834764831845f;
constexpr int NTHREADS = 512, NWAVES = 8;

constexpr size_t MiB = 1u << 20;
constexpr size_t WS_MOD = 1 * MiB;
constexpr size_t WS_LB = 1 * MiB + 512 * 1024;
constexpr size_t WS_W0T = 2 * MiB, WS_WO0T = 10 * MiB, WS_W1T = 12 * MiB, WS_WO1T = 22 * MiB;
constexpr size_t WS_X1 = 32 * MiB;
constexpr size_t WS_R1 = 304 * MiB;
constexpr size_t WS_END = 984 * MiB;
static_assert(WS_X1 + (size_t)MTOT * D * 4 <= WS_R1 && WS_R1 + (size_t)MTOT * N1 * 2 <= WS_END, "ws map");

constexpr int LDS_BYTES = 147456;

struct Params {
    const float *x, *c, *ctx, *c_ctx, *ada_w, *ada_b, *norm_w, *na_w_in, *na_rpb, *na_w_out, *hg_w_in, *hg_lower, *hg_norm_w, *hg_w_out, *final_norm_w;
    float* out; unsigned char* ws; int ph_lo, ph_hi;
};

__device__ __forceinline__ float bf2f(bf16_t v) { return __uint_as_float((unsigned)v << 16); }
__device__ __forceinline__ unsigned f2bf(float f) { unsigned u = __float_as_uint(f); return (u + 0x7fffu + ((u >> 16) & 1u)) >> 16; }
__device__ __forceinline__ unsigned pk2(float lo, float hi) { return f2bf(lo) | (f2bf(hi) << 16); }
__device__ __forceinline__ float h2f(unsigned short v) { return (float)__builtin_bit_cast(_Float16, v); }
__device__ __forceinline__ unsigned short f2h(float f) { return __builtin_bit_cast(unsigned short, (_Float16)f); }
__device__ __forceinline__ float siluf(float v) { return v / (1.f + __expf(-v)); }
__device__ __forceinline__ float wave_sum(float v) {
#pragma unroll
    for (int o = 1; o < 64; o <<= 1) v += __shfl_xor(v, o);
    return v;
}
__device__ __forceinline__ void unpack8(const u32x4 w, float* f) {
    f[0] = __uint_as_float(w.x << 16); f[1] = __uint_as_float(w.x & 0xffff0000u);
    f[2] = __uint_as_float(w.y << 16); f[3] = __uint_as_float(w.y & 0xffff0000u);
    f[4] = __uint_as_float(w.z << 16); f[5] = __uint_as_float(w.z & 0xffff0000u);
    f[6] = __uint_as_float(w.w << 16); f[7] = __uint_as_float(w.w & 0xffff0000u);
}

__device__ __forceinline__ void transpose_item(const float* W, int K, int N, bf16_t* WT, float* scr, int item, int lane) {
    const int nblk = N / 32, kb = item / nblk, nb = item % nblk, k0 = 64 * kb, n0 = 32 * nb;
#pragma unroll 8
    for (int i = 0; i < 32; ++i) { const int kk = 2 * i + (lane >> 5); scr[kk * 33 + (lane & 31)] = W[(size_t)(k0 + kk) * N + n0 + (lane & 31)]; }
    __builtin_amdgcn_wave_barrier();
    const int c = lane & 7;
#pragma unroll
    for (int j = 0; j < 4; ++j) { const int n = (lane >> 3) + 8 * j; const float* s = scr + (8 * c) * 33 + n;
        u32x4 o; o.x = pk2(s[0 * 33], s[1 * 33]); o.y = pk2(s[2 * 33], s[3 * 33]); o.z = pk2(s[4 * 33], s[5 * 33]); o.w = pk2(s[6 * 33], s[7 * 33]);
        *(u32x4*)(WT + (size_t)(n0 + n) * K + k0 + 8 * c) = o; }
    __builtin_amdgcn_wave_barrier();
}

__device__ __forceinline__ void phase_prologue(const Params& P, unsigned char* lds) {
    const int tid = threadIdx.x, lane = tid & 63, wave = tid >> 6;
    unsigned char* ws = P.ws;
    {
        float* scr = (float*)(lds) + wave * (64 * 33);
        const int gw = blockIdx.x * NWAVES + wave, NGW = gridDim.x * NWAVES;
        constexpr int I0 = (D / 64) * (N0 / 32), IO = (D / 64) * (D / 32), I1 = (D / 64) * (N1 / 32);
        constexpr int NIT = I0 + IO + I1 + IO;
        for (int it = gw; it < NIT; it += NGW) {
            int r = it;
            if (r < I0) { transpose_item(P.na_w_in, D, N0, (bf16_t*)(ws + WS_W0T), scr, r, lane); continue; } r -= I0;
            if (r < IO) { transpose_item(P.na_w_out, D, D, (bf16_t*)(ws + WS_WO0T), scr, r, lane); continue; } r -= IO;
            if (r < I1) { transpose_item(P.hg_w_in, D, N1, (bf16_t*)(ws + WS_W1T), scr, r, lane); continue; } r -= I1;
            transpose_item(P.hg_w_out, D, D, (bf16_t*)(ws + WS_WO1T), scr, r, lane);
        }
    }
    __syncthreads();
    {
        float* sc = (float*)lds;
        float* red = (float*)(lds + 17 * 1024 * 4);
        for (int e = tid; e < 17 * 1024; e += NTHREADS) { const int r = e >> 10, k = e & 1023; const float v = (r < 16) ? P.c[r * 1024 + k] : P.c_ctx[k]; sc[e] = siluf(v); }
        __syncthreads();
        float* mod = (float*)(ws + WS_MOD);
        for (int it = blockIdx.x; it < 2 * 48; it += gridDim.x) {
            const int l = it / 48, n0 = (it % 48) * 64;
            const float* W = P.ada_w + (size_t)l * 1024 * 3072 + n0 + lane;
            float acc[17];
#pragma unroll
            for (int r = 0; r < 17; ++r) acc[r] = 0.f;
            const int kb = wave * 128;
#pragma unroll 4
            for (int k = 0; k < 128; ++k) { const float w = W[(size_t)(kb + k) * 3072];
#pragma unroll
                for (int r = 0; r < 17; ++r) acc[r] += sc[r * 1024 + kb + k] * w; }
#pragma unroll
            for (int r = 0; r < 17; ++r) red[(wave * 17 + r) * 64 + lane] = acc[r];
            __syncthreads();
            for (int e = tid; e < 17 * 64; e += NTHREADS) { const int r = e >> 6, n = e & 63; float s = P.ada_b[l * 3072 + n0 + n];
#pragma unroll
                for (int w = 0; w < 8; ++w) s += red[(w * 17 + r) * 64 + n];
                mod[(size_t)(l * 17 + r) * 3072 + n0 + n] = s; }
            __syncthreads();
        }
    }
    if (blockIdx.x == gridDim.x - 1) {
        float* lb = (float*)(ws + WS_LB);
        for (int cidx = tid; cidx < 1024; cidx += NTHREADS) { const float l0 = P.hg_lower[cidx], l1 = P.hg_lower[1024 + cidx]; const float mx = fmaxf(l0, l1);
            const float e0 = __expf(l0 - mx), e1 = __expf(l1 - mx); const float p0 = e0 / (e0 + e1), p1 = e1 / (e0 + e1); lb[cidx] = (p0 + p1) - p0; }
    }
}

__device__ __forceinline__ void phase_modulate(const Params& P, int layer, const float* xlat, const float* xctx, bf16_t* H) {
    const int tid = threadIdx.x, lane = tid & 63, wave = tid >> 6;
    const int gw = blockIdx.x * NWAVES + wave, NGW = gridDim.x * NWAVES;
    const float* mod = (const float*)(P.ws + WS_MOD) + (size_t)layer * 17 * 3072;
    const float* nw = P.norm_w + layer * 1024;
    for (int row = gw; row < MTOT; row += NGW) {
        const float* src = (row < NLAT) ? xlat + (size_t)row * D : xctx + (size_t)(row - NLAT) * D;
        const int br = (row < NLAT) ? (row >> 12) : 16;
        const float* sh = mod + (size_t)br * 3072; const float* scl = sh + 1024;
        f32x4 v[4]; float ss = 0.f;
#pragma unroll
        for (int j = 0; j < 4; ++j) { v[j] = *(const f32x4*)(src + lane * 4 + 256 * j); ss += (v[j].x * v[j].x + v[j].y * v[j].y) + (v[j].z * v[j].z + v[j].w * v[j].w); }
        const float rstd = 1.f / sqrtf(wave_sum(ss) * (1.f / D) + EPS);
#pragma unroll
        for (int j = 0; j < 4; ++j) { const int c0 = lane * 4 + 256 * j; const f32x4 w = *(const f32x4*)(nw + c0), s1 = *(const f32x4*)(scl + c0), s0 = *(const f32x4*)(sh + c0);
            const f32x4 h = (v[j] * rstd) * w * (s1 + 1.f) + s0;
            u32x2 o; o.x = pk2(h.x, h.y); o.y = pk2(h.z, h.w); *(u32x2*)(H + (size_t)row * D + c0) = o; }
    }
}

template <int MODE> __device__ __forceinline__ void epi_elem(const Params& P, int row, int col, float acc) {
    unsigned char* ws = P.ws;
    if (MODE == 0) {
        bf16_t* O = (bf16_t*)(ws + WS_R1);
        O[(size_t)row * N0 + col] = (bf16_t)f2bf(col < 1024 ? acc * QSCALE0 : acc);
    } else if (MODE == 1) {
        float* X1 = (float*)(ws + WS_X1);
        const float* mod = (const float*)(ws + WS_MOD);
        const int br = (row < NLAT) ? (row >> 12) : 16;
        const float xin = (row < NLAT) ? P.x[(size_t)row * D + col] : P.ctx[(size_t)(row - NLAT) * D + col];
        X1[(size_t)row * D + col] = xin + mod[(size_t)br * 3072 + 2048 + col] * acc;
    } else if (MODE == 2) {
        bf16_t* O = (bf16_t*)(ws + WS_R1);
        const int grp = col >> 10;
        unsigned short o;
        if (grp == 0) o = (unsigned short)f2bf(siluf(acc) * QSCALE1);
        else if (grp == 2 || grp == 3) { const float lb = ((const float*)(ws + WS_LB))[col & 1023]; const float f = lb + (1.f - lb) / (1.f + __expf(-acc)); o = f2h(__log2f(f)); }
        else o = (unsigned short)f2bf(acc);
        O[(size_t)row * N1 + col] = o;
    } else {
        float* X1 = (float*)(ws + WS_X1);
        const float* mod = (const float*)(ws + WS_MOD) + (size_t)17 * 3072;
        const int br = row >> 12;
        X1[(size_t)row * D + col] += mod[(size_t)br * 3072 + 2048 + col] * acc;
    }
}

namespace pg8 {
#define PG8_LAS __attribute__((address_space(3)))
typedef unsigned short bf16_t;
typedef short bf16x8 __attribute__((ext_vector_type(8)));
typedef float f32x4 __attribute__((ext_vector_type(4)));
typedef unsigned u32x4 __attribute__((ext_vector_type(4)));
constexpr int BM = 256, BK = 64, HALF = 128, HTB = HALF * BK * 2  , STAGE_BYTES = 8 * HTB, NXCD = 8, WGM = 8;

__host__ __device__ __forceinline__ int lds_byte(int r, int c) { const int st = (r >> 4) * 2 + (c >> 5), rr = r & 15, cc = c & 31, ob = rr * 64 + cc * 2; return st * 1024 + (ob ^ (((ob >> 9) & 1) << 5)); }
__host__ __device__ __forceinline__ void stage_rc(int b, int& R, int& C) { const int st = b / 1024, sb = b % 1024, swz = sb ^ (((sb >> 9) & 1) << 5); R = (st >> 1) * 16 + swz / 64; C = (st & 1) * 32 + (swz % 64) / 2; }
__host__ __device__ __forceinline__ int perm32(int rho) { const int n = rho >> 4, i = rho & 15; return 8 * (i >> 2) + 4 * n + (i & 3); }

struct Unit { int pm, pn; };
struct Gemm { const bf16_t* A; const bf16_t* Bt; int M, N, K; };

struct StaticOrder {
    int nM, nN, nwg, G, c;
    __host__ __device__ void init(int M, int N, int G_, int c_) { nM = M / BM; nN = N / BM; nwg = nM * nN; G = G_; c = c_; }
    __host__ __device__ bool next(int i, Unit& u) const {
        const long L = (long)i * G + c; if (L >= nwg) return false;
        int wgid = (int)L; { const int q = nwg / NXCD, r = nwg % NXCD, xcd = wgid % NXCD, off = wgid / NXCD; wgid = (xcd < r ? xcd * (q + 1) : r * (q + 1) + (xcd - r) * q) + off; }
        const int nig = WGM * nN, gid = wgid / nig, fm = gid * WGM, gsz = (nM - fm) < WGM ? (nM - fm) : WGM;
        u.pm = fm + ((wgid % nig) % gsz); u.pn = (wgid % nig) / gsz; return true;
    }
    __device__ __forceinline__ void a_ready(const Unit&) const {}
    __device__ __forceinline__ void done(const Unit&) const {}
};


__device__ __forceinline__ unsigned cvt_pk_bf16(float lo, float hi) { unsigned r; asm volatile("v_cvt_pk_bf16_f32 %0, %1, %2" : "=v"(r) : "v"(lo), "v"(hi)); return r; }
__device__ __forceinline__ unsigned cvt_pk_f16(float lo, float hi) { return (unsigned)__builtin_bit_cast(unsigned short, (_Float16)lo) | ((unsigned)__builtin_bit_cast(unsigned short, (_Float16)hi) << 16); }
struct EpiQKVZ {
    static constexpr bool PERM = true, AFTER_DRAIN = false;
    bf16_t* O;
    __device__ __forceinline__ void operator()(const f32x4 (&acc)[2][2][4][2], const Unit& u, int wr, int wc, int fr, int fq) const {
        const int row0 = u.pm * BM + wr * 64 + fr, col0 = u.pn * BM + wc * 32 + 8 * fq;
        const float sc = (u.pn < 4) ? QSCALE0 : 1.f;
#pragma unroll
        for (int ai = 0; ai < 2; ++ai)
#pragma unroll
            for (int m = 0; m < 4; ++m) { bf16_t* rowp = O + (size_t)(row0 + ai * HALF + m * 16) * N0 + col0;
#pragma unroll
                for (int bj = 0; bj < 2; ++bj) { const f32x4 v0 = acc[ai][bj][m][0] * sc, v1 = acc[ai][bj][m][1] * sc;
                    u32x4 w; w.x = cvt_pk_bf16(v0[0], v0[1]); w.y = cvt_pk_bf16(v0[2], v0[3]); w.z = cvt_pk_bf16(v1[0], v1[1]); w.w = cvt_pk_bf16(v1[2], v1[3]);
                    *(u32x4*)(rowp + bj * HALF) = w; } }
    }
};
struct EpiRes {
    static constexpr bool PERM = false, AFTER_DRAIN = false;
    const float* xlat; const float* xctx; const float* mod; float* X1;
    __device__ __forceinline__ void operator()(const f32x4 (&acc)[2][2][4][2], const Unit& u, int wr, int wc, int fr, int fq) const {
        const int rowt = u.pm * BM; const bool lat = rowt < NLAT; const int br = lat ? (rowt >> 12) : 16;
        const float* src = lat ? xlat + (size_t)rowt * D : xctx + (size_t)(rowt - NLAT) * D;
        float* dst = X1 + (size_t)rowt * D;
        const int rl0 = wr * 64 + fr, col0 = u.pn * BM + wc * 32 + 4 * fq;
        f32x4 g[2][2];
#pragma unroll
        for (int bj = 0; bj < 2; ++bj)
#pragma unroll
            for (int n = 0; n < 2; ++n) g[bj][n] = *(const f32x4*)(mod + (size_t)br * 3072 + 2048 + col0 + bj * HALF + n * 16);
#pragma unroll
        for (int ai = 0; ai < 2; ++ai)
#pragma unroll
            for (int m = 0; m < 4; ++m) { const size_t off = (size_t)(rl0 + ai * HALF + m * 16) * D + col0;
#pragma unroll
                for (int bj = 0; bj < 2; ++bj)
#pragma unroll
                    for (int n = 0; n < 2; ++n) { const size_t o = off + bj * HALF + n * 16; *(f32x4*)(dst + o) = *(const f32x4*)(src + o) + g[bj][n] * acc[ai][bj][m][n]; } }
    }
};
struct EpiHG {
    static constexpr bool PERM = true, AFTER_DRAIN = false;
    unsigned short* O; const float* lb;
    __device__ __forceinline__ void operator()(const f32x4 (&acc)[2][2][4][2], const Unit& u, int wr, int wc, int fr, int fq) const {
        const int row0 = u.pm * BM + wr * 64 + fr, col0 = u.pn * BM + wc * 32 + 8 * fq;
        const int grp = u.pn >> 2;
        if (grp == 2 || grp == 3) {
#pragma unroll
            for (int bj = 0; bj < 2; ++bj) {
                const f32x4 l0 = *(const f32x4*)(lb + ((col0 + bj * HALF) & 1023)), l1 = *(const f32x4*)(lb + ((col0 + bj * HALF) & 1023) + 4);
#pragma unroll
                for (int ai = 0; ai < 2; ++ai)
#pragma unroll
                    for (int m = 0; m < 4; ++m) { unsigned short* rowp = O + (size_t)(row0 + ai * HALF + m * 16) * N1 + col0 + bj * HALF;
                        const f32x4 v0 = acc[ai][bj][m][0], v1 = acc[ai][bj][m][1]; float r[8];
#pragma unroll
                        for (int e = 0; e < 4; ++e) { const float f0 = l0[e] + (1.f - l0[e]) * __builtin_amdgcn_rcpf(1.f + __expf(-v0[e])); r[e] = __log2f(f0);
                            const float f1 = l1[e] + (1.f - l1[e]) * __builtin_amdgcn_rcpf(1.f + __expf(-v1[e])); r[4 + e] = __log2f(f1); }
                        u32x4 w; w.x = cvt_pk_f16(r[0], r[1]); w.y = cvt_pk_f16(r[2], r[3]); w.z = cvt_pk_f16(r[4], r[5]); w.w = cvt_pk_f16(r[6], r[7]);
                        *(u32x4*)rowp = w; }
            }
        } else {
#pragma unroll
            for (int ai = 0; ai < 2; ++ai)
#pragma unroll
                for (int m = 0; m < 4; ++m) { unsigned short* rowp = O + (size_t)(row0 + ai * HALF + m * 16) * N1 + col0;
#pragma unroll
                    for (int bj = 0; bj < 2; ++bj) { f32x4 v0 = acc[ai][bj][m][0], v1 = acc[ai][bj][m][1];
                        if (grp == 0) {
#pragma unroll
                            for (int e = 0; e < 4; ++e) { v0[e] = v0[e] * QSCALE1 * __builtin_amdgcn_rcpf(1.f + __expf(-v0[e])); v1[e] = v1[e] * QSCALE1 * __builtin_amdgcn_rcpf(1.f + __expf(-v1[e])); } }
                        u32x4 w; w.x = cvt_pk_bf16(v0[0], v0[1]); w.y = cvt_pk_bf16(v0[2], v0[3]); w.z = cvt_pk_bf16(v1[0], v1[1]); w.w = cvt_pk_bf16(v1[2], v1[3]);
                        *(u32x4*)(rowp + bj * HALF) = w; } }
        }
    }
};
template <class Epi, class Sched, bool ALIGN_EPI = false, bool SP2 = false>
__device__ __forceinline__ void gemm_phase(PG8_LAS unsigned char* lds, const Gemm g, const Sched& S, const Epi& E) {
    const int tid = threadIdx.x, wid = __builtin_amdgcn_readfirstlane(tid >> 6), lane = tid & 63, wr = wid >> 2, wc = wid & 3, fr = lane & 15, fq = lane >> 4;
    const int K = g.K, nt = K / BK;
    unsigned voffA[2], voffB[2];
#pragma unroll
    for (int i = 0; i < 2; ++i) { int R, C; stage_rc(tid * 16 + i * 8192, R, C); const int Rb = Epi::PERM ? ((R & ~31) + perm32(R & 31)) : R;
        voffA[i] = (unsigned)(R * K + C) * 2u; voffB[i] = (unsigned)(Rb * K + C) * 2u; }
    const size_t kstep = (size_t)(BK * 2);
    const size_t hstep = (size_t)HALF * K * 2;
    const size_t tstep = 2 * hstep;
    const unsigned ldsw = (unsigned)wid * 1024u;
    const int aoff = lds_byte(wr * 64 + fr, fq * 8), boff = lds_byte(wc * 32 + fr, fq * 8);
#define PG8_SA(b, h) (((b) * 2 + (h)) * HTB)
#define PG8_SB(b, h) ((4 + (b) * 2 + (h)) * HTB)
#define PG8_STAGE(bufoff, gbase, voff) do { _Pragma("unroll") for (int _i = 0; _i < 2; ++_i) \
        __builtin_amdgcn_global_load_lds((const unsigned*)((const char*)(gbase) + (voff)[_i]), (PG8_LAS unsigned*)(lds + (bufoff) + ldsw + _i * 8192), 16, 0, 0); } while (0)
#define PG8_LDA(dst, b, h) do { _Pragma("unroll") for (int m = 0; m < 4; ++m) _Pragma("unroll") for (int k = 0; k < 2; ++k) dst[m][k] = *(const PG8_LAS bf16x8*)(lds + PG8_SA(b, h) + aoff + m * 2048 + k * 1024); } while (0)
#define PG8_LDB(dst, b, h) do { _Pragma("unroll") for (int n = 0; n < 2; ++n) _Pragma("unroll") for (int k = 0; k < 2; ++k) dst[n][k] = *(const PG8_LAS bf16x8*)(lds + PG8_SB(b, h) + boff + n * 2048 + k * 1024); } while (0)
#define PG8_MMA(ai, bj, At, Bt) do { __builtin_amdgcn_s_setprio(1); _Pragma("unroll") for (int m = 0; m < 4; ++m) _Pragma("unroll") for (int n = 0; n < 2; ++n) _Pragma("unroll") for (int k = 0; k < 2; ++k) \
        acc[ai][bj][m][n] = __builtin_amdgcn_mfma_f32_16x16x32_bf16(Bt[n][k], At[m][k], acc[ai][bj][m][n], 0, 0, 0); __builtin_amdgcn_s_setprio(0); } while (0)
#define PG8_WAIT_V(n) asm volatile("s_waitcnt vmcnt(" #n ")" ::: "memory")
#define PG8_WAIT_L(n) asm volatile("s_waitcnt lgkmcnt(" #n ")" ::: "memory")
#define PG8_BAR __builtin_amdgcn_s_barrier()
#define PG8_SCHED __builtin_amdgcn_sched_barrier(0)
    Unit cur, nxt; int ui = 0;
    if (!S.next(0, cur)) return;
    f32x4 acc[2][2][4][2];
#pragma unroll
    for (int a = 0; a < 2; ++a)
#pragma unroll
        for (int b = 0; b < 2; ++b)
#pragma unroll
            for (int m = 0; m < 4; ++m)
#pragma unroll
                for (int n = 0; n < 2; ++n) acc[a][b][m][n] = (f32x4){0.f, 0.f, 0.f, 0.f};
    bf16x8 At[4][2], B0[2][2], B1[2][2];
    const char* cA = (const char*)g.A + (size_t)cur.pm * tstep; const char* cB = (const char*)g.Bt + (size_t)cur.pn * tstep;
    S.a_ready(cur);
    if constexpr (SP2) {
        PG8_STAGE(PG8_SB(0, 0), cB, voffB); PG8_STAGE(PG8_SB(0, 1), cB + hstep, voffB); PG8_STAGE(PG8_SA(0, 0), cA, voffA); PG8_STAGE(PG8_SA(0, 1), cA + hstep, voffA);
        if (wr == 1) PG8_BAR;
        PG8_WAIT_V(2); PG8_BAR;
        PG8_STAGE(PG8_SB(1, 0), cB + kstep, voffB); PG8_STAGE(PG8_SA(1, 0), cA + kstep, voffA); PG8_STAGE(PG8_SB(1, 1), cB + hstep + kstep, voffB);
        PG8_WAIT_V(6); PG8_BAR;
    } else {
        PG8_STAGE(PG8_SB(0, 0), cB, voffB); PG8_STAGE(PG8_SA(0, 0), cA, voffA); PG8_STAGE(PG8_SB(0, 1), cB + hstep, voffB); PG8_STAGE(PG8_SA(0, 1), cA + hstep, voffA);
        if (wr == 1) PG8_BAR;
        PG8_WAIT_V(4); PG8_BAR;
        PG8_STAGE(PG8_SB(1, 0), cB + kstep, voffB); PG8_STAGE(PG8_SA(1, 0), cA + kstep, voffA); PG8_STAGE(PG8_SB(1, 1), cB + hstep + kstep, voffB);
        PG8_WAIT_V(6); PG8_BAR;
    }
    for (;;) {
        const bool has_next = S.next(ui + 1, nxt);
        const char* nA = has_next ? (const char*)g.A + (size_t)nxt.pm * tstep : cA; const char* nB = has_next ? (const char*)g.Bt + (size_t)nxt.pn * tstep : cB;
        for (int t = 0; t < nt; t += 2) {
            const bool last = (t == nt - 2);
            const char* a1 = cA + (size_t)(t + 1) * kstep;
            const char* a2 = last ? nA : cA + (size_t)(t + 2) * kstep; const char* b2 = last ? nB : cB + (size_t)(t + 2) * kstep;
            const char* a3 = a2 + kstep; const char* b3 = b2 + kstep;
            if (last && has_next) S.a_ready(nxt);
            if constexpr (SP2) {
            PG8_LDB(B0, 0, 0); PG8_LDB(B1, 0, 1); PG8_SCHED; PG8_LDA(At, 0, 0); PG8_STAGE(PG8_SA(1, 1), a1 + hstep, voffA);
            PG8_WAIT_V(8); PG8_WAIT_L(0); PG8_BAR; PG8_MMA(0, 0, At, B0); PG8_MMA(0, 1, At, B1); PG8_BAR; PG8_SCHED;
            PG8_LDA(At, 0, 1); PG8_STAGE(PG8_SB(0, 0), b2, voffB); PG8_STAGE(PG8_SB(0, 1), b2 + hstep, voffB); PG8_STAGE(PG8_SA(0, 0), a2, voffA);
            PG8_WAIT_V(8); PG8_WAIT_L(0); PG8_BAR; PG8_MMA(1, 0, At, B0); PG8_MMA(1, 1, At, B1); PG8_BAR; PG8_SCHED;
            PG8_LDB(B0, 1, 0); PG8_LDB(B1, 1, 1); PG8_SCHED; PG8_LDA(At, 1, 0); PG8_STAGE(PG8_SA(0, 1), a2 + hstep, voffA);
            PG8_WAIT_V(8); PG8_WAIT_L(0); PG8_BAR; PG8_MMA(0, 0, At, B0); PG8_MMA(0, 1, At, B1); PG8_BAR; PG8_SCHED;
            PG8_LDA(At, 1, 1); PG8_STAGE(PG8_SB(1, 0), b3, voffB); PG8_STAGE(PG8_SB(1, 1), b3 + hstep, voffB); PG8_STAGE(PG8_SA(1, 0), a3, voffA);
            PG8_WAIT_V(8); PG8_WAIT_L(0); PG8_BAR; PG8_MMA(1, 0, At, B0); PG8_MMA(1, 1, At, B1); PG8_BAR; PG8_SCHED;
            } else {
            PG8_LDB(B0, 0, 0); PG8_SCHED; PG8_LDA(At, 0, 0); PG8_STAGE(PG8_SA(1, 1), a1 + hstep, voffA);
            PG8_WAIT_L(8); PG8_BAR; PG8_WAIT_L(0); PG8_MMA(0, 0, At, B0); PG8_BAR; PG8_SCHED;
            PG8_LDB(B1, 0, 1); PG8_STAGE(PG8_SB(0, 0), b2, voffB);
            PG8_BAR; PG8_WAIT_L(0); PG8_MMA(0, 1, At, B1); PG8_BAR;
            PG8_LDA(At, 0, 1); PG8_STAGE(PG8_SA(0, 0), a2, voffA);
            PG8_BAR; PG8_WAIT_L(0); PG8_MMA(1, 0, At, B0); PG8_BAR; PG8_SCHED;
            PG8_STAGE(PG8_SB(0, 1), b2 + hstep, voffB);
            PG8_WAIT_V(6); PG8_BAR; PG8_MMA(1, 1, At, B1); PG8_BAR;
            PG8_LDB(B0, 1, 0); PG8_SCHED; PG8_LDA(At, 1, 0); PG8_STAGE(PG8_SA(0, 1), a2 + hstep, voffA);
            PG8_WAIT_L(8); PG8_BAR; PG8_WAIT_L(0); PG8_MMA(0, 0, At, B0); PG8_BAR; PG8_SCHED;
            PG8_LDB(B1, 1, 1); PG8_STAGE(PG8_SB(1, 0), b3, voffB);
            PG8_BAR; PG8_WAIT_L(0); PG8_MMA(0, 1, At, B1); PG8_BAR;
            PG8_LDA(At, 1, 1); PG8_STAGE(PG8_SA(1, 0), a3, voffA);
            PG8_BAR; PG8_WAIT_L(0); PG8_MMA(1, 0, At, B0); PG8_BAR; PG8_SCHED;
            PG8_STAGE(PG8_SB(1, 1), b3 + hstep, voffB);
            PG8_WAIT_V(6); PG8_BAR; PG8_MMA(1, 1, At, B1); PG8_BAR;
            }
        }
        if constexpr (ALIGN_EPI) { if (wr == 0) PG8_BAR; }
        if constexpr (!Epi::AFTER_DRAIN) { E(acc, cur, wr, wc, fr, fq); S.done(cur); }
        if (!has_next) break;
#pragma unroll
        for (int a = 0; a < 2; ++a)
#pragma unroll
            for (int b = 0; b < 2; ++b)
#pragma unroll
                for (int m = 0; m < 4; ++m)
#pragma unroll
                    for (int n = 0; n < 2; ++n) acc[a][b][m][n] = (f32x4){0.f, 0.f, 0.f, 0.f};
        cur = nxt; cA = nA; cB = nB; ++ui;
        if constexpr (ALIGN_EPI) { if (wr == 1) PG8_BAR; }
    }
    PG8_WAIT_V(0);
    if constexpr (!ALIGN_EPI) { if (wr == 0) PG8_BAR; }
    PG8_BAR;
    if constexpr (Epi::AFTER_DRAIN) { E.fused(acc, cur, wr, wc, fr, fq, lds, wid, lane); S.done(cur); }
#undef PG8_SA
#undef PG8_SB
#undef PG8_STAGE
#undef PG8_LDA
#undef PG8_LDB
#undef PG8_MMA
#undef PG8_WAIT_V
#undef PG8_WAIT_L
#undef PG8_BAR
#undef PG8_SCHED
}
}

template <int MODE> __device__ __forceinline__ void gemm_naive(const Params& P, const bf16_t* A, const bf16_t* Bt, int M, int N, int K, unsigned char* lds) {
    float* As = (float*)lds;
    float* Bs = As + 32 * 132;
    const int tid = threadIdx.x, ty = tid >> 5, tx = tid & 31;
    const int nTn = N / 128, ntiles = (M / 128) * nTn;
    for (int t = blockIdx.x; t < ntiles; t += gridDim.x) {
        const int tm = t / nTn, tn = t % nTn;
        float acc[8][4];
#pragma unroll
        for (int i = 0; i < 8; ++i)
#pragma unroll
            for (int j = 0; j < 4; ++j) acc[i][j] = 0.f;
        for (int k0 = 0; k0 < K; k0 += 32) {
            {
                const int r = tid >> 2, kc = (tid & 3) * 8;
                float f[8];
                unpack8(*(const u32x4*)(A + (size_t)(tm * 128 + r) * K + k0 + kc), f);
#pragma unroll
                for (int i = 0; i < 8; ++i) As[(kc + i) * 132 + r] = f[i];
                unpack8(*(const u32x4*)(Bt + (size_t)(tn * 128 + r) * K + k0 + kc), f);
#pragma unroll
                for (int i = 0; i < 8; ++i) Bs[(kc + i) * 132 + r] = f[i];
            }
            __syncthreads();
#pragma unroll 8
            for (int k = 0; k < 32; ++k) {
                const f32x4 a0 = *(const f32x4*)(As + k * 132 + ty * 8), a1 = *(const f32x4*)(As + k * 132 + ty * 8 + 4), b = *(const f32x4*)(Bs + k * 132 + tx * 4);
                const float a[8] = {a0.x, a0.y, a0.z, a0.w, a1.x, a1.y, a1.z, a1.w}; const float bb[4] = {b.x, b.y, b.z, b.w};
#pragma unroll
                for (int i = 0; i < 8; ++i)
#pragma unroll
                    for (int j = 0; j < 4; ++j) acc[i][j] += a[i] * bb[j];
            }
            __syncthreads();
        }
#pragma unroll
        for (int i = 0; i < 8; ++i)
#pragma unroll
            for (int j = 0; j < 4; ++j) epi_elem<MODE>(P, tm * 128 + ty * 8 + i, tn * 128 + tx * 4 + j, acc[i][j]);
    }
}

__device__ __forceinline__ void phase_na_naive(const Params& P, unsigned char* lds, bf16_t* Y) {
    const int tid = threadIdx.x, lane = tid & 63, wave = tid >> 6;
    float* rpbL = (float*)lds;
    for (int e = tid; e < 16 * 15 * 31; e += NTHREADS) rpbL[e] = P.na_rpb[e] * LOG2E;
    __syncthreads();
    const bf16_t* R = (const bf16_t*)(P.ws + WS_R1);
    const int gw = blockIdx.x * NWAVES + wave, NGW = gridDim.x * NWAVES;
    for (int u = gw; u < 16384 + 1024; u += NGW) {
        int b, h, r = 0, qtok, nloc, r0 = 0, cs = 0;
        if (u < 16384) { r = u & 63; h = (u >> 6) & 15; b = u >> 10; qtok = b * SEQ + r * 64 + lane; nloc = 128;
            r0 = min(max(r - 4, 0), 56); cs = min(max(lane - 8, 0), 48); }
        else { const int v = u - 16384; const int qb = v & 3; h = (v >> 2) & 15; b = v >> 6; qtok = NLAT + b * CTX + qb * 64 + lane; nloc = 0; }
        float q[64], O[64];
        {
            const bf16_t* qp = R + (size_t)qtok * N0 + h * 64;
#pragma unroll
            for (int i = 0; i < 8; ++i) unpack8(*(const u32x4*)(qp + 8 * i), q + 8 * i);
        }
#pragma unroll
        for (int d = 0; d < 64; ++d) O[d] = 0.f;
        float m = -1e30f, l = 0.f;
        const int nk = nloc + CTX;
        for (int kk = 0; kk < nk; ++kk) {
            int ktok; float s;
            if (kk < nloc) { const int kr = kk >> 4, j = kk & 15; ktok = b * SEQ + (r0 + kr) * 64 + cs + j; s = rpbL[h * 465 + (r0 + kr - r + 7) * 31 + (cs + j - lane + 15)]; }
            else { ktok = NLAT + b * CTX + (kk - nloc); s = 0.f; }
            const bf16_t* kp = R + (size_t)ktok * N0 + 1024 + h * 64;
#pragma unroll
            for (int i = 0; i < 8; ++i) { float f[8]; unpack8(*(const u32x4*)(kp + 8 * i), f);
#pragma unroll
                for (int j2 = 0; j2 < 8; ++j2) s += q[8 * i + j2] * f[j2]; }
            const float mn = fmaxf(m, s), alpha = exp2f(m - mn), p = exp2f(s - mn);
            l = l * alpha + p; m = mn;
            const bf16_t* vp = kp + 1024;
#pragma unroll
            for (int i = 0; i < 8; ++i) { float f[8]; unpack8(*(const u32x4*)(vp + 8 * i), f);
#pragma unroll
                for (int j2 = 0; j2 < 8; ++j2) O[8 * i + j2] = O[8 * i + j2] * alpha + p * f[j2]; }
        }
        const float rl = 1.f / l;
        const bf16_t* zp = R + (size_t)qtok * N0 + 3072 + h * 64;
        bf16_t* yp = Y + (size_t)qtok * D + h * 64;
#pragma unroll
        for (int i = 0; i < 8; ++i) { float z[8]; unpack8(*(const u32x4*)(zp + 8 * i), z);
            u32x4 o;
            o.x = pk2(O[8 * i + 0] * rl * siluf(z[0]), O[8 * i + 1] * rl * siluf(z[1]));
            o.y = pk2(O[8 * i + 2] * rl * siluf(z[2]), O[8 * i + 3] * rl * siluf(z[3]));
            o.z = pk2(O[8 * i + 4] * rl * siluf(z[4]), O[8 * i + 5] * rl * siluf(z[5]));
            o.w = pk2(O[8 * i + 6] * rl * siluf(z[6]), O[8 * i + 7] * rl * siluf(z[7]));
            *(u32x4*)(yp + 8 * i) = o; }
    }
}

__device__ __forceinline__ void phase_hgrn_naive(const Params& P, unsigned char* lds, bf16_t* OF, bf16_t* OB) {
    const int tid = threadIdx.x, lane = tid & 63, wave = tid >> 6, l16 = lane & 15, q4 = lane >> 4;
    float* fT = (float*)lds;
    float* kT = fT + 32 * 128; float* qT = kT + 32 * 128; float* vT = qT + 32 * 128; float* oT = vT + 32 * 128;
    const unsigned short* R = (const unsigned short*)(P.ws + WS_R1);
    for (int it = blockIdx.x; it < 256; it += gridDim.x) {
        const int b = it >> 4, h = (it >> 1) & 7, dir = it & 1;
        bf16_t* Odst = dir ? OB : OF;
        float S[32];
#pragma unroll
        for (int i = 0; i < 32; ++i) S[i] = 0.f;
        for (int ci = 0; ci < 8 + 128; ++ci) {
            const bool is_ctx = ci < 8;
            const int len = is_ctx ? CTX : SEQ, sp0 = is_ctx ? ci * 32 : (ci - 8) * 32;
            const size_t rowbase = is_ctx ? (size_t)(NLAT + b * CTX) : (size_t)b * SEQ;
#pragma unroll
            for (int j = 0; j < 8; ++j) {
                const int e = tid + NTHREADS * j, p = e >> 7, c = e & 127;
                const int sp = sp0 + p, ti = dir ? (len - 1 - sp) : sp;
                const unsigned short* rp = R + (rowbase + ti) * N1 + h * 128 + c;
                const float lf2 = h2f(rp[(2 + dir) * 1024]);
                fT[e] = exp2f(lf2); kT[e] = -expm1f(lf2 * 0.6931471805599453f);
                vT[e] = bf2f(rp[1024]); qT[e] = is_ctx ? 0.f : bf2f(rp[0]);
            }
            __syncthreads();
            for (int t = 0; t < 32; ++t) {
                const float v = vT[t * 128 + wave * 16 + l16];
                float o = 0.f;
#pragma unroll
                for (int i4 = 0; i4 < 8; ++i4) {
                    const f32x4 f = *(const f32x4*)(fT + t * 128 + q4 * 32 + i4 * 4), k = *(const f32x4*)(kT + t * 128 + q4 * 32 + i4 * 4), qq = *(const f32x4*)(qT + t * 128 + q4 * 32 + i4 * 4);
                    S[i4 * 4 + 0] = f.x * S[i4 * 4 + 0] + k.x * v; o += S[i4 * 4 + 0] * qq.x;
                    S[i4 * 4 + 1] = f.y * S[i4 * 4 + 1] + k.y * v; o += S[i4 * 4 + 1] * qq.y;
                    S[i4 * 4 + 2] = f.z * S[i4 * 4 + 2] + k.z * v; o += S[i4 * 4 + 2] * qq.z;
                    S[i4 * 4 + 3] = f.w * S[i4 * 4 + 3] + k.w * v; o += S[i4 * 4 + 3] * qq.w;
                }
                o += __shfl_xor(o, 16); o += __shfl_xor(o, 32);
                if (q4 == 0) oT[t * 128 + wave * 16 + l16] = o;
            }
            __syncthreads();
            if (!is_ctx) {
#pragma unroll
                for (int j = 0; j < 8; ++j) {
                    const int e = tid + NTHREADS * j, p = e >> 7, c = e & 127;
                    const int sp = sp0 + p, ti = dir ? (len - 1 - sp) : sp;
                    Odst[(rowbase + ti) * D + h * 128 + c] = (bf16_t)f2bf(oT[e]);
                }
            }
        }
        __syncthreads();
    }
}

__device__ __forceinline__ void phase_readout(const Params& P, bf16_t* OF, const bf16_t* OB) {
    const int tid = threadIdx.x, lane = tid & 63, wave = tid >> 6;
    const int gw = blockIdx.x * NWAVES + wave, NGW = gridDim.x * NWAVES;
    const bf16_t* R = (const bf16_t*)(P.ws + WS_R1);
    float hw[16];
#pragma unroll
    for (int i = 0; i < 16; ++i) hw[i] = P.hg_norm_w[(lane * 16 + i) & 127];
    for (int row = gw; row < NLAT; row += NGW) {
        float o[16], g[16], t[8];
        unpack8(*(const u32x4*)(OF + (size_t)row * D + lane * 16), o); unpack8(*(const u32x4*)(OF + (size_t)row * D + lane * 16 + 8), o + 8);
        unpack8(*(const u32x4*)(OB + (size_t)row * D + lane * 16), t);
#pragma unroll
        for (int i = 0; i < 8; ++i) o[i] += t[i];
        unpack8(*(const u32x4*)(OB + (size_t)row * D + lane * 16 + 8), t);
#pragma unroll
        for (int i = 0; i < 8; ++i) o[8 + i] += t[i];
        unpack8(*(const u32x4*)(R + (size_t)row * N1 + 4096 + lane * 16), g); unpack8(*(const u32x4*)(R + (size_t)row * N1 + 4096 + lane * 16 + 8), g + 8);
        float ss = 0.f;
#pragma unroll
        for (int i = 0; i < 16; ++i) ss += o[i] * o[i];
        ss += __shfl_xor(ss, 1); ss += __shfl_xor(ss, 2); ss += __shfl_xor(ss, 4);
        const float rstd = 1.f / sqrtf(ss * (1.f / 128.f) + EPS);
        float y[16];
#pragma unroll
        for (int i = 0; i < 16; ++i) y[i] = o[i] * rstd * hw[i] * siluf(g[i]);
        u32x4 w0, w1;
        w0.x = pk2(y[0], y[1]); w0.y = pk2(y[2], y[3]); w0.z = pk2(y[4], y[5]); w0.w = pk2(y[6], y[7]);
        w1.x = pk2(y[8], y[9]); w1.y = pk2(y[10], y[11]); w1.z = pk2(y[12], y[13]); w1.w = pk2(y[14], y[15]);
        *(u32x4*)(OF + (size_t)row * D + lane * 16) = w0; *(u32x4*)(OF + (size_t)row * D + lane * 16 + 8) = w1;
    }
}

__device__ __forceinline__ void phase_final(const Params& P) {
    const int tid = threadIdx.x, lane = tid & 63, wave = tid >> 6;
    const int gw = blockIdx.x * NWAVES + wave, NGW = gridDim.x * NWAVES;
    const float* X1 = (const float*)(P.ws + WS_X1);
    for (int row = gw; row < NLAT; row += NGW) {
        f32x4 v[4]; float ss = 0.f;
#pragma unroll
        for (int j = 0; j < 4; ++j) { v[j] = *(const f32x4*)(X1 + (size_t)row * D + lane * 4 + 256 * j); ss += (v[j].x * v[j].x + v[j].y * v[j].y) + (v[j].z * v[j].z + v[j].w * v[j].w); }
        const float rstd = 1.f / sqrtf(wave_sum(ss) * (1.f / D) + EPS);
#pragma unroll
        for (int j = 0; j < 4; ++j) { const f32x4 w = *(const f32x4*)(P.final_norm_w + lane * 4 + 256 * j); *(f32x4*)(P.out + (size_t)row * D + lane * 4 + 256 * j) = (v[j] * rstd) * w; }
    }
}

constexpr int NPHASE = 11;
__global__ void __launch_bounds__(NTHREADS, 2) fwd_megakernel(Params P) {
    extern __shared__ __attribute__((aligned(16))) unsigned char lds[];
    cg::grid_group grid = cg::this_grid();
    unsigned char* ws = P.ws;
    bf16_t* H = (bf16_t*)P.out;
    bf16_t* OF = (bf16_t*)P.out;
    bf16_t* OB = (bf16_t*)P.out + (size_t)NLAT * D;
    float* X1 = (float*)(ws + WS_X1);
    const int lo = P.ph_lo, hi = P.ph_hi;
#define IN(k) (lo <= (k) && (k) < hi)
#define SEAM(k) do { if (IN(k) && IN((k) + 1)) grid.sync(); } while (0)
    if (IN(0)) phase_prologue(P, lds);
    SEAM(0);
    if (IN(1)) phase_modulate(P, 0, P.x, P.ctx, H);
    SEAM(1);
    if (IN(2)) { pg8::Gemm g{H, (const bf16_t*)(ws + WS_W0T), MTOT, N0, D}; pg8::StaticOrder S; S.init(MTOT, N0, (int)gridDim.x, (int)blockIdx.x);
        pg8::EpiQKVZ E{(bf16_t*)(ws + WS_R1)}; pg8::gemm_phase<pg8::EpiQKVZ, pg8::StaticOrder, true, true>((PG8_LAS unsigned char*)lds, g, S, E); }
    SEAM(2);
    if (IN(3)) phase_na_naive(P, lds, H);
    SEAM(3);
    if (IN(4)) { pg8::Gemm g{H, (const bf16_t*)(ws + WS_WO0T), MTOT, D, D}; pg8::StaticOrder S; S.init(MTOT, D, (int)gridDim.x, (int)blockIdx.x);
        pg8::EpiRes E{P.x, P.ctx, (const float*)(ws + WS_MOD), X1}; pg8::gemm_phase<pg8::EpiRes, pg8::StaticOrder, true, true>((PG8_LAS unsigned char*)lds, g, S, E); }
    SEAM(4);
    if (IN(5)) phase_modulate(P, 1, X1, X1 + (size_t)NLAT * D, H);
    SEAM(5);
    if (IN(6)) { pg8::Gemm g{H, (const bf16_t*)(ws + WS_W1T), MTOT, N1, D}; pg8::StaticOrder S; S.init(MTOT, N1, (int)gridDim.x, (int)blockIdx.x);
        pg8::EpiHG E{(unsigned short*)(ws + WS_R1), (const float*)(ws + WS_LB)}; pg8::gemm_phase<pg8::EpiHG, pg8::StaticOrder, true, true>((PG8_LAS unsigned char*)lds, g, S, E); }
    SEAM(6);
    if (IN(7)) phase_hgrn_naive(P, lds, OF, OB);
    SEAM(7);
    if (IN(8)) phase_readout(P, OF, OB);
    SEAM(8);
    if (IN(9)) { pg8::Gemm g{OF, (const bf16_t*)(ws + WS_WO1T), NLAT, D, D}; pg8::StaticOrder S; S.init(NLAT, D, (int)gridDim.x, (int)blockIdx.x);
        pg8::EpiRes E{X1, X1 + (size_t)NLAT * D, (const float*)(ws + WS_MOD) + 17 * 3072, X1}; pg8::gemm_phase<pg8::EpiRes, pg8::StaticOrder, true, true>((PG8_LAS unsigned char*)lds, g, S, E); }
    SEAM(9);
    if (IN(10)) phase_final(P);
#undef IN
#undef SEAM
}

extern "C" void kernel_launch(void* const* d_in, const int* in_sizes, int n_in, void* d_out, int out_size, void* d_ws, size_t ws_size, hipStream_t stream) {
    static int grid = 0;
    if (grid == 0) {
        if (n_in != 15 || out_size != NLAT * D || ws_size < WS_END) { fprintf(stderr, "kernel_launch: unexpected sizes n_in %d out %d ws %zu\n", n_in, out_size, ws_size); grid = -1; return; }
        int dev = 0, cus = 0, per_cu = 0;
        (void)hipGetDevice(&dev);
        (void)hipDeviceGetAttribute(&cus, hipDeviceAttributeMultiprocessorCount, dev);
        (void)hipFuncSetAttribute((const void*)fwd_megakernel, hipFuncAttributeMaxDynamicSharedMemorySize, LDS_BYTES);
        (void)hipOccupancyMaxActiveBlocksPerMultiprocessor(&per_cu, (const void*)fwd_megakernel, NTHREADS, LDS_BYTES);
        if (per_cu < 1) per_cu = 1;
        (void)hipGetLastError();
        grid = cus * per_cu;
    }
    if (grid < 0) return;
    Params p{};
    p.x = (const float*)d_in[0]; p.c = (const float*)d_in[1]; p.ctx = (const float*)d_in[2]; p.c_ctx = (const float*)d_in[3];
    p.ada_w = (const float*)d_in[4]; p.ada_b = (const float*)d_in[5]; p.norm_w = (const float*)d_in[6]; p.na_w_in = (const float*)d_in[7];
    p.na_rpb = (const float*)d_in[8]; p.na_w_out = (const float*)d_in[9]; p.hg_w_in = (const float*)d_in[10]; p.hg_lower = (const float*)d_in[11];
    p.hg_norm_w = (const float*)d_in[12]; p.hg_w_out = (const float*)d_in[13]; p.final_norm_w = (const float*)d_in[14];
    p.out = (float*)d_out; p.ws = (unsigned char*)d_ws; p.ph_lo = 0; p.ph_hi = NPHASE;
    void* args[] = {&p};
    hipError_t e = hipLaunchCooperativeKernel((const void*)fwd_megakernel, dim3(grid), dim3(NTHREADS), args, LDS_BYTES, stream);
    if (e != hipSuccess) fprintf(stderr, "cooperative launch failed: %s (grid %d)\n", hipGetErrorString(e), grid);
}
```

```cpp
#include <hip/hip_runtime.h>
#include <hip/hip_cooperative_groups.h>
#include <cstdio>
#include <cstdint>
namespace cg = cooperative_groups;

typedef unsigned short bf16_t;
typedef float f32x4 __attribute__((ext_vector_type(4)));
typedef unsigned u32x4 __attribute__((ext_vector_type(4)));
typedef unsigned u32x2 __attribute__((ext_vector_type(2)));

constexpr int D = 1024, NB = 16, SEQ = 4096, CTX = 256;
constexpr int NLAT = NB * SEQ;
constexpr int NCTX = NB * CTX;
constexpr int MTOT = NLAT + NCTX;
constexpr int N0 = 4096, N1 = 5120;
constexpr float EPS = 1e-6f;
constexpr float LOG2E = 1.4426950408889634f;
constexpr float QSCALE0 = 0.125f * LOG2E;
constexpr float QSCALE1 = 0.08838834764831845f;
constexpr int NTHREADS = 512, NWAVES = 8;

constexpr size_t MiB = 1u << 20;
constexpr size_t WS_MOD = 1 * MiB;
constexpr size_t WS_LB = 1 * MiB + 512 * 1024;
constexpr size_t WS_W0T = 2 * MiB, WS_WO0T = 10 * MiB, WS_W1T = 12 * MiB, WS_WO1T = 22 * MiB;
constexpr size_t WS_X1 = 32 * MiB;
constexpr size_t WS_R1 = 304 * MiB;
constexpr size_t WS_END = 984 * MiB;
static_assert(WS_X1 + (size_t)MTOT * D * 4 <= WS_R1 && WS_R1 + (size_t)MTOT * N1 * 2 <= WS_END, "ws map");

constexpr int LDS_BYTES = 147456;

struct Params {
    const float *x, *c, *ctx, *c_ctx, *ada_w, *ada_b, *norm_w, *na_w_in, *na_rpb, *na_w_out, *hg_w_in, *hg_lower, *hg_norm_w, *hg_w_out, *final_norm_w;
    float* out; unsigned char* ws; int ph_lo, ph_hi;
};

__device__ __forceinline__ float bf2f(bf16_t v) { return __uint_as_float((unsigned)v << 16); }
__device__ __forceinline__ unsigned f2bf(float f) { unsigned u = __float_as_uint(f); return (u + 0x7fffu + ((u >> 16) & 1u)) >> 16; }
__device__ __forceinline__ unsigned pk2(float lo, float hi) { return f2bf(lo) | (f2bf(hi) << 16); }
__device__ __forceinline__ float h2f(unsigned short v) { return (float)__builtin_bit_cast(_Float16, v); }
__device__ __forceinline__ unsigned short f2h(float f) { return __builtin_bit_cast(unsigned short, (_Float16)f); }
__device__ __forceinline__ float siluf(float v) { return v / (1.f + __expf(-v)); }
__device__ __forceinline__ float wave_sum(float v) {
#pragma unroll
    for (int o = 1; o < 64; o <<= 1) v += __shfl_xor(v, o);
    return v;
}
__device__ __forceinline__ void unpack8(const u32x4 w, float* f) {
    f[0] = __uint_as_float(w.x << 16); f[1] = __uint_as_float(w.x & 0xffff0000u);
    f[2] = __uint_as_float(w.y << 16); f[3] = __uint_as_float(w.y & 0xffff0000u);
    f[4] = __uint_as_float(w.z << 16); f[5] = __uint_as_float(w.z & 0xffff0000u);
    f[6] = __uint_as_float(w.w << 16); f[7] = __uint_as_float(w.w & 0xffff0000u);
}

__device__ __forceinline__ void transpose_item(const float* W, int K, int N, bf16_t* WT, float* scr, int item, int lane) {
    const int nblk = N / 32, kb = item / nblk, nb = item % nblk, k0 = 64 * kb, n0 = 32 * nb;
#pragma unroll 8
    for (int i = 0; i < 32; ++i) { const int kk = 2 * i + (lane >> 5); scr[kk * 33 + (lane & 31)] = W[(size_t)(k0 + kk) * N + n0 + (lane & 31)]; }
    __builtin_amdgcn_wave_barrier();
    const int c = lane & 7;
#pragma unroll
    for (int j = 0; j < 4; ++j) { const int n = (lane >> 3) + 8 * j; const float* s = scr + (8 * c) * 33 + n;
        u32x4 o; o.x = pk2(s[0 * 33], s[1 * 33]); o.y = pk2(s[2 * 33], s[3 * 33]); o.z = pk2(s[4 * 33], s[5 * 33]); o.w = pk2(s[6 * 33], s[7 * 33]);
        *(u32x4*)(WT + (size_t)(n0 + n) * K + k0 + 8 * c) = o; }
    __builtin_amdgcn_wave_barrier();
}

__device__ __forceinline__ void phase_prologue(const Params& P, unsigned char* lds) {
    const int tid = threadIdx.x, lane = tid & 63, wave = tid >> 6;
    unsigned char* ws = P.ws;
    {
        float* scr = (float*)(lds) + wave * (64 * 33);
        const int gw = blockIdx.x * NWAVES + wave, NGW = gridDim.x * NWAVES;
        constexpr int I0 = (D / 64) * (N0 / 32), IO = (D / 64) * (D / 32), I1 = (D / 64) * (N1 / 32);
        constexpr int NIT = I0 + IO + I1 + IO;
        for (int it = gw; it < NIT; it += NGW) {
            int r = it;
            if (r < I0) { transpose_item(P.na_w_in, D, N0, (bf16_t*)(ws + WS_W0T), scr, r, lane); continue; } r -= I0;
            if (r < IO) { transpose_item(P.na_w_out, D, D, (bf16_t*)(ws + WS_WO0T), scr, r, lane); continue; } r -= IO;
            if (r < I1) { transpose_item(P.hg_w_in, D, N1, (bf16_t*)(ws + WS_W1T), scr, r, lane); continue; } r -= I1;
            transpose_item(P.hg_w_out, D, D, (bf16_t*)(ws + WS_WO1T), scr, r, lane);
        }
    }
    __syncthreads();
    {
        float* sc = (float*)lds;
        float* red = (float*)(lds + 17 * 1024 * 4);
        for (int e = tid; e < 17 * 1024; e += NTHREADS) { const int r = e >> 10, k = e & 1023; const float v = (r < 16) ? P.c[r * 1024 + k] : P.c_ctx[k]; sc[e] = siluf(v); }
        __syncthreads();
        float* mod = (float*)(ws + WS_MOD);
        for (int it = blockIdx.x; it < 2 * 48; it += gridDim.x) {
            const int l = it / 48, n0 = (it % 48) * 64;
            const float* W = P.ada_w + (size_t)l * 1024 * 3072 + n0 + lane;
            float acc[17];
#pragma unroll
            for (int r = 0; r < 17; ++r) acc[r] = 0.f;
            const int kb = wave * 128;
#pragma unroll 4
            for (int k = 0; k < 128; ++k) { const float w = W[(size_t)(kb + k) * 3072];
#pragma unroll
                for (int r = 0; r < 17; ++r) acc[r] += sc[r * 1024 + kb + k] * w; }
#pragma unroll
            for (int r = 0; r < 17; ++r) red[(wave * 17 + r) * 64 + lane] = acc[r];
            __syncthreads();
            for (int e = tid; e < 17 * 64; e += NTHREADS) { const int r = e >> 6, n = e & 63; float s = P.ada_b[l * 3072 + n0 + n];
#pragma unroll
                for (int w = 0; w < 8; ++w) s += red[(w * 17 + r) * 64 + n];
                mod[(size_t)(l * 17 + r) * 3072 + n0 + n] = s; }
            __syncthreads();
        }
    }
    if (blockIdx.x == gridDim.x - 1) {
        float* lb = (float*)(ws + WS_LB);
        for (int cidx = tid; cidx < 1024; cidx += NTHREADS) { const float l0 = P.hg_lower[cidx], l1 = P.hg_lower[1024 + cidx]; const float mx = fmaxf(l0, l1);
            const float e0 = __expf(l0 - mx), e1 = __expf(l1 - mx); const float p0 = e0 / (e0 + e1), p1 = e1 / (e0 + e1); lb[cidx] = (p0 + p1) - p0; }
    }
}

__device__ __forceinline__ void phase_modulate(const Params& P, int layer, const float* xlat, const float* xctx, bf16_t* H) {
    const int tid = threadIdx.x, lane = tid & 63, wave = tid >> 6;
    const int gw = blockIdx.x * NWAVES + wave, NGW = gridDim.x * NWAVES;
    const float* mod = (const float*)(P.ws + WS_MOD) + (size_t)layer * 17 * 3072;
    const float* nw = P.norm_w + layer * 1024;
    for (int row = gw; row < MTOT; row += NGW) {
        const float* src = (row < NLAT) ? xlat + (size_t)row * D : xctx + (size_t)(row - NLAT) * D;
        const int br = (row < NLAT) ? (row >> 12) : 16;
        const float* sh = mod + (size_t)br * 3072; const float* scl = sh + 1024;
        f32x4 v[4]; float ss = 0.f;
#pragma unroll
        for (int j = 0; j < 4; ++j) { v[j] = *(const f32x4*)(src + lane * 4 + 256 * j); ss += (v[j].x * v[j].x + v[j].y * v[j].y) + (v[j].z * v[j].z + v[j].w * v[j].w); }
        const float rstd = 1.f / sqrtf(wave_sum(ss) * (1.f / D) + EPS);
#pragma unroll
        for (int j = 0; j < 4; ++j) { const int c0 = lane * 4 + 256 * j; const f32x4 w = *(const f32x4*)(nw + c0), s1 = *(const f32x4*)(scl + c0), s0 = *(const f32x4*)(sh + c0);
            const f32x4 h = (v[j] * rstd) * w * (s1 + 1.f) + s0;
            u32x2 o; o.x = pk2(h.x, h.y); o.y = pk2(h.z, h.w); *(u32x2*)(H + (size_t)row * D + c0) = o; }
    }
}

template <int MODE> __device__ __forceinline__ void epi_elem(const Params& P, int row, int col, float acc) {
    unsigned char* ws = P.ws;
    if (MODE == 0) {
        bf16_t* O = (bf16_t*)(ws + WS_R1);
        O[(size_t)row * N0 + col] = (bf16_t)f2bf(col < 1024 ? acc * QSCALE0 : acc);
    } else if (MODE == 1) {
        float* X1 = (float*)(ws + WS_X1);
        const float* mod = (const float*)(ws + WS_MOD);
        const int br = (row < NLAT) ? (row >> 12) : 16;
        const float xin = (row < NLAT) ? P.x[(size_t)row * D + col] : P.ctx[(size_t)(row - NLAT) * D + col];
        X1[(size_t)row * D + col] = xin + mod[(size_t)br * 3072 + 2048 + col] * acc;
    } else if (MODE == 2) {
        bf16_t* O = (bf16_t*)(ws + WS_R1);
        const int grp = col >> 10;
        unsigned short o;
        if (grp == 0) o = (unsigned short)f2bf(siluf(acc) * QSCALE1);
        else if (grp == 2 || grp == 3) { const float lb = ((const float*)(ws + WS_LB))[col & 1023]; const float f = lb + (1.f - lb) / (1.f + __expf(-acc)); o = f2h(__log2f(f)); }
        else o = (unsigned short)f2bf(acc);
        O[(size_t)row * N1 + col] = o;
    } else {
        float* X1 = (float*)(ws + WS_X1);
        const float* mod = (const float*)(ws + WS_MOD) + (size_t)17 * 3072;
        const int br = row >> 12;
        X1[(size_t)row * D + col] += mod[(size_t)br * 3072 + 2048 + col] * acc;
    }
}

namespace pg8 {
#define PG8_LAS __attribute__((address_space(3)))
typedef unsigned short bf16_t;
typedef short bf16x8 __attribute__((ext_vector_type(8)));
typedef float f32x4 __attribute__((ext_vector_type(4)));
typedef unsigned u32x4 __attribute__((ext_vector_type(4)));
constexpr int BM = 256, BK = 64, HALF = 128, HTB = HALF * BK * 2  , STAGE_BYTES = 8 * HTB, NXCD = 8, WGM = 8;

__host__ __device__ __forceinline__ int lds_byte(int r, int c) { const int st = (r >> 4) * 2 + (c >> 5), rr = r & 15, cc = c & 31, ob = rr * 64 + cc * 2; return st * 1024 + (ob ^ (((ob >> 9) & 1) << 5)); }
__host__ __device__ __forceinline__ void stage_rc(int b, int& R, int& C) { const int st = b / 1024, sb = b % 1024, swz = sb ^ (((sb >> 9) & 1) << 5); R = (st >> 1) * 16 + swz / 64; C = (st & 1) * 32 + (swz % 64) / 2; }
__host__ __device__ __forceinline__ int perm32(int rho) { const int n = rho >> 4, i = rho & 15; return 8 * (i >> 2) + 4 * n + (i & 3); }

struct Unit { int pm, pn; };
struct Gemm { const bf16_t* A; const bf16_t* Bt; int M, N, K; };

struct StaticOrder {
    int nM, nN, nwg, G, c;
    __host__ __device__ void init(int M, int N, int G_, int c_) { nM = M / BM; nN = N / BM; nwg = nM * nN; G = G_; c = c_; }
    __host__ __device__ bool next(int i, Unit& u) const {
        const long L = (long)i * G + c; if (L >= nwg) return false;
        int wgid = (int)L; { const int q = nwg / NXCD, r = nwg % NXCD, xcd = wgid % NXCD, off = wgid / NXCD; wgid = (xcd < r ? xcd * (q + 1) : r * (q + 1) + (xcd - r) * q) + off; }
        const int nig = WGM * nN, gid = wgid / nig, fm = gid * WGM, gsz = (nM - fm) < WGM ? (nM - fm) : WGM;
        u.pm = fm + ((wgid % nig) % gsz); u.pn = (wgid % nig) / gsz; return true;
    }
    __device__ __forceinline__ void a_ready(const Unit&) const {}
    __device__ __forceinline__ void done(const Unit&) const {}
};


__device__ __forceinline__ unsigned cvt_pk_bf16(float lo, float hi) { unsigned r; asm volatile("v_cvt_pk_bf16_f32 %0, %1, %2" : "=v"(r) : "v"(lo), "v"(hi)); return r; }
__device__ __forceinline__ unsigned cvt_pk_f16(float lo, float hi) { return (unsigned)__builtin_bit_cast(unsigned short, (_Float16)lo) | ((unsigned)__builtin_bit_cast(unsigned short, (_Float16)hi) << 16); }
struct EpiQKVZ {
    static constexpr bool PERM = true, AFTER_DRAIN = false;
    bf16_t* O;
    __device__ __forceinline__ void operator()(const f32x4 (&acc)[2][2][4][2], const Unit& u, int wr, int wc, int fr, int fq) const {
        const int row0 = u.pm * BM + wr * 64 + fr, col0 = u.pn * BM + wc * 32 + 8 * fq;
        const float sc = (u.pn < 4) ? QSCALE0 : 1.f;
#pragma unroll
        for (int ai = 0; ai < 2; ++ai)
#pragma unroll
            for (int m = 0; m < 4; ++m) { bf16_t* rowp = O + (size_t)(row0 + ai * HALF + m * 16) * N0 + col0;
#pragma unroll
                for (int bj = 0; bj < 2; ++bj) { const f32x4 v0 = acc[ai][bj][m][0] * sc, v1 = acc[ai][bj][m][1] * sc;
                    u32x4 w; w.x = cvt_pk_bf16(v0[0], v0[1]); w.y = cvt_pk_bf16(v0[2], v0[3]); w.z = cvt_pk_bf16(v1[0], v1[1]); w.w = cvt_pk_bf16(v1[2], v1[3]);
                    *(u32x4*)(rowp + bj * HALF) = w; } }
    }
};
struct EpiRes {
    static constexpr bool PERM = false, AFTER_DRAIN = false;
    const float* xlat; const float* xctx; const float* mod; float* X1;
    __device__ __forceinline__ void operator()(const f32x4 (&acc)[2][2][4][2], const Unit& u, int wr, int wc, int fr, int fq) const {
        const int rowt = u.pm * BM; const bool lat = rowt < NLAT; const int br = lat ? (rowt >> 12) : 16;
        const float* src = lat ? xlat + (size_t)rowt * D : xctx + (size_t)(rowt - NLAT) * D;
        float* dst = X1 + (size_t)rowt * D;
        const int rl0 = wr * 64 + fr, col0 = u.pn * BM + wc * 32 + 4 * fq;
        f32x4 g[2][2];
#pragma unroll
        for (int bj = 0; bj < 2; ++bj)
#pragma unroll
            for (int n = 0; n < 2; ++n) g[bj][n] = *(const f32x4*)(mod + (size_t)br * 3072 + 2048 + col0 + bj * HALF + n * 16);
#pragma unroll
        for (int ai = 0; ai < 2; ++ai)
#pragma unroll
            for (int m = 0; m < 4; ++m) { const size_t off = (size_t)(rl0 + ai * HALF + m * 16) * D + col0;
#pragma unroll
                for (int bj = 0; bj < 2; ++bj)
#pragma unroll
                    for (int n = 0; n < 2; ++n) { const size_t o = off + bj * HALF + n * 16; *(f32x4*)(dst + o) = *(const f32x4*)(src + o) + g[bj][n] * acc[ai][bj][m][n]; } }
    }
};
struct EpiHG {
    static constexpr bool PERM = true, AFTER_DRAIN = false;
    unsigned short* O; const float* lb;
    __device__ __forceinline__ void operator()(const f32x4 (&acc)[2][2][4][2], const Unit& u, int wr, int wc, int fr, int fq) const {
        const int row0 = u.pm * BM + wr * 64 + fr, col0 = u.pn * BM + wc * 32 + 8 * fq;
        const int grp = u.pn >> 2;
        if (grp == 2 || grp == 3) {
#pragma unroll
            for (int bj = 0; bj < 2; ++bj) {
                const f32x4 l0 = *(const f32x4*)(lb + ((col0 + bj * HALF) & 1023)), l1 = *(const f32x4*)(lb + ((col0 + bj * HALF) & 1023) + 4);
#pragma unroll
                for (int ai = 0; ai < 2; ++ai)
#pragma unroll
                    for (int m = 0; m < 4; ++m) { unsigned short* rowp = O + (size_t)(row0 + ai * HALF + m * 16) * N1 + col0 + bj * HALF;
                        const f32x4 v0 = acc[ai][bj][m][0], v1 = acc[ai][bj][m][1]; float r[8];
#pragma unroll
                        for (int e = 0; e < 4; ++e) { const float f0 = l0[e] + (1.f - l0[e]) * __builtin_amdgcn_rcpf(1.f + __expf(-v0[e])); r[e] = __log2f(f0);
                            const float f1 = l1[e] + (1.f - l1[e]) * __builtin_amdgcn_rcpf(1.f + __expf(-v1[e])); r[4 + e] = __log2f(f1); }
                        u32x4 w; w.x = cvt_pk_f16(r[0], r[1]); w.y = cvt_pk_f16(r[2], r[3]); w.z = cvt_pk_f16(r[4], r[5]); w.w = cvt_pk_f16(r[6], r[7]);
                        *(u32x4*)rowp = w; }
            }
        } else {
#pragma unroll
            for (int ai = 0; ai < 2; ++ai)
#pragma unroll
                for (int m = 0; m < 4; ++m) { unsigned short* rowp = O + (size_t)(row0 + ai * HALF + m * 16) * N1 + col0;
#pragma unroll
                    for (int bj = 0; bj < 2; ++bj) { f32x4 v0 = acc[ai][bj][m][0], v1 = acc[ai][bj][m][1];
                        if (grp == 0) {
#pragma unroll
                            for (int e = 0; e < 4; ++e) { v0[e] = v0[e] * QSCALE1 * __builtin_amdgcn_rcpf(1.f + __expf(-v0[e])); v1[e] = v1[e] * QSCALE1 * __builtin_amdgcn_rcpf(1.f + __expf(-v1[e])); } }
                        u32x4 w; w.x = cvt_pk_bf16(v0[0], v0[1]); w.y = cvt_pk_bf16(v0[2], v0[3]); w.z = cvt_pk_bf16(v1[0], v1[1]); w.w = cvt_pk_bf16(v1[2], v1[3]);
                        *(u32x4*)(rowp + bj * HALF) = w; } }
        }
    }
};
template <class Epi, class Sched, bool ALIGN_EPI = false, bool SP2 = false>
__device__ __forceinline__ void gemm_phase(PG8_LAS unsigned char* lds, const Gemm g, const Sched& S, const Epi& E) {
    const int tid = threadIdx.x, wid = __builtin_amdgcn_readfirstlane(tid >> 6), lane = tid & 63, wr = wid >> 2, wc = wid & 3, fr = lane & 15, fq = lane >> 4;
    const int K = g.K, nt = K / BK;
    unsigned voffA[2], voffB[2];
#pragma unroll
    for (int i = 0; i < 2; ++i) { int R, C; stage_rc(tid * 16 + i * 8192, R, C); const int Rb = Epi::PERM ? ((R & ~31) + perm32(R & 31)) : R;
        voffA[i] = (unsigned)(R * K + C) * 2u; voffB[i] = (unsigned)(Rb * K + C) * 2u; }
    const size_t kstep = (size_t)(BK * 2);
    const size_t hstep = (size_t)HALF * K * 2;
    const size_t tstep = 2 * hstep;
    const unsigned ldsw = (unsigned)wid * 1024u;
    const int aoff = lds_byte(wr * 64 + fr, fq * 8), boff = lds_byte(wc * 32 + fr, fq * 8);
#define PG8_SA(b, h) (((b) * 2 + (h)) * HTB)
#define PG8_SB(b, h) ((4 + (b) * 2 + (h)) * HTB)
#define PG8_STAGE(bufoff, gbase, voff) do { _Pragma("unroll") for (int _i = 0; _i < 2; ++_i) \
        __builtin_amdgcn_global_load_lds((const unsigned*)((const char*)(gbase) + (voff)[_i]), (PG8_LAS unsigned*)(lds + (bufoff) + ldsw + _i * 8192), 16, 0, 0); } while (0)
#define PG8_LDA(dst, b, h) do { _Pragma("unroll") for (int m = 0; m < 4; ++m) _Pragma("unroll") for (int k = 0; k < 2; ++k) dst[m][k] = *(const PG8_LAS bf16x8*)(lds + PG8_SA(b, h) + aoff + m * 2048 + k * 1024); } while (0)
#define PG8_LDB(dst, b, h) do { _Pragma("unroll") for (int n = 0; n < 2; ++n) _Pragma("unroll") for (int k = 0; k < 2; ++k) dst[n][k] = *(const PG8_LAS bf16x8*)(lds + PG8_SB(b, h) + boff + n * 2048 + k * 1024); } while (0)
#define PG8_MMA(ai, bj, At, Bt) do { __builtin_amdgcn_s_setprio(1); _Pragma("unroll") for (int m = 0; m < 4; ++m) _Pragma("unroll") for (int n = 0; n < 2; ++n) _Pragma("unroll") for (int k = 0; k < 2; ++k) \
        acc[ai][bj][m][n] = __builtin_amdgcn_mfma_f32_16x16x32_bf16(Bt[n][k], At[m][k], acc[ai][bj][m][n], 0, 0, 0); __builtin_amdgcn_s_setprio(0); } while (0)
#define PG8_WAIT_V(n) asm volatile("s_waitcnt vmcnt(" #n ")" ::: "memory")
#define PG8_WAIT_L(n) asm volatile("s_waitcnt lgkmcnt(" #n ")" ::: "memory")
#define PG8_BAR __builtin_amdgcn_s_barrier()
#define PG8_SCHED __builtin_amdgcn_sched_barrier(0)
    Unit cur, nxt; int ui = 0;
    if (!S.next(0, cur)) return;
    f32x4 acc[2][2][4][2];
#pragma unroll
    for (int a = 0; a < 2; ++a)
#pragma unroll
        for (int b = 0; b < 2; ++b)
#pragma unroll
            for (int m = 0; m < 4; ++m)
#pragma unroll
                for (int n = 0; n < 2; ++n) acc[a][b][m][n] = (f32x4){0.f, 0.f, 0.f, 0.f};
    bf16x8 At[4][2], B0[2][2], B1[2][2];
    const char* cA = (const char*)g.A + (size_t)cur.pm * tstep; const char* cB = (const char*)g.Bt + (size_t)cur.pn * tstep;
    S.a_ready(cur);
    if constexpr (SP2) {
        PG8_STAGE(PG8_SB(0, 0), cB, voffB); PG8_STAGE(PG8_SB(0, 1), cB + hstep, voffB); PG8_STAGE(PG8_SA(0, 0), cA, voffA); PG8_STAGE(PG8_SA(0, 1), cA + hstep, voffA);
        if (wr == 1) PG8_BAR;
        PG8_WAIT_V(2); PG8_BAR;
        PG8_STAGE(PG8_SB(1, 0), cB + kstep, voffB); PG8_STAGE(PG8_SA(1, 0), cA + kstep, voffA); PG8_STAGE(PG8_SB(1, 1), cB + hstep + kstep, voffB);
        PG8_WAIT_V(6); PG8_BAR;
    } else {
        PG8_STAGE(PG8_SB(0, 0), cB, voffB); PG8_STAGE(PG8_SA(0, 0), cA, voffA); PG8_STAGE(PG8_SB(0, 1), cB + hstep, voffB); PG8_STAGE(PG8_SA(0, 1), cA + hstep, voffA);
        if (wr == 1) PG8_BAR;
        PG8_WAIT_V(4); PG8_BAR;
        PG8_STAGE(PG8_SB(1, 0), cB + kstep, voffB); PG8_STAGE(PG8_SA(1, 0), cA + kstep, voffA); PG8_STAGE(PG8_SB(1, 1), cB + hstep + kstep, voffB);
        PG8_WAIT_V(6); PG8_BAR;
    }
    for (;;) {
        const bool has_next = S.next(ui + 1, nxt);
        const char* nA = has_next ? (const char*)g.A + (size_t)nxt.pm * tstep : cA; const char* nB = has_next ? (const char*)g.Bt + (size_t)nxt.pn * tstep : cB;
        for (int t = 0; t < nt; t += 2) {
            const bool last = (t == nt - 2);
            const char* a1 = cA + (size_t)(t + 1) * kstep;
            const char* a2 = last ? nA : cA + (size_t)(t + 2) * kstep; const char* b2 = last ? nB : cB + (size_t)(t + 2) * kstep;
            const char* a3 = a2 + kstep; const char* b3 = b2 + kstep;
            if (last && has_next) S.a_ready(nxt);
            if constexpr (SP2) {
            PG8_LDB(B0, 0, 0); PG8_LDB(B1, 0, 1); PG8_SCHED; PG8_LDA(At, 0, 0); PG8_STAGE(PG8_SA(1, 1), a1 + hstep, voffA);
            PG8_WAIT_V(8); PG8_WAIT_L(0); PG8_BAR; PG8_MMA(0, 0, At, B0); PG8_MMA(0, 1, At, B1); PG8_BAR; PG8_SCHED;
            PG8_LDA(At, 0, 1); PG8_STAGE(PG8_SB(0, 0), b2, voffB); PG8_STAGE(PG8_SB(0, 1), b2 + hstep, voffB); PG8_STAGE(PG8_SA(0, 0), a2, voffA);
            PG8_WAIT_V(8); PG8_WAIT_L(0); PG8_BAR; PG8_MMA(1, 0, At, B0); PG8_MMA(1, 1, At, B1); PG8_BAR; PG8_SCHED;
            PG8_LDB(B0, 1, 0); PG8_LDB(B1, 1, 1); PG8_SCHED; PG8_LDA(At, 1, 0); PG8_STAGE(PG8_SA(0, 1), a2 + hstep, voffA);
            PG8_WAIT_V(8); PG8_WAIT_L(0); PG8_BAR; PG8_MMA(0, 0, At, B0); PG8_MMA(0, 1, At, B1); PG8_BAR; PG8_SCHED;
            PG8_LDA(At, 1, 1); PG8_STAGE(PG8_SB(1, 0), b3, voffB); PG8_STAGE(PG8_SB(1, 1), b3 + hstep, voffB); PG8_STAGE(PG8_SA(1, 0), a3, voffA);
            PG8_WAIT_V(8); PG8_WAIT_L(0); PG8_BAR; PG8_MMA(1, 0, At, B0); PG8_MMA(1, 1, At, B1); PG8_BAR; PG8_SCHED;
            } else {
            PG8_LDB(B0, 0, 0); PG8_SCHED; PG8_LDA(At, 0, 0); PG8_STAGE(PG8_SA(1, 1), a1 + hstep, voffA);
            PG8_WAIT_L(8); PG8_BAR; PG8_WAIT_L(0); PG8_MMA(0, 0, At, B0); PG8_BAR; PG8_SCHED;
            PG8_LDB(B1, 0, 1); PG8_STAGE(PG8_SB(0, 0), b2, voffB);
            PG8_BAR; PG8_WAIT_L(0); PG8_MMA(0, 1, At, B1); PG8_BAR;
            PG8_LDA(At, 0, 1); PG8_STAGE(PG8_SA(0, 0), a2, voffA);
            PG8_BAR; PG8_WAIT_L(0); PG8_MMA(1, 0, At, B0); PG8_BAR; PG8_SCHED;
            PG8_STAGE(PG8_SB(0, 1), b2 + hstep, voffB);
            PG8_WAIT_V(6); PG8_BAR; PG8_MMA(1, 1, At, B1); PG8_BAR;
            PG8_LDB(B0, 1, 0); PG8_SCHED; PG8_LDA(At, 1, 0); PG8_STAGE(PG8_SA(0, 1), a2 + hstep, voffA);
            PG8_WAIT_L(8); PG8_BAR; PG8_WAIT_L(0); PG8_MMA(0, 0, At, B0); PG8_BAR; PG8_SCHED;
            PG8_LDB(B1, 1, 1); PG8_STAGE(PG8_SB(1, 0), b3, voffB);
            PG8_BAR; PG8_WAIT_L(0); PG8_MMA(0, 1, At, B1); PG8_BAR;
            PG8_LDA(At, 1, 1); PG8_STAGE(PG8_SA(1, 0), a3, voffA);
            PG8_BAR; PG8_WAIT_L(0); PG8_MMA(1, 0, At, B0); PG8_BAR; PG8_SCHED;
            PG8_STAGE(PG8_SB(1, 1), b3 + hstep, voffB);
            PG8_WAIT_V(6); PG8_BAR; PG8_MMA(1, 1, At, B1); PG8_BAR;
            }
        }
        if constexpr (ALIGN_EPI) { if (wr == 0) PG8_BAR; }
        if constexpr (!Epi::AFTER_DRAIN) { E(acc, cur, wr, wc, fr, fq); S.done(cur); }
        if (!has_next) break;
#pragma unroll
        for (int a = 0; a < 2; ++a)
#pragma unroll
            for (int b = 0; b < 2; ++b)
#pragma unroll
                for (int m = 0; m < 4; ++m)
#pragma unroll
                    for (int n = 0; n < 2; ++n) acc[a][b][m][n] = (f32x4){0.f, 0.f, 0.f, 0.f};
        cur = nxt; cA = nA; cB = nB; ++ui;
        if constexpr (ALIGN_EPI) { if (wr == 1) PG8_BAR; }
    }
    PG8_WAIT_V(0);
    if constexpr (!ALIGN_EPI) { if (wr == 0) PG8_BAR; }
    PG8_BAR;
    if constexpr (Epi::AFTER_DRAIN) { E.fused(acc, cur, wr, wc, fr, fq, lds, wid, lane); S.done(cur); }
#undef PG8_SA
#undef PG8_SB
#undef PG8_STAGE
#undef PG8_LDA
#undef PG8_LDB
#undef PG8_MMA
#undef PG8_WAIT_V
#undef PG8_WAIT_L
#undef PG8_BAR
#undef PG8_SCHED
}
}

template <int MODE> __device__ __forceinline__ void gemm_naive(const Params& P, const bf16_t* A, const bf16_t* Bt, int M, int N, int K, unsigned char* lds) {
    float* As = (float*)lds;
    float* Bs = As + 32 * 132;
    const int tid = threadIdx.x, ty = tid >> 5, tx = tid & 31;
    const int nTn = N / 128, ntiles = (M / 128) * nTn;
    for (int t = blockIdx.x; t < ntiles; t += gridDim.x) {
        const int tm = t / nTn, tn = t % nTn;
        float acc[8][4];
#pragma unroll
        for (int i = 0; i < 8; ++i)
#pragma unroll
            for (int j = 0; j < 4; ++j) acc[i][j] = 0.f;
        for (int k0 = 0; k0 < K; k0 += 32) {
            {
                const int r = tid >> 2, kc = (tid & 3) * 8;
                float f[8];
                unpack8(*(const u32x4*)(A + (size_t)(tm * 128 + r) * K + k0 + kc), f);
#pragma unroll
                for (int i = 0; i < 8; ++i) As[(kc + i) * 132 + r] = f[i];
                unpack8(*(const u32x4*)(Bt + (size_t)(tn * 128 + r) * K + k0 + kc), f);
#pragma unroll
                for (int i = 0; i < 8; ++i) Bs[(kc + i) * 132 + r] = f[i];
            }
            __syncthreads();
#pragma unroll 8
            for (int k = 0; k < 32; ++k) {
                const f32x4 a0 = *(const f32x4*)(As + k * 132 + ty * 8), a1 = *(const f32x4*)(As + k * 132 + ty * 8 + 4), b = *(const f32x4*)(Bs + k * 132 + tx * 4);
                const float a[8] = {a0.x, a0.y, a0.z, a0.w, a1.x, a1.y, a1.z, a1.w}; const float bb[4] = {b.x, b.y, b.z, b.w};
#pragma unroll
                for (int i = 0; i < 8; ++i)
#pragma unroll
                    for (int j = 0; j < 4; ++j) acc[i][j] += a[i] * bb[j];
            }
            __syncthreads();
        }
#pragma unroll
        for (int i = 0; i < 8; ++i)
#pragma unroll
            for (int j = 0; j < 4; ++j) epi_elem<MODE>(P, tm * 128 + ty * 8 + i, tn * 128 + tx * 4 + j, acc[i][j]);
    }
}

__device__ __forceinline__ void phase_na_naive(const Params& P, unsigned char* lds, bf16_t* Y) {
    const int tid = threadIdx.x, lane = tid & 63, wave = tid >> 6;
    float* rpbL = (float*)lds;
    for (int e = tid; e < 16 * 15 * 31; e += NTHREADS) rpbL[e] = P.na_rpb[e] * LOG2E;
    __syncthreads();
    const bf16_t* R = (const bf16_t*)(P.ws + WS_R1);
    const int gw = blockIdx.x * NWAVES + wave, NGW = gridDim.x * NWAVES;
    for (int u = gw; u < 16384 + 1024; u += NGW) {
        int b, h, r = 0, qtok, nloc, r0 = 0, cs = 0;
        if (u < 16384) { r = u & 63; h = (u >> 6) & 15; b = u >> 10; qtok = b * SEQ + r * 64 + lane; nloc = 128;
            r0 = min(max(r - 4, 0), 56); cs = min(max(lane - 8, 0), 48); }
        else { const int v = u - 16384; const int qb = v & 3; h = (v >> 2) & 15; b = v >> 6; qtok = NLAT + b * CTX + qb * 64 + lane; nloc = 0; }
        float q[64], O[64];
        {
            const bf16_t* qp = R + (size_t)qtok * N0 + h * 64;
#pragma unroll
            for (int i = 0; i < 8; ++i) unpack8(*(const u32x4*)(qp + 8 * i), q + 8 * i);
        }
#pragma unroll
        for (int d = 0; d < 64; ++d) O[d] = 0.f;
        float m = -1e30f, l = 0.f;
        const int nk = nloc + CTX;
        for (int kk = 0; kk < nk; ++kk) {
            int ktok; float s;
            if (kk < nloc) { const int kr = kk >> 4, j = kk & 15; ktok = b * SEQ + (r0 + kr) * 64 + cs + j; s = rpbL[h * 465 + (r0 + kr - r + 7) * 31 + (cs + j - lane + 15)]; }
            else { ktok = NLAT + b * CTX + (kk - nloc); s = 0.f; }
            const bf16_t* kp = R + (size_t)ktok * N0 + 1024 + h * 64;
#pragma unroll
            for (int i = 0; i < 8; ++i) { float f[8]; unpack8(*(const u32x4*)(kp + 8 * i), f);
#pragma unroll
                for (int j2 = 0; j2 < 8; ++j2) s += q[8 * i + j2] * f[j2]; }
            const float mn = fmaxf(m, s), alpha = exp2f(m - mn), p = exp2f(s - mn);
            l = l * alpha + p; m = mn;
            const bf16_t* vp = kp + 1024;
#pragma unroll
            for (int i = 0; i < 8; ++i) { float f[8]; unpack8(*(const u32x4*)(vp + 8 * i), f);
#pragma unroll
                for (int j2 = 0; j2 < 8; ++j2) O[8 * i + j2] = O[8 * i + j2] * alpha + p * f[j2]; }
        }
        const float rl = 1.f / l;
        const bf16_t* zp = R + (size_t)qtok * N0 + 3072 + h * 64;
        bf16_t* yp = Y + (size_t)qtok * D + h * 64;
#pragma unroll
        for (int i = 0; i < 8; ++i) { float z[8]; unpack8(*(const u32x4*)(zp + 8 * i), z);
            u32x4 o;
            o.x = pk2(O[8 * i + 0] * rl * siluf(z[0]), O[8 * i + 1] * rl * siluf(z[1]));
            o.y = pk2(O[8 * i + 2] * rl * siluf(z[2]), O[8 * i + 3] * rl * siluf(z[3]));
            o.z = pk2(O[8 * i + 4] * rl * siluf(z[4]), O[8 * i + 5] * rl * siluf(z[5]));
            o.w = pk2(O[8 * i + 6] * rl * siluf(z[6]), O[8 * i + 7] * rl * siluf(z[7]));
            *(u32x4*)(yp + 8 * i) = o; }
    }
}


typedef short bf16x8 __attribute__((ext_vector_type(8)));
typedef short v4i16 __attribute__((ext_vector_type(4)));
#define LAS __attribute__((address_space(3)))
__device__ __forceinline__ unsigned cvtpk(float lo, float hi) { unsigned r; asm("v_cvt_pk_bf16_f32 %0, %1, %2" : "=v"(r) : "v"(lo), "v"(hi)); return r; }
__device__ __forceinline__ f32x4 mfma16(bf16x8 a, bf16x8 b, f32x4 c) { return __builtin_amdgcn_mfma_f32_16x16x32_bf16(a, b, c, 0, 0, 0); }
__device__ __forceinline__ bf16x8 pack8(const f32x4 a, const f32x4 b) { u32x4 w; w.x = cvtpk(a[0], a[1]); w.y = cvtpk(a[2], a[3]); w.z = cvtpk(b[0], b[1]); w.w = cvtpk(b[2], b[3]); return __builtin_bit_cast(bf16x8, w); }

template <bool LOCAL, int HF>
__device__ __forceinline__ void na_scores(const bf16x8 (&Kf)[2][2], const bf16x8 (&qf)[4][2], f32x4 (&O)[4][4], float (&m)[4], float (&l)[4], bf16x8 (&pb)[4],
                                          const LAS float* rpbrow, int l16, int q4) {
#pragma unroll
    for (int tb = 0; tb < 4; ++tb) {
        const bool tb_act = !LOCAL || (HF == 0 ? tb <= 2 : tb >= 1);
        if (tb_act) {
            f32x4 s[2];
            const int qc = 16 * tb + l16, cs = min(max(qc - 8, 0), 48);
            float mx = -1e30f;
#pragma unroll
            for (int k2 = 0; k2 < 2; ++k2) {
                const int kb = 2 * HF + k2;
                const bool act = !LOCAL || (kb - tb <= 1 && tb - kb <= 1);
                if (act) {
                    f32x4 a = {0.f, 0.f, 0.f, 0.f};
                    a = mfma16(Kf[k2][0], qf[tb][0], a); a = mfma16(Kf[k2][1], qf[tb][1], a);
                    if (LOCAL) {
#pragma unroll
                        for (int e = 0; e < 4; ++e) { const int kc = 16 * kb + 4 * q4 + e; const bool valid = (unsigned)(kc - cs) < 16u;
                            const int idx = kc - qc + 15; const float bias = rpbrow[min(max(idx, 0), 30)];
                            a[e] = valid ? a[e] + bias : -1e30f; }
                    }
                    s[k2] = a; mx = fmaxf(mx, fmaxf(fmaxf(a[0], a[1]), fmaxf(a[2], a[3])));
                } else s[k2] = (f32x4){-1e30f, -1e30f, -1e30f, -1e30f};
            }
            mx = fmaxf(mx, __shfl_xor(mx, 16)); mx = fmaxf(mx, __shfl_xor(mx, 32));
            const float mn = fmaxf(m[tb], mx), alpha = __builtin_amdgcn_exp2f(m[tb] - mn); m[tb] = mn;
            float ps = 0.f;
#pragma unroll
            for (int k2 = 0; k2 < 2; ++k2)
#pragma unroll
                for (int e = 0; e < 4; ++e) { const float p = __builtin_amdgcn_exp2f(s[k2][e] - mn); s[k2][e] = p; ps += p; }
            l[tb] = l[tb] * alpha + ps;
#pragma unroll
            for (int db = 0; db < 4; ++db) O[db][tb] *= alpha;
            pb[tb] = pack8(s[0], s[1]);
        }
        __builtin_amdgcn_sched_barrier(0);
    }
}
template <bool LOCAL, int HF>
__device__ __forceinline__ void na_pv(const bf16x8 (&Vf)[4], const bf16x8 (&pb)[4], f32x4 (&O)[4][4]) {
#pragma unroll
    for (int tb = 0; tb < 4; ++tb) {
        const bool tb_act = !LOCAL || (HF == 0 ? tb <= 2 : tb >= 1);
        if (tb_act) {
#pragma unroll
            for (int db = 0; db < 4; ++db) O[db][tb] = mfma16(Vf[db], pb[tb], O[db][tb]);
        }
    }
}

__device__ __forceinline__ void phase_na_mfma(const Params& P, unsigned char* lds_, bf16_t* Y) {
    LAS unsigned char* lds = (LAS unsigned char*)lds_;
    const int tid = threadIdx.x, lane = tid & 63, l16 = lane & 15, q4 = lane >> 4;
    const int wave = __builtin_amdgcn_readfirstlane(tid >> 6);
    LAS float* rpbL = (LAS float*)lds;
    LAS unsigned char* Kt = lds + 2048 + wave * 16384;
    LAS unsigned char* Vt = Kt + 8192;
    const char* R = (const char*)(P.ws + WS_R1);
    const unsigned rowoff = (unsigned)(lane >> 3) * (N0 * 2);
    const unsigned kofs_e = rowoff + (unsigned)(((lane & 7) ^ (lane >> 4)) * 16), kofs_o = rowoff + (unsigned)(((lane & 7) ^ (4 + (lane >> 4))) * 16);
    const unsigned vofs = rowoff + (unsigned)((((((lane & 7) >> 1) ^ (lane >> 4)) & 3) << 1 | (lane & 1)) * 16);
    int koff[2];
#pragma unroll
    for (int ks = 0; ks < 2; ++ks) koff[ks] = l16 * 128 + (((4 * ks + q4) ^ ((l16 >> 1) & 7)) * 16);
    const int vrow = 4 * q4 + (l16 >> 2), vsw = (2 * (q4 & 1) + (l16 >> 3)) & 3;
    int voff[4];
#pragma unroll
    for (int db = 0; db < 4; ++db) voff[db] = vrow * 128 + ((db ^ vsw) * 32) + (l16 & 3) * 8;
    const int NITEM = 2048 + 128;
    for (int it = blockIdx.x; it < NITEM; it += gridDim.x) {
        int b, h, r = 0, r0 = 0, nloc, qtok0;
        if (it < 2048) { const int rg = it & 7; h = (it >> 3) & 15; b = it >> 7; r = rg * 8 + wave; r0 = min(max(r - 4, 0), 56); nloc = 8; qtok0 = b * SEQ + r * 64;
            __syncthreads();
            for (int e = tid; e < 465; e += NTHREADS) rpbL[e] = P.na_rpb[h * 465 + e] * LOG2E;
            __syncthreads();
        } else { const int v = it - 2048; b = v >> 3; h = (v & 7) * 2 + (wave >> 2); nloc = 0; qtok0 = NLAT + b * CTX + (wave & 3) * 64; }
        const int nt = nloc + 4;
        const char* kbase = R + (size_t)(1024 + h * 64) * 2;
        auto tile_tok = [&](int j) { return (j < nloc) ? (b * SEQ + (r0 + j) * 64) : (NLAT + b * CTX + (j - nloc) * 64); };
#define NA_DMA_K(j) do { const char* kp_ = kbase + (size_t)tile_tok(j) * (N0 * 2); \
        _Pragma("unroll") for (int i_ = 0; i_ < 8; ++i_) \
            __builtin_amdgcn_global_load_lds((const unsigned*)(kp_ + (size_t)i_ * 8 * N0 * 2 + ((i_ & 1) ? kofs_o : kofs_e)), (LAS unsigned*)(Kt + i_ * 1024), 16, 0, 0); } while (0)
#define NA_DMA_V(j) do { const char* kp_ = kbase + (size_t)tile_tok(j) * (N0 * 2); \
        _Pragma("unroll") for (int i_ = 0; i_ < 8; ++i_) \
            __builtin_amdgcn_global_load_lds((const unsigned*)(kp_ + 2048 + (size_t)i_ * 8 * N0 * 2 + vofs), (LAS unsigned*)(Vt + i_ * 1024), 16, 0, 0); } while (0)
        bf16x8 qf[4][2];
        {
            const bf16_t* qp = (const bf16_t*)R + (size_t)(qtok0 + l16) * N0 + h * 64 + 8 * q4;
#pragma unroll
            for (int tb = 0; tb < 4; ++tb)
#pragma unroll
                for (int ks = 0; ks < 2; ++ks) qf[tb][ks] = *(const bf16x8*)(qp + (size_t)tb * 16 * N0 + 32 * ks);
        }
        NA_DMA_K(0); NA_DMA_V(0);
        f32x4 O[4][4]; float m[4], l[4];
#pragma unroll
        for (int tb = 0; tb < 4; ++tb) { m[tb] = -1e30f; l[tb] = 0.f;
#pragma unroll
            for (int db = 0; db < 4; ++db) O[db][tb] = (f32x4){0.f, 0.f, 0.f, 0.f}; }
        for (int j = 0; j < nt; ++j) {
            const bool more = (j + 1 < nt);
            const LAS float* rpbrow = rpbL + (r0 + j - r + 7) * 31;
            int l16v = l16, q4v = q4; asm volatile("" : "+v"(l16v), "+v"(q4v));
#define NA_HALF(HF) do { \
            bf16x8 pb[4]; \
            { bf16x8 Kf[2][2]; \
              _Pragma("unroll") for (int k2 = 0; k2 < 2; ++k2) _Pragma("unroll") for (int ks = 0; ks < 2; ++ks) Kf[k2][ks] = *(const LAS bf16x8*)(Kt + (2 * HF + k2) * 2048 + koff[ks]); \
              asm volatile("s_waitcnt lgkmcnt(0)" ::: "memory"); \
              if (HF == 1 && more) NA_DMA_K(j + 1); \
              if (j < nloc) na_scores<true, HF>(Kf, qf, O, m, l, pb, rpbrow, l16v, q4v); else na_scores<false, HF>(Kf, qf, O, m, l, pb, rpbrow, l16v, q4v); } \
            if (HF == 0) { asm volatile("s_waitcnt vmcnt(0)" ::: "memory"); } \
            { bf16x8 Vf[4]; \
              _Pragma("unroll") for (int db = 0; db < 4; ++db) { \
                    const v4i16 lo = __builtin_amdgcn_ds_read_tr16_b64_v4i16((LAS v4i16*)(Vt + (2 * HF) * 2048 + voff[db])); \
                    const v4i16 hi = __builtin_amdgcn_ds_read_tr16_b64_v4i16((LAS v4i16*)(Vt + (2 * HF + 1) * 2048 + voff[db])); \
                    Vf[db] = __builtin_shufflevector(lo, hi, 0, 1, 2, 3, 4, 5, 6, 7); } \
              asm volatile("s_waitcnt lgkmcnt(0)" ::: "memory"); \
              if (HF == 1 && more) NA_DMA_V(j + 1); \
              if (j < nloc) na_pv<true, HF>(Vf, pb, O); else na_pv<false, HF>(Vf, pb, O); } } while (0)
            if (j == 0) asm volatile("s_waitcnt vmcnt(0)" ::: "memory"); else asm volatile("s_waitcnt vmcnt(8)" ::: "memory");
            NA_HALF(0);
            NA_HALF(1);
#undef NA_HALF
        }
#undef NA_DMA_K
#undef NA_DMA_V

#pragma unroll
        for (int tb = 0; tb < 4; ++tb) {
            float lt = l[tb]; lt += __shfl_xor(lt, 16); lt += __shfl_xor(lt, 32);
            const float rl = 1.f / lt;
            const size_t tok = (size_t)(qtok0 + 16 * tb + l16);
#pragma unroll
            for (int db = 0; db < 4; ++db) {
                const int col = h * 64 + 16 * db + 4 * q4;
                const u32x2 zz = *(const u32x2*)((const bf16_t*)R + tok * N0 + 3072 + col);
                const float z0 = __uint_as_float(zz.x << 16), z1 = __uint_as_float(zz.x & 0xffff0000u), z2 = __uint_as_float(zz.y << 16), z3 = __uint_as_float(zz.y & 0xffff0000u);
                const f32x4 o = O[db][tb] * rl;
                u32x2 w; w.x = cvtpk(o[0] * siluf(z0), o[1] * siluf(z1)); w.y = cvtpk(o[2] * siluf(z2), o[3] * siluf(z3));
                *(u32x2*)(Y + tok * D + col) = w; }
        }
    }
}

__device__ __forceinline__ void phase_hgrn_naive(const Params& P, unsigned char* lds, bf16_t* OF, bf16_t* OB) {
    const int tid = threadIdx.x, lane = tid & 63, wave = tid >> 6, l16 = lane & 15, q4 = lane >> 4;
    float* fT = (float*)lds;
    float* kT = fT + 32 * 128; float* qT = kT + 32 * 128; float* vT = qT + 32 * 128; float* oT = vT + 32 * 128;
    const unsigned short* R = (const unsigned short*)(P.ws + WS_R1);
    for (int it = blockIdx.x; it < 256; it += gridDim.x) {
        const int b = it >> 4, h = (it >> 1) & 7, dir = it & 1;
        bf16_t* Odst = dir ? OB : OF;
        float S[32];
#pragma unroll
        for (int i = 0; i < 32; ++i) S[i] = 0.f;
        for (int ci = 0; ci < 8 + 128; ++ci) {
            const bool is_ctx = ci < 8;
            const int len = is_ctx ? CTX : SEQ, sp0 = is_ctx ? ci * 32 : (ci - 8) * 32;
            const size_t rowbase = is_ctx ? (size_t)(NLAT + b * CTX) : (size_t)b * SEQ;
#pragma unroll
            for (int j = 0; j < 8; ++j) {
                const int e = tid + NTHREADS * j, p = e >> 7, c = e & 127;
                const int sp = sp0 + p, ti = dir ? (len - 1 - sp) : sp;
                const unsigned short* rp = R + (rowbase + ti) * N1 + h * 128 + c;
                const float lf2 = h2f(rp[(2 + dir) * 1024]);
                fT[e] = exp2f(lf2); kT[e] = -expm1f(lf2 * 0.6931471805599453f);
                vT[e] = bf2f(rp[1024]); qT[e] = is_ctx ? 0.f : bf2f(rp[0]);
            }
            __syncthreads();
            for (int t = 0; t < 32; ++t) {
                const float v = vT[t * 128 + wave * 16 + l16];
                float o = 0.f;
#pragma unroll
                for (int i4 = 0; i4 < 8; ++i4) {
                    const f32x4 f = *(const f32x4*)(fT + t * 128 + q4 * 32 + i4 * 4), k = *(const f32x4*)(kT + t * 128 + q4 * 32 + i4 * 4), qq = *(const f32x4*)(qT + t * 128 + q4 * 32 + i4 * 4);
                    S[i4 * 4 + 0] = f.x * S[i4 * 4 + 0] + k.x * v; o += S[i4 * 4 + 0] * qq.x;
                    S[i4 * 4 + 1] = f.y * S[i4 * 4 + 1] + k.y * v; o += S[i4 * 4 + 1] * qq.y;
                    S[i4 * 4 + 2] = f.z * S[i4 * 4 + 2] + k.z * v; o += S[i4 * 4 + 2] * qq.z;
                    S[i4 * 4 + 3] = f.w * S[i4 * 4 + 3] + k.w * v; o += S[i4 * 4 + 3] * qq.w;
                }
                o += __shfl_xor(o, 16); o += __shfl_xor(o, 32);
                if (q4 == 0) oT[t * 128 + wave * 16 + l16] = o;
            }
            __syncthreads();
            if (!is_ctx) {
#pragma unroll
                for (int j = 0; j < 8; ++j) {
                    const int e = tid + NTHREADS * j, p = e >> 7, c = e & 127;
                    const int sp = sp0 + p, ti = dir ? (len - 1 - sp) : sp;
                    Odst[(rowbase + ti) * D + h * 128 + c] = (bf16_t)f2bf(oT[e]);
                }
            }
        }
        __syncthreads();
    }
}

__device__ __forceinline__ void phase_readout(const Params& P, bf16_t* OF, const bf16_t* OB) {
    const int tid = threadIdx.x, lane = tid & 63, wave = tid >> 6;
    const int gw = blockIdx.x * NWAVES + wave, NGW = gridDim.x * NWAVES;
    const bf16_t* R = (const bf16_t*)(P.ws + WS_R1);
    float hw[16];
#pragma unroll
    for (int i = 0; i < 16; ++i) hw[i] = P.hg_norm_w[(lane * 16 + i) & 127];
    for (int row = gw; row < NLAT; row += NGW) {
        float o[16], g[16], t[8];
        unpack8(*(const u32x4*)(OF + (size_t)row * D + lane * 16), o); unpack8(*(const u32x4*)(OF + (size_t)row * D + lane * 16 + 8), o + 8);
        unpack8(*(const u32x4*)(OB + (size_t)row * D + lane * 16), t);
#pragma unroll
        for (int i = 0; i < 8; ++i) o[i] += t[i];
        unpack8(*(const u32x4*)(OB + (size_t)row * D + lane * 16 + 8), t);
#pragma unroll
        for (int i = 0; i < 8; ++i) o[8 + i] += t[i];
        unpack8(*(const u32x4*)(R + (size_t)row * N1 + 4096 + lane * 16), g); unpack8(*(const u32x4*)(R + (size_t)row * N1 + 4096 + lane * 16 + 8), g + 8);
        float ss = 0.f;
#pragma unroll
        for (int i = 0; i < 16; ++i) ss += o[i] * o[i];
        ss += __shfl_xor(ss, 1); ss += __shfl_xor(ss, 2); ss += __shfl_xor(ss, 4);
        const float rstd = 1.f / sqrtf(ss * (1.f / 128.f) + EPS);
        float y[16];
#pragma unroll
        for (int i = 0; i < 16; ++i) y[i] = o[i] * rstd * hw[i] * siluf(g[i]);
        u32x4 w0, w1;
        w0.x = pk2(y[0], y[1]); w0.y = pk2(y[2], y[3]); w0.z = pk2(y[4], y[5]); w0.w = pk2(y[6], y[7]);
        w1.x = pk2(y[8], y[9]); w1.y = pk2(y[10], y[11]); w1.z = pk2(y[12], y[13]); w1.w = pk2(y[14], y[15]);
        *(u32x4*)(OF + (size_t)row * D + lane * 16) = w0; *(u32x4*)(OF + (size_t)row * D + lane * 16 + 8) = w1;
    }
}

__device__ __forceinline__ void phase_final(const Params& P) {
    const int tid = threadIdx.x, lane = tid & 63, wave = tid >> 6;
    const int gw = blockIdx.x * NWAVES + wave, NGW = gridDim.x * NWAVES;
    const float* X1 = (const float*)(P.ws + WS_X1);
    for (int row = gw; row < NLAT; row += NGW) {
        f32x4 v[4]; float ss = 0.f;
#pragma unroll
        for (int j = 0; j < 4; ++j) { v[j] = *(const f32x4*)(X1 + (size_t)row * D + lane * 4 + 256 * j); ss += (v[j].x * v[j].x + v[j].y * v[j].y) + (v[j].z * v[j].z + v[j].w * v[j].w); }
        const float rstd = 1.f / sqrtf(wave_sum(ss) * (1.f / D) + EPS);
#pragma unroll
        for (int j = 0; j < 4; ++j) { const f32x4 w = *(const f32x4*)(P.final_norm_w + lane * 4 + 256 * j); *(f32x4*)(P.out + (size_t)row * D + lane * 4 + 256 * j) = (v[j] * rstd) * w; }
    }
}

constexpr int NPHASE = 11;
__global__ void __launch_bounds__(NTHREADS, 2) fwd_megakernel(Params P) {
    extern __shared__ __attribute__((aligned(16))) unsigned char lds[];
    cg::grid_group grid = cg::this_grid();
    unsigned char* ws = P.ws;
    bf16_t* H = (bf16_t*)P.out;
    bf16_t* OF = (bf16_t*)P.out;
    bf16_t* OB = (bf16_t*)P.out + (size_t)NLAT * D;
    float* X1 = (float*)(ws + WS_X1);
    const int lo = P.ph_lo, hi = P.ph_hi;
#define IN(k) (lo <= (k) && (k) < hi)
#define SEAM(k) do { if (IN(k) && IN((k) + 1)) grid.sync(); } while (0)
    if (IN(0)) phase_prologue(P, lds);
    SEAM(0);
    if (IN(1)) phase_modulate(P, 0, P.x, P.ctx, H);
    SEAM(1);
    if (IN(2)) { pg8::Gemm g{H, (const bf16_t*)(ws + WS_W0T), MTOT, N0, D}; pg8::StaticOrder S; S.init(MTOT, N0, (int)gridDim.x, (int)blockIdx.x);
        pg8::EpiQKVZ E{(bf16_t*)(ws + WS_R1)}; pg8::gemm_phase<pg8::EpiQKVZ, pg8::StaticOrder, true, true>((PG8_LAS unsigned char*)lds, g, S, E); }
    SEAM(2);
    if (IN(3)) phase_na_mfma(P, lds, H);
    SEAM(3);
    if (IN(4)) { pg8::Gemm g{H, (const bf16_t*)(ws + WS_WO0T), MTOT, D, D}; pg8::StaticOrder S; S.init(MTOT, D, (int)gridDim.x, (int)blockIdx.x);
        pg8::EpiRes E{P.x, P.ctx, (const float*)(ws + WS_MOD), X1}; pg8::gemm_phase<pg8::EpiRes, pg8::StaticOrder, true, true>((PG8_LAS unsigned char*)lds, g, S, E); }
    SEAM(4);
    if (IN(5)) phase_modulate(P, 1, X1, X1 + (size_t)NLAT * D, H);
    SEAM(5);
    if (IN(6)) { pg8::Gemm g{H, (const bf16_t*)(ws + WS_W1T), MTOT, N1, D}; pg8::StaticOrder S; S.init(MTOT, N1, (int)gridDim.x, (int)blockIdx.x);
        pg8::EpiHG E{(unsigned short*)(ws + WS_R1), (const float*)(ws + WS_LB)}; pg8::gemm_phase<pg8::EpiHG, pg8::StaticOrder, true, true>((PG8_LAS unsigned char*)lds, g, S, E); }
    SEAM(6);
    if (IN(7)) phase_hgrn_naive(P, lds, OF, OB);
    SEAM(7);
    if (IN(8)) phase_readout(P, OF, OB);
    SEAM(8);
    if (IN(9)) { pg8::Gemm g{OF, (const bf16_t*)(ws + WS_WO1T), NLAT, D, D}; pg8::StaticOrder S; S.init(NLAT, D, (int)gridDim.x, (int)blockIdx.x);
        pg8::EpiRes E{X1, X1 + (size_t)NLAT * D, (const float*)(ws + WS_MOD) + 17 * 3072, X1}; pg8::gemm_phase<pg8::EpiRes, pg8::StaticOrder, true, true>((PG8_LAS unsigned char*)lds, g, S, E); }
    SEAM(9);
    if (IN(10)) phase_final(P);
#undef IN
#undef SEAM
}

extern "C" void kernel_launch(void* const* d_in, const int* in_sizes, int n_in, void* d_out, int out_size, void* d_ws, size_t ws_size, hipStream_t stream) {
    static int grid = 0;
    if (grid == 0) {
        if (n_in != 15 || out_size != NLAT * D || ws_size < WS_END) { fprintf(stderr, "kernel_launch: unexpected sizes n_in %d out %d ws %zu\n", n_in, out_size, ws_size); grid = -1; return; }
        int dev = 0, cus = 0, per_cu = 0;
        (void)hipGetDevice(&dev);
        (void)hipDeviceGetAttribute(&cus, hipDeviceAttributeMultiprocessorCount, dev);
        (void)hipFuncSetAttribute((const void*)fwd_megakernel, hipFuncAttributeMaxDynamicSharedMemorySize, LDS_BYTES);
        (void)hipOccupancyMaxActiveBlocksPerMultiprocessor(&per_cu, (const void*)fwd_megakernel, NTHREADS, LDS_BYTES);
        if (per_cu < 1) per_cu = 1;
        (void)hipGetLastError();
        grid = cus * per_cu;
    }
    if (grid < 0) return;
    Params p{};
    p.x = (const float*)d_in[0]; p.c = (const float*)d_in[1]; p.ctx = (const float*)d_in[2]; p.c_ctx = (const float*)d_in[3];
    p.ada_w = (const float*)d_in[4]; p.ada_b = (const float*)d_in[5]; p.norm_w = (const float*)d_in[6]; p.na_w_in = (const float*)d_in[7];
    p.na_rpb = (const float*)d_in[8]; p.na_w_out = (const float*)d_in[9]; p.hg_w_in = (const float*)d_in[10]; p.hg_lower = (const float*)d_in[11];
    p.hg_norm_w = (const float*)d_in[12]; p.hg_w_out = (const float*)d_in[13]; p.final_norm_w = (const float*)d_in[14];
    p.out = (float*)d_out; p.ws = (unsigned char*)d_ws; p.ph_lo = 0; p.ph_hi = NPHASE;
    void* args[] = {&p};
    hipError_t e = hipLaunchCooperativeKernel((const void*)fwd_megakernel, dim3(grid), dim3(NTHREADS), args, LDS_BYTES, stream);
    if (e != hipSuccess) fprintf(stderr, "cooperative launch failed: %s (grid %d)\n", hipGetErrorString(e), grid);
}
```

```cpp
#include <hip/hip_runtime.h>
#include <hip/hip_cooperative_groups.h>
#include <cstdio>
#include <cstdint>
namespace cg = cooperative_groups;

typedef unsigned short bf16_t;
typedef float f32x4 __attribute__((ext_vector_type(4)));
typedef unsigned u32x4 __attribute__((ext_vector_type(4)));
typedef unsigned u32x2 __attribute__((ext_vector_type(2)));

constexpr int D = 1024, NB = 16, SEQ = 4096, CTX = 256;
constexpr int NLAT = NB * SEQ;
constexpr int NCTX = NB * CTX;
constexpr int MTOT = NLAT + NCTX;
constexpr int N0 = 4096, N1 = 5120;
constexpr float EPS = 1e-6f;
constexpr float LOG2E = 1.4426950408889634f;
constexpr float QSCALE0 = 0.125f * LOG2E;
constexpr float QSCALE1 = 0.08838834764831845f;
constexpr int NTHREADS = 512, NWAVES = 8;

constexpr size_t MiB = 1u << 20;
constexpr size_t WS_MOD = 1 * MiB;
constexpr size_t WS_LB = 1 * MiB + 512 * 1024;
constexpr size_t WS_W0T = 2 * MiB, WS_WO0T = 10 * MiB, WS_W1T = 12 * MiB, WS_WO1T = 22 * MiB;
constexpr size_t WS_X1 = 32 * MiB;
constexpr size_t WS_R1 = 304 * MiB;
constexpr size_t WS_END = 984 * MiB;
static_assert(WS_X1 + (size_t)MTOT * D * 4 <= WS_R1 && WS_R1 + (size_t)MTOT * N1 * 2 <= WS_END, "ws map");

constexpr int LDS_BYTES = 147456;

struct Params {
    const float *x, *c, *ctx, *c_ctx, *ada_w, *ada_b, *norm_w, *na_w_in, *na_rpb, *na_w_out, *hg_w_in, *hg_lower, *hg_norm_w, *hg_w_out, *final_norm_w;
    float* out; unsigned char* ws; int ph_lo, ph_hi;
};

__device__ __forceinline__ float bf2f(bf16_t v) { return __uint_as_float((unsigned)v << 16); }
__device__ __forceinline__ unsigned f2bf(float f) { unsigned u = __float_as_uint(f); return (u + 0x7fffu + ((u >> 16) & 1u)) >> 16; }
__device__ __forceinline__ unsigned pk2(float lo, float hi) { return f2bf(lo) | (f2bf(hi) << 16); }
__device__ __forceinline__ float h2f(unsigned short v) { return (float)__builtin_bit_cast(_Float16, v); }
__device__ __forceinline__ unsigned short f2h(float f) { return __builtin_bit_cast(unsigned short, (_Float16)f); }
__device__ __forceinline__ float siluf(float v) { return v / (1.f + __expf(-v)); }
__device__ __forceinline__ float wave_sum(float v) {
#pragma unroll
    for (int o = 1; o < 64; o <<= 1) v += __shfl_xor(v, o);
    return v;
}
__device__ __forceinline__ void unpack8(const u32x4 w, float* f) {
    f[0] = __uint_as_float(w.x << 16); f[1] = __uint_as_float(w.x & 0xffff0000u);
    f[2] = __uint_as_float(w.y << 16); f[3] = __uint_as_float(w.y & 0xffff0000u);
    f[4] = __uint_as_float(w.z << 16); f[5] = __uint_as_float(w.z & 0xffff0000u);
    f[6] = __uint_as_float(w.w << 16); f[7] = __uint_as_float(w.w & 0xffff0000u);
}

__device__ __forceinline__ void transpose_item(const float* W, int K, int N, bf16_t* WT, float* scr, int item, int lane) {
    const int nblk = N / 32, kb = item / nblk, nb = item % nblk, k0 = 64 * kb, n0 = 32 * nb;
#pragma unroll 8
    for (int i = 0; i < 32; ++i) { const int kk = 2 * i + (lane >> 5); scr[kk * 33 + (lane & 31)] = W[(size_t)(k0 + kk) * N + n0 + (lane & 31)]; }
    __builtin_amdgcn_wave_barrier();
    const int c = lane & 7;
#pragma unroll
    for (int j = 0; j < 4; ++j) { const int n = (lane >> 3) + 8 * j; const float* s = scr + (8 * c) * 33 + n;
        u32x4 o; o.x = pk2(s[0 * 33], s[1 * 33]); o.y = pk2(s[2 * 33], s[3 * 33]); o.z = pk2(s[4 * 33], s[5 * 33]); o.w = pk2(s[6 * 33], s[7 * 33]);
        *(u32x4*)(WT + (size_t)(n0 + n) * K + k0 + 8 * c) = o; }
    __builtin_amdgcn_wave_barrier();
}

__device__ __forceinline__ void phase_prologue(const Params& P, unsigned char* lds) {
    const int tid = threadIdx.x, lane = tid & 63, wave = tid >> 6;
    unsigned char* ws = P.ws;
    {
        float* scr = (float*)(lds) + wave * (64 * 33);
        const int gw = blockIdx.x * NWAVES + wave, NGW = gridDim.x * NWAVES;
        constexpr int I0 = (D / 64) * (N0 / 32), IO = (D / 64) * (D / 32), I1 = (D / 64) * (N1 / 32);
        constexpr int NIT = I0 + IO + I1 + IO;
        for (int it = gw; it < NIT; it += NGW) {
            int r = it;
            if (r < I0) { transpose_item(P.na_w_in, D, N0, (bf16_t*)(ws + WS_W0T), scr, r, lane); continue; } r -= I0;
            if (r < IO) { transpose_item(P.na_w_out, D, D, (bf16_t*)(ws + WS_WO0T), scr, r, lane); continue; } r -= IO;
            if (r < I1) { transpose_item(P.hg_w_in, D, N1, (bf16_t*)(ws + WS_W1T), scr, r, lane); continue; } r -= I1;
            transpose_item(P.hg_w_out, D, D, (bf16_t*)(ws + WS_WO1T), scr, r, lane);
        }
    }
    __syncthreads();
    {
        float* sc = (float*)lds;
        float* red = (float*)(lds + 17 * 1024 * 4);
        for (int e = tid; e < 17 * 1024; e += NTHREADS) { const int r = e >> 10, k = e & 1023; const float v = (r < 16) ? P.c[r * 1024 + k] : P.c_ctx[k]; sc[e] = siluf(v); }
        __syncthreads();
        float* mod = (float*)(ws + WS_MOD);
        for (int it = blockIdx.x; it < 2 * 48; it += gridDim.x) {
            const int l = it / 48, n0 = (it % 48) * 64;
            const float* W = P.ada_w + (size_t)l * 1024 * 3072 + n0 + lane;
            float acc[17];
#pragma unroll
            for (int r = 0; r < 17; ++r) acc[r] = 0.f;
            const int kb = wave * 128;
#pragma unroll 4
            for (int k = 0; k < 128; ++k) { const float w = W[(size_t)(kb + k) * 3072];
#pragma unroll
                for (int r = 0; r < 17; ++r) acc[r] += sc[r * 1024 + kb + k] * w; }
#pragma unroll
            for (int r = 0; r < 17; ++r) red[(wave * 17 + r) * 64 + lane] = acc[r];
            __syncthreads();
            for (int e = tid; e < 17 * 64; e += NTHREADS) { const int r = e >> 6, n = e & 63; float s = P.ada_b[l * 3072 + n0 + n];
#pragma unroll
                for (int w = 0; w < 8; ++w) s += red[(w * 17 + r) * 64 + n];
                mod[(size_t)(l * 17 + r) * 3072 + n0 + n] = s; }
            __syncthreads();
        }
    }
    if (blockIdx.x == gridDim.x - 1) {
        float* lb = (float*)(ws + WS_LB);
        for (int cidx = tid; cidx < 1024; cidx += NTHREADS) { const float l0 = P.hg_lower[cidx], l1 = P.hg_lower[1024 + cidx]; const float mx = fmaxf(l0, l1);
            const float e0 = __expf(l0 - mx), e1 = __expf(l1 - mx); const float p0 = e0 / (e0 + e1), p1 = e1 / (e0 + e1); lb[cidx] = (p0 + p1) - p0; }
    }
}

__device__ __forceinline__ void phase_modulate(const Params& P, int layer, const float* xlat, const float* xctx, bf16_t* H) {
    const int tid = threadIdx.x, lane = tid & 63, wave = tid >> 6;
    const int gw = blockIdx.x * NWAVES + wave, NGW = gridDim.x * NWAVES;
    const float* mod = (const float*)(P.ws + WS_MOD) + (size_t)layer * 17 * 3072;
    const float* nw = P.norm_w + layer * 1024;
    for (int row = gw; row < MTOT; row += NGW) {
        const float* src = (row < NLAT) ? xlat + (size_t)row * D : xctx + (size_t)(row - NLAT) * D;
        const int br = (row < NLAT) ? (row >> 12) : 16;
        const float* sh = mod + (size_t)br * 3072; const float* scl = sh + 1024;
        f32x4 v[4]; float ss = 0.f;
#pragma unroll
        for (int j = 0; j < 4; ++j) { v[j] = *(const f32x4*)(src + lane * 4 + 256 * j); ss += (v[j].x * v[j].x + v[j].y * v[j].y) + (v[j].z * v[j].z + v[j].w * v[j].w); }
        const float rstd = 1.f / sqrtf(wave_sum(ss) * (1.f / D) + EPS);
#pragma unroll
        for (int j = 0; j < 4; ++j) { const int c0 = lane * 4 + 256 * j; const f32x4 w = *(const f32x4*)(nw + c0), s1 = *(const f32x4*)(scl + c0), s0 = *(const f32x4*)(sh + c0);
            const f32x4 h = (v[j] * rstd) * w * (s1 + 1.f) + s0;
            u32x2 o; o.x = pk2(h.x, h.y); o.y = pk2(h.z, h.w); *(u32x2*)(H + (size_t)row * D + c0) = o; }
    }
}

template <int MODE> __device__ __forceinline__ void epi_elem(const Params& P, int row, int col, float acc) {
    unsigned char* ws = P.ws;
    if (MODE == 0) {
        bf16_t* O = (bf16_t*)(ws + WS_R1);
        O[(size_t)row * N0 + col] = (bf16_t)f2bf(col < 1024 ? acc * QSCALE0 : acc);
    } else if (MODE == 1) {
        float* X1 = (float*)(ws + WS_X1);
        const float* mod = (const float*)(ws + WS_MOD);
        const int br = (row < NLAT) ? (row >> 12) : 16;
        const float xin = (row < NLAT) ? P.x[(size_t)row * D + col] : P.ctx[(size_t)(row - NLAT) * D + col];
        X1[(size_t)row * D + col] = xin + mod[(size_t)br * 3072 + 2048 + col] * acc;
    } else if (MODE == 2) {
        bf16_t* O = (bf16_t*)(ws + WS_R1);
        const int grp = col >> 10;
        unsigned short o;
        if (grp == 0) o = (unsigned short)f2bf(siluf(acc) * QSCALE1);
        else if (grp == 2 || grp == 3) { const float lb = ((const float*)(ws + WS_LB))[col & 1023]; const float f = lb + (1.f - lb) / (1.f + __expf(-acc)); o = f2h(__log2f(f)); }
        else o = (unsigned short)f2bf(acc);
        O[(size_t)row * N1 + col] = o;
    } else {
        float* X1 = (float*)(ws + WS_X1);
        const float* mod = (const float*)(ws + WS_MOD) + (size_t)17 * 3072;
        const int br = row >> 12;
        X1[(size_t)row * D + col] += mod[(size_t)br * 3072 + 2048 + col] * acc;
    }
}

namespace pg8 {
#define PG8_LAS __attribute__((address_space(3)))
typedef unsigned short bf16_t;
typedef short bf16x8 __attribute__((ext_vector_type(8)));
typedef float f32x4 __attribute__((ext_vector_type(4)));
typedef unsigned u32x4 __attribute__((ext_vector_type(4)));
constexpr int BM = 256, BK = 64, HALF = 128, HTB = HALF * BK * 2  , STAGE_BYTES = 8 * HTB, NXCD = 8, WGM = 8;

__host__ __device__ __forceinline__ int lds_byte(int r, int c) { const int st = (r >> 4) * 2 + (c >> 5), rr = r & 15, cc = c & 31, ob = rr * 64 + cc * 2; return st * 1024 + (ob ^ (((ob >> 9) & 1) << 5)); }
__host__ __device__ __forceinline__ void stage_rc(int b, int& R, int& C) { const int st = b / 1024, sb = b % 1024, swz = sb ^ (((sb >> 9) & 1) << 5); R = (st >> 1) * 16 + swz / 64; C = (st & 1) * 32 + (swz % 64) / 2; }
__host__ __device__ __forceinline__ int perm32(int rho) { const int n = rho >> 4, i = rho & 15; return 8 * (i >> 2) + 4 * n + (i & 3); }

struct Unit { int pm, pn; };
struct Gemm { const bf16_t* A; const bf16_t* Bt; int M, N, K; };

struct StaticOrder {
    int nM, nN, nwg, G, c;
    __host__ __device__ void init(int M, int N, int G_, int c_) { nM = M / BM; nN = N / BM; nwg = nM * nN; G = G_; c = c_; }
    __host__ __device__ bool next(int i, Unit& u) const {
        const long L = (long)i * G + c; if (L >= nwg) return false;
        int wgid = (int)L; { const int q = nwg / NXCD, r = nwg % NXCD, xcd = wgid % NXCD, off = wgid / NXCD; wgid = (xcd < r ? xcd * (q + 1) : r * (q + 1) + (xcd - r) * q) + off; }
        const int nig = WGM * nN, gid = wgid / nig, fm = gid * WGM, gsz = (nM - fm) < WGM ? (nM - fm) : WGM;
        u.pm = fm + ((wgid % nig) % gsz); u.pn = (wgid % nig) / gsz; return true;
    }
    __device__ __forceinline__ void a_ready(const Unit&) const {}
    __device__ __forceinline__ void done(const Unit&) const {}
};


typedef float f32x2_t_ __attribute__((ext_vector_type(2))); typedef __bf16 bf16x2_t_ __attribute__((ext_vector_type(2)));
__device__ __forceinline__ unsigned cvt_pk_bf16(float lo, float hi) { f32x2_t_ v = {lo, hi}; bf16x2_t_ b = __builtin_convertvector(v, bf16x2_t_); return __builtin_bit_cast(unsigned, b); }
__device__ __forceinline__ unsigned cvt_pk_f16(float lo, float hi) { return (unsigned)__builtin_bit_cast(unsigned short, (_Float16)lo) | ((unsigned)__builtin_bit_cast(unsigned short, (_Float16)hi) << 16); }
struct EpiQKVZ {
    static constexpr bool PERM = true, AFTER_DRAIN = false;
    bf16_t* O;
    __device__ __forceinline__ void operator()(const f32x4 (&acc)[2][2][4][2], const Unit& u, int wr, int wc, int fr, int fq) const {
        const int row0 = u.pm * BM + wr * 64 + fr, col0 = u.pn * BM + wc * 32 + 8 * fq;
        const float sc = (u.pn < 4) ? QSCALE0 : 1.f;
#pragma unroll
        for (int ai = 0; ai < 2; ++ai)
#pragma unroll
            for (int m = 0; m < 4; ++m) { bf16_t* rowp = O + (size_t)(row0 + ai * HALF + m * 16) * N0 + col0;
#pragma unroll
                for (int bj = 0; bj < 2; ++bj) { const f32x4 v0 = acc[ai][bj][m][0] * sc, v1 = acc[ai][bj][m][1] * sc;
                    u32x4 w; w.x = cvt_pk_bf16(v0[0], v0[1]); w.y = cvt_pk_bf16(v0[2], v0[3]); w.z = cvt_pk_bf16(v1[0], v1[1]); w.w = cvt_pk_bf16(v1[2], v1[3]);
                    *(u32x4*)(rowp + bj * HALF) = w; } }
    }
};
struct EpiRes {
    static constexpr bool PERM = false, AFTER_DRAIN = false;
    const float* xlat; const float* xctx; const float* mod; float* X1;
    __device__ __forceinline__ void operator()(const f32x4 (&acc)[2][2][4][2], const Unit& u, int wr, int wc, int fr, int fq) const {
        const int rowt = u.pm * BM; const bool lat = rowt < NLAT; const int br = lat ? (rowt >> 12) : 16;
        const float* src = lat ? xlat + (size_t)rowt * D : xctx + (size_t)(rowt - NLAT) * D;
        float* dst = X1 + (size_t)rowt * D;
        const int rl0 = wr * 64 + fr, col0 = u.pn * BM + wc * 32 + 4 * fq;
        f32x4 g[2][2];
#pragma unroll
        for (int bj = 0; bj < 2; ++bj)
#pragma unroll
            for (int n = 0; n < 2; ++n) g[bj][n] = *(const f32x4*)(mod + (size_t)br * 3072 + 2048 + col0 + bj * HALF + n * 16);
#pragma unroll
        for (int ai = 0; ai < 2; ++ai)
#pragma unroll
            for (int m = 0; m < 4; ++m) { const size_t off = (size_t)(rl0 + ai * HALF + m * 16) * D + col0;
#pragma unroll
                for (int bj = 0; bj < 2; ++bj)
#pragma unroll
                    for (int n = 0; n < 2; ++n) { const size_t o = off + bj * HALF + n * 16; *(f32x4*)(dst + o) = *(const f32x4*)(src + o) + g[bj][n] * acc[ai][bj][m][n]; } }
    }
};
struct EpiHG {
    static constexpr bool PERM = true, AFTER_DRAIN = false;
    unsigned short* O; const float* lb;
    __device__ __forceinline__ void operator()(const f32x4 (&acc)[2][2][4][2], const Unit& u, int wr, int wc, int fr, int fq) const {
        const int row0 = u.pm * BM + wr * 64 + fr, col0 = u.pn * BM + wc * 32 + 8 * fq;
        const int grp = u.pn >> 2;
        if (grp == 2 || grp == 3) {
#pragma unroll
            for (int bj = 0; bj < 2; ++bj) {
                const f32x4 l0 = *(const f32x4*)(lb + ((col0 + bj * HALF) & 1023)), l1 = *(const f32x4*)(lb + ((col0 + bj * HALF) & 1023) + 4);
#pragma unroll
                for (int ai = 0; ai < 2; ++ai)
#pragma unroll
                    for (int m = 0; m < 4; ++m) { unsigned short* rowp = O + (size_t)(row0 + ai * HALF + m * 16) * N1 + col0 + bj * HALF;
                        const f32x4 v0 = acc[ai][bj][m][0], v1 = acc[ai][bj][m][1]; float r[8];
#pragma unroll
                        for (int e = 0; e < 4; ++e) { const float f0 = l0[e] + (1.f - l0[e]) * __builtin_amdgcn_rcpf(1.f + __expf(-v0[e])); r[e] = __log2f(f0);
                            const float f1 = l1[e] + (1.f - l1[e]) * __builtin_amdgcn_rcpf(1.f + __expf(-v1[e])); r[4 + e] = __log2f(f1); }
                        u32x4 w; w.x = cvt_pk_f16(r[0], r[1]); w.y = cvt_pk_f16(r[2], r[3]); w.z = cvt_pk_f16(r[4], r[5]); w.w = cvt_pk_f16(r[6], r[7]);
                        *(u32x4*)rowp = w; }
            }
        } else {
#pragma unroll
            for (int ai = 0; ai < 2; ++ai)
#pragma unroll
                for (int m = 0; m < 4; ++m) { unsigned short* rowp = O + (size_t)(row0 + ai * HALF + m * 16) * N1 + col0;
#pragma unroll
                    for (int bj = 0; bj < 2; ++bj) { f32x4 v0 = acc[ai][bj][m][0], v1 = acc[ai][bj][m][1];
                        if (grp == 0) {
#pragma unroll
                            for (int e = 0; e < 4; ++e) { v0[e] = v0[e] * QSCALE1 * __builtin_amdgcn_rcpf(1.f + __expf(-v0[e])); v1[e] = v1[e] * QSCALE1 * __builtin_amdgcn_rcpf(1.f + __expf(-v1[e])); } }
                        u32x4 w; w.x = cvt_pk_bf16(v0[0], v0[1]); w.y = cvt_pk_bf16(v0[2], v0[3]); w.z = cvt_pk_bf16(v1[0], v1[1]); w.w = cvt_pk_bf16(v1[2], v1[3]);
                        *(u32x4*)(rowp + bj * HALF) = w; } }
        }
    }
};
template <class Epi, class Sched, bool ALIGN_EPI = false, bool SP2 = false>
__device__ __forceinline__ void gemm_phase(PG8_LAS unsigned char* lds, const Gemm g, const Sched& S, const Epi& E) {
    const int tid = threadIdx.x, wid = __builtin_amdgcn_readfirstlane(tid >> 6), lane = tid & 63, wr = wid >> 2, wc = wid & 3, fr = lane & 15, fq = lane >> 4;
    const int K = g.K, nt = K / BK;
    unsigned voffA[2], voffB[2];
#pragma unroll
    for (int i = 0; i < 2; ++i) { int R, C; stage_rc(tid * 16 + i * 8192, R, C); const int Rb = Epi::PERM ? ((R & ~31) + perm32(R & 31)) : R;
        voffA[i] = (unsigned)(R * K + C) * 2u; voffB[i] = (unsigned)(Rb * K + C) * 2u; }
    const size_t kstep = (size_t)(BK * 2);
    const size_t hstep = (size_t)HALF * K * 2;
    const size_t tstep = 2 * hstep;
    const unsigned ldsw = (unsigned)wid * 1024u;
    const int aoff = lds_byte(wr * 64 + fr, fq * 8), boff = lds_byte(wc * 32 + fr, fq * 8);
#define PG8_SA(b, h) (((b) * 2 + (h)) * HTB)
#define PG8_SB(b, h) ((4 + (b) * 2 + (h)) * HTB)
#define PG8_STAGE(bufoff, gbase, voff) do { _Pragma("unroll") for (int _i = 0; _i < 2; ++_i) \
        __builtin_amdgcn_global_load_lds((const unsigned*)((const char*)(gbase) + (voff)[_i]), (PG8_LAS unsigned*)(lds + (bufoff) + ldsw + _i * 8192), 16, 0, 0); } while (0)
#define PG8_LDA(dst, b, h) do { _Pragma("unroll") for (int m = 0; m < 4; ++m) _Pragma("unroll") for (int k = 0; k < 2; ++k) dst[m][k] = *(const PG8_LAS bf16x8*)(lds + PG8_SA(b, h) + aoff + m * 2048 + k * 1024); } while (0)
#define PG8_LDB(dst, b, h) do { _Pragma("unroll") for (int n = 0; n < 2; ++n) _Pragma("unroll") for (int k = 0; k < 2; ++k) dst[n][k] = *(const PG8_LAS bf16x8*)(lds + PG8_SB(b, h) + boff + n * 2048 + k * 1024); } while (0)
#define PG8_MMA(ai, bj, At, Bt) do { __builtin_amdgcn_s_setprio(1); _Pragma("unroll") for (int m = 0; m < 4; ++m) _Pragma("unroll") for (int n = 0; n < 2; ++n) _Pragma("unroll") for (int k = 0; k < 2; ++k) \
        acc[ai][bj][m][n] = __builtin_amdgcn_mfma_f32_16x16x32_bf16(Bt[n][k], At[m][k], acc[ai][bj][m][n], 0, 0, 0); __builtin_amdgcn_s_setprio(0); } while (0)
#define PG8_WAIT_V(n) asm volatile("s_waitcnt vmcnt(" #n ")" ::: "memory")
#define PG8_WAIT_L(n) asm volatile("s_waitcnt lgkmcnt(" #n ")" ::: "memory")
#define PG8_BAR __builtin_amdgcn_s_barrier()
#define PG8_SCHED __builtin_amdgcn_sched_barrier(0)
    Unit cur, nxt; int ui = 0;
    if (!S.next(0, cur)) return;
    f32x4 acc[2][2][4][2];
#pragma unroll
    for (int a = 0; a < 2; ++a)
#pragma unroll
        for (int b = 0; b < 2; ++b)
#pragma unroll
            for (int m = 0; m < 4; ++m)
#pragma unroll
                for (int n = 0; n < 2; ++n) acc[a][b][m][n] = (f32x4){0.f, 0.f, 0.f, 0.f};
    bf16x8 At[4][2], B0[2][2], B1[2][2];
    const char* cA = (const char*)g.A + (size_t)cur.pm * tstep; const char* cB = (const char*)g.Bt + (size_t)cur.pn * tstep;
    S.a_ready(cur);
    if constexpr (SP2) {
        PG8_STAGE(PG8_SB(0, 0), cB, voffB); PG8_STAGE(PG8_SB(0, 1), cB + hstep, voffB); PG8_STAGE(PG8_SA(0, 0), cA, voffA); PG8_STAGE(PG8_SA(0, 1), cA + hstep, voffA);
        if (wr == 1) PG8_BAR;
        PG8_WAIT_V(2); PG8_BAR;
        PG8_STAGE(PG8_SB(1, 0), cB + kstep, voffB); PG8_STAGE(PG8_SA(1, 0), cA + kstep, voffA); PG8_STAGE(PG8_SB(1, 1), cB + hstep + kstep, voffB);
        PG8_WAIT_V(6); PG8_BAR;
    } else {
        PG8_STAGE(PG8_SB(0, 0), cB, voffB); PG8_STAGE(PG8_SA(0, 0), cA, voffA); PG8_STAGE(PG8_SB(0, 1), cB + hstep, voffB); PG8_STAGE(PG8_SA(0, 1), cA + hstep, voffA);
        if (wr == 1) PG8_BAR;
        PG8_WAIT_V(4); PG8_BAR;
        PG8_STAGE(PG8_SB(1, 0), cB + kstep, voffB); PG8_STAGE(PG8_SA(1, 0), cA + kstep, voffA); PG8_STAGE(PG8_SB(1, 1), cB + hstep + kstep, voffB);
        PG8_WAIT_V(6); PG8_BAR;
    }
    for (;;) {
        const bool has_next = S.next(ui + 1, nxt);
        const char* nA = has_next ? (const char*)g.A + (size_t)nxt.pm * tstep : cA; const char* nB = has_next ? (const char*)g.Bt + (size_t)nxt.pn * tstep : cB;
        for (int t = 0; t < nt; t += 2) {
            const bool last = (t == nt - 2);
            const char* a1 = cA + (size_t)(t + 1) * kstep;
            const char* a2 = last ? nA : cA + (size_t)(t + 2) * kstep; const char* b2 = last ? nB : cB + (size_t)(t + 2) * kstep;
            const char* a3 = a2 + kstep; const char* b3 = b2 + kstep;
            if (last && has_next) S.a_ready(nxt);
            if constexpr (SP2) {
            PG8_LDB(B0, 0, 0); PG8_LDB(B1, 0, 1); PG8_SCHED; PG8_LDA(At, 0, 0); PG8_STAGE(PG8_SA(1, 1), a1 + hstep, voffA);
            PG8_WAIT_V(8); PG8_WAIT_L(0); PG8_BAR; PG8_MMA(0, 0, At, B0); PG8_MMA(0, 1, At, B1); PG8_BAR; PG8_SCHED;
            PG8_LDA(At, 0, 1); PG8_STAGE(PG8_SB(0, 0), b2, voffB); PG8_STAGE(PG8_SB(0, 1), b2 + hstep, voffB); PG8_STAGE(PG8_SA(0, 0), a2, voffA);
            PG8_WAIT_V(8); PG8_WAIT_L(0); PG8_BAR; PG8_MMA(1, 0, At, B0); PG8_MMA(1, 1, At, B1); PG8_BAR; PG8_SCHED;
            PG8_LDB(B0, 1, 0); PG8_LDB(B1, 1, 1); PG8_SCHED; PG8_LDA(At, 1, 0); PG8_STAGE(PG8_SA(0, 1), a2 + hstep, voffA);
            PG8_WAIT_V(8); PG8_WAIT_L(0); PG8_BAR; PG8_MMA(0, 0, At, B0); PG8_MMA(0, 1, At, B1); PG8_BAR; PG8_SCHED;
            PG8_LDA(At, 1, 1); PG8_STAGE(PG8_SB(1, 0), b3, voffB); PG8_STAGE(PG8_SB(1, 1), b3 + hstep, voffB); PG8_STAGE(PG8_SA(1, 0), a3, voffA);
            PG8_WAIT_V(8); PG8_WAIT_L(0); PG8_BAR; PG8_MMA(1, 0, At, B0); PG8_MMA(1, 1, At, B1); PG8_BAR; PG8_SCHED;
            } else {
            PG8_LDB(B0, 0, 0); PG8_SCHED; PG8_LDA(At, 0, 0); PG8_STAGE(PG8_SA(1, 1), a1 + hstep, voffA);
            PG8_WAIT_L(8); PG8_BAR; PG8_WAIT_L(0); PG8_MMA(0, 0, At, B0); PG8_BAR; PG8_SCHED;
            PG8_LDB(B1, 0, 1); PG8_STAGE(PG8_SB(0, 0), b2, voffB);
            PG8_BAR; PG8_WAIT_L(0); PG8_MMA(0, 1, At, B1); PG8_BAR;
            PG8_LDA(At, 0, 1); PG8_STAGE(PG8_SA(0, 0), a2, voffA);
            PG8_BAR; PG8_WAIT_L(0); PG8_MMA(1, 0, At, B0); PG8_BAR; PG8_SCHED;
            PG8_STAGE(PG8_SB(0, 1), b2 + hstep, voffB);
            PG8_WAIT_V(6); PG8_BAR; PG8_MMA(1, 1, At, B1); PG8_BAR;
            PG8_LDB(B0, 1, 0); PG8_SCHED; PG8_LDA(At, 1, 0); PG8_STAGE(PG8_SA(0, 1), a2 + hstep, voffA);
            PG8_WAIT_L(8); PG8_BAR; PG8_WAIT_L(0); PG8_MMA(0, 0, At, B0); PG8_BAR; PG8_SCHED;
            PG8_LDB(B1, 1, 1); PG8_STAGE(PG8_SB(1, 0), b3, voffB);
            PG8_BAR; PG8_WAIT_L(0); PG8_MMA(0, 1, At, B1); PG8_BAR;
            PG8_LDA(At, 1, 1); PG8_STAGE(PG8_SA(1, 0), a3, voffA);
            PG8_BAR; PG8_WAIT_L(0); PG8_MMA(1, 0, At, B0); PG8_BAR; PG8_SCHED;
            PG8_STAGE(PG8_SB(1, 1), b3 + hstep, voffB);
            PG8_WAIT_V(6); PG8_BAR; PG8_MMA(1, 1, At, B1); PG8_BAR;
            }
        }
        if constexpr (ALIGN_EPI) { if (wr == 0) PG8_BAR; }
        if constexpr (!Epi::AFTER_DRAIN) { E(acc, cur, wr, wc, fr, fq); S.done(cur); }
        if (!has_next) break;
#pragma unroll
        for (int a = 0; a < 2; ++a)
#pragma unroll
            for (int b = 0; b < 2; ++b)
#pragma unroll
                for (int m = 0; m < 4; ++m)
#pragma unroll
                    for (int n = 0; n < 2; ++n) acc[a][b][m][n] = (f32x4){0.f, 0.f, 0.f, 0.f};
        cur = nxt; cA = nA; cB = nB; ++ui;
        if constexpr (ALIGN_EPI) { if (wr == 1) PG8_BAR; }
    }
    PG8_WAIT_V(0);
    if constexpr (!ALIGN_EPI) { if (wr == 0) PG8_BAR; }
    PG8_BAR;
    if constexpr (Epi::AFTER_DRAIN) { E.fused(acc, cur, wr, wc, fr, fq, lds, wid, lane); S.done(cur); }
#undef PG8_SA
#undef PG8_SB
#undef PG8_STAGE
#undef PG8_LDA
#undef PG8_LDB
#undef PG8_MMA
#undef PG8_WAIT_V
#undef PG8_WAIT_L
#undef PG8_BAR
#undef PG8_SCHED
}
}

template <int MODE> __device__ __forceinline__ void gemm_naive(const Params& P, const bf16_t* A, const bf16_t* Bt, int M, int N, int K, unsigned char* lds) {
    float* As = (float*)lds;
    float* Bs = As + 32 * 132;
    const int tid = threadIdx.x, ty = tid >> 5, tx = tid & 31;
    const int nTn = N / 128, ntiles = (M / 128) * nTn;
    for (int t = blockIdx.x; t < ntiles; t += gridDim.x) {
        const int tm = t / nTn, tn = t % nTn;
        float acc[8][4];
#pragma unroll
        for (int i = 0; i < 8; ++i)
#pragma unroll
            for (int j = 0; j < 4; ++j) acc[i][j] = 0.f;
        for (int k0 = 0; k0 < K; k0 += 32) {
            {
                const int r = tid >> 2, kc = (tid & 3) * 8;
                float f[8];
                unpack8(*(const u32x4*)(A + (size_t)(tm * 128 + r) * K + k0 + kc), f);
#pragma unroll
                for (int i = 0; i < 8; ++i) As[(kc + i) * 132 + r] = f[i];
                unpack8(*(const u32x4*)(Bt + (size_t)(tn * 128 + r) * K + k0 + kc), f);
#pragma unroll
                for (int i = 0; i < 8; ++i) Bs[(kc + i) * 132 + r] = f[i];
            }
            __syncthreads();
#pragma unroll 8
            for (int k = 0; k < 32; ++k) {
                const f32x4 a0 = *(const f32x4*)(As + k * 132 + ty * 8), a1 = *(const f32x4*)(As + k * 132 + ty * 8 + 4), b = *(const f32x4*)(Bs + k * 132 + tx * 4);
                const float a[8] = {a0.x, a0.y, a0.z, a0.w, a1.x, a1.y, a1.z, a1.w}; const float bb[4] = {b.x, b.y, b.z, b.w};
#pragma unroll
                for (int i = 0; i < 8; ++i)
#pragma unroll
                    for (int j = 0; j < 4; ++j) acc[i][j] += a[i] * bb[j];
            }
            __syncthreads();
        }
#pragma unroll
        for (int i = 0; i < 8; ++i)
#pragma unroll
            for (int j = 0; j < 4; ++j) epi_elem<MODE>(P, tm * 128 + ty * 8 + i, tn * 128 + tx * 4 + j, acc[i][j]);
    }
}

__device__ __forceinline__ void phase_na_naive(const Params& P, unsigned char* lds, bf16_t* Y) {
    const int tid = threadIdx.x, lane = tid & 63, wave = tid >> 6;
    float* rpbL = (float*)lds;
    for (int e = tid; e < 16 * 15 * 31; e += NTHREADS) rpbL[e] = P.na_rpb[e] * LOG2E;
    __syncthreads();
    const bf16_t* R = (const bf16_t*)(P.ws + WS_R1);
    const int gw = blockIdx.x * NWAVES + wave, NGW = gridDim.x * NWAVES;
    for (int u = gw; u < 16384 + 1024; u += NGW) {
        int b, h, r = 0, qtok, nloc, r0 = 0, cs = 0;
        if (u < 16384) { r = u & 63; h = (u >> 6) & 15; b = u >> 10; qtok = b * SEQ + r * 64 + lane; nloc = 128;
            r0 = min(max(r - 4, 0), 56); cs = min(max(lane - 8, 0), 48); }
        else { const int v = u - 16384; const int qb = v & 3; h = (v >> 2) & 15; b = v >> 6; qtok = NLAT + b * CTX + qb * 64 + lane; nloc = 0; }
        float q[64], O[64];
        {
            const bf16_t* qp = R + (size_t)qtok * N0 + h * 64;
#pragma unroll
            for (int i = 0; i < 8; ++i) unpack8(*(const u32x4*)(qp + 8 * i), q + 8 * i);
        }
#pragma unroll
        for (int d = 0; d < 64; ++d) O[d] = 0.f;
        float m = -1e30f, l = 0.f;
        const int nk = nloc + CTX;
        for (int kk = 0; kk < nk; ++kk) {
            int ktok; float s;
            if (kk < nloc) { const int kr = kk >> 4, j = kk & 15; ktok = b * SEQ + (r0 + kr) * 64 + cs + j; s = rpbL[h * 465 + (r0 + kr - r + 7) * 31 + (cs + j - lane + 15)]; }
            else { ktok = NLAT + b * CTX + (kk - nloc); s = 0.f; }
            const bf16_t* kp = R + (size_t)ktok * N0 + 1024 + h * 64;
#pragma unroll
            for (int i = 0; i < 8; ++i) { float f[8]; unpack8(*(const u32x4*)(kp + 8 * i), f);
#pragma unroll
                for (int j2 = 0; j2 < 8; ++j2) s += q[8 * i + j2] * f[j2]; }
            const float mn = fmaxf(m, s), alpha = exp2f(m - mn), p = exp2f(s - mn);
            l = l * alpha + p; m = mn;
            const bf16_t* vp = kp + 1024;
#pragma unroll
            for (int i = 0; i < 8; ++i) { float f[8]; unpack8(*(const u32x4*)(vp + 8 * i), f);
#pragma unroll
                for (int j2 = 0; j2 < 8; ++j2) O[8 * i + j2] = O[8 * i + j2] * alpha + p * f[j2]; }
        }
        const float rl = 1.f / l;
        const bf16_t* zp = R + (size_t)qtok * N0 + 3072 + h * 64;
        bf16_t* yp = Y + (size_t)qtok * D + h * 64;
#pragma unroll
        for (int i = 0; i < 8; ++i) { float z[8]; unpack8(*(const u32x4*)(zp + 8 * i), z);
            u32x4 o;
            o.x = pk2(O[8 * i + 0] * rl * siluf(z[0]), O[8 * i + 1] * rl * siluf(z[1]));
            o.y = pk2(O[8 * i + 2] * rl * siluf(z[2]), O[8 * i + 3] * rl * siluf(z[3]));
            o.z = pk2(O[8 * i + 4] * rl * siluf(z[4]), O[8 * i + 5] * rl * siluf(z[5]));
            o.w = pk2(O[8 * i + 6] * rl * siluf(z[6]), O[8 * i + 7] * rl * siluf(z[7]));
            *(u32x4*)(yp + 8 * i) = o; }
    }
}


typedef short bf16x8 __attribute__((ext_vector_type(8)));
typedef short v4i16 __attribute__((ext_vector_type(4)));
#define LAS __attribute__((address_space(3)))
typedef float f32x2_t __attribute__((ext_vector_type(2))); typedef __bf16 bf16x2_t __attribute__((ext_vector_type(2)));
__device__ __forceinline__ unsigned cvtpk(float lo, float hi) { f32x2_t v = {lo, hi}; bf16x2_t b = __builtin_convertvector(v, bf16x2_t); return __builtin_bit_cast(unsigned, b); }
__device__ __forceinline__ f32x4 mfma16(bf16x8 a, bf16x8 b, f32x4 c) { return __builtin_amdgcn_mfma_f32_16x16x32_bf16(a, b, c, 0, 0, 0); }
__device__ __forceinline__ bf16x8 pack8(const f32x4 a, const f32x4 b) { u32x4 w; w.x = cvtpk(a[0], a[1]); w.y = cvtpk(a[2], a[3]); w.z = cvtpk(b[0], b[1]); w.w = cvtpk(b[2], b[3]); return __builtin_bit_cast(bf16x8, w); }

template <bool LOCAL, int HF>
__device__ __forceinline__ void na_scores(const bf16x8 (&Kf)[2][2], const bf16x8 (&qf)[4][2], f32x4 (&O)[4][4], float (&m)[4], float (&l)[4], bf16x8 (&pb)[4],
                                          const LAS float* rpbrow, int l16, int q4) {
#pragma unroll
    for (int tb = 0; tb < 4; ++tb) {
        const bool tb_act = !LOCAL || (HF == 0 ? tb <= 2 : tb >= 1);
        if (tb_act) {
            f32x4 s[2];
            const int qc = 16 * tb + l16, cs = min(max(qc - 8, 0), 48);
            float mx = -1e30f;
#pragma unroll
            for (int k2 = 0; k2 < 2; ++k2) {
                const int kb = 2 * HF + k2;
                const bool act = !LOCAL || (kb - tb <= 1 && tb - kb <= 1);
                if (act) {
                    f32x4 a = {0.f, 0.f, 0.f, 0.f};
                    a = mfma16(Kf[k2][0], qf[tb][0], a); a = mfma16(Kf[k2][1], qf[tb][1], a);
                    if (LOCAL) {
#pragma unroll
                        for (int e = 0; e < 4; ++e) { const int kc = 16 * kb + 4 * q4 + e; const bool valid = (unsigned)(kc - cs) < 16u;
                            const int idx = kc - qc + 15; const float bias = rpbrow[min(max(idx, 0), 30)];
                            a[e] = valid ? a[e] + bias : -1e30f; }
                    }
                    s[k2] = a; mx = fmaxf(mx, fmaxf(fmaxf(a[0], a[1]), fmaxf(a[2], a[3])));
                } else s[k2] = (f32x4){-1e30f, -1e30f, -1e30f, -1e30f};
            }
            mx = fmaxf(mx, __shfl_xor(mx, 16)); mx = fmaxf(mx, __shfl_xor(mx, 32));
            const float mn = fmaxf(m[tb], mx), alpha = __builtin_amdgcn_exp2f(m[tb] - mn); m[tb] = mn;
            float ps = 0.f;
#pragma unroll
            for (int k2 = 0; k2 < 2; ++k2)
#pragma unroll
                for (int e = 0; e < 4; ++e) { const float p = __builtin_amdgcn_exp2f(s[k2][e] - mn); s[k2][e] = p; ps += p; }
            l[tb] = l[tb] * alpha + ps;
#pragma unroll
            for (int db = 0; db < 4; ++db) O[db][tb] *= alpha;
            pb[tb] = pack8(s[0], s[1]);
        }
        __builtin_amdgcn_sched_barrier(0);
    }
}
template <bool LOCAL, int HF>
__device__ __forceinline__ void na_pv(const bf16x8 (&Vf)[4], const bf16x8 (&pb)[4], f32x4 (&O)[4][4]) {
#pragma unroll
    for (int tb = 0; tb < 4; ++tb) {
        const bool tb_act = !LOCAL || (HF == 0 ? tb <= 2 : tb >= 1);
        if (tb_act) {
#pragma unroll
            for (int db = 0; db < 4; ++db) O[db][tb] = mfma16(Vf[db], pb[tb], O[db][tb]);
        }
    }
}

__device__ __forceinline__ void phase_na_mfma(const Params& P, unsigned char* lds_, bf16_t* Y) {
    LAS unsigned char* lds = (LAS unsigned char*)lds_;
    const int tid = threadIdx.x, lane = tid & 63, l16 = lane & 15, q4 = lane >> 4;
    const int wave = __builtin_amdgcn_readfirstlane(tid >> 6);
    LAS float* rpbL = (LAS float*)lds;
    LAS unsigned char* Kt = lds + 2048 + wave * 16384;
    LAS unsigned char* Vt = Kt + 8192;
    const char* R = (const char*)(P.ws + WS_R1);
    const unsigned rowoff = (unsigned)(lane >> 3) * (N0 * 2);
    const unsigned kofs_e = rowoff + (unsigned)(((lane & 7) ^ (lane >> 4)) * 16), kofs_o = rowoff + (unsigned)(((lane & 7) ^ (4 + (lane >> 4))) * 16);
    const unsigned vofs = rowoff + (unsigned)((((((lane & 7) >> 1) ^ (lane >> 4)) & 3) << 1 | (lane & 1)) * 16);
    int koff[2];
#pragma unroll
    for (int ks = 0; ks < 2; ++ks) koff[ks] = l16 * 128 + (((4 * ks + q4) ^ ((l16 >> 1) & 7)) * 16);
    const int vrow = 4 * q4 + (l16 >> 2), vsw = (2 * (q4 & 1) + (l16 >> 3)) & 3;
    int voff[4];
#pragma unroll
    for (int db = 0; db < 4; ++db) voff[db] = vrow * 128 + ((db ^ vsw) * 32) + (l16 & 3) * 8;
    const int NITEM = 2048 + 128;
    for (int it = blockIdx.x; it < NITEM; it += gridDim.x) {
        int b, h, r = 0, r0 = 0, nloc, qtok0;
        if (it < 2048) { const int rg = it & 7; h = (it >> 3) & 15; b = it >> 7; r = rg * 8 + wave; r0 = min(max(r - 4, 0), 56); nloc = 8; qtok0 = b * SEQ + r * 64;
            __syncthreads();
            for (int e = tid; e < 465; e += NTHREADS) rpbL[e] = P.na_rpb[h * 465 + e] * LOG2E;
            __syncthreads();
        } else { const int v = it - 2048; b = v >> 3; h = (v & 7) * 2 + (wave >> 2); nloc = 0; qtok0 = NLAT + b * CTX + (wave & 3) * 64; }
        const int nt = nloc + 4;
        const char* kbase = R + (size_t)(1024 + h * 64) * 2;
        auto tile_tok = [&](int j) { return (j < nloc) ? (b * SEQ + (r0 + j) * 64) : (NLAT + b * CTX + (j - nloc) * 64); };
#define NA_DMA_K(j) do { const char* kp_ = kbase + (size_t)tile_tok(j) * (N0 * 2); \
        _Pragma("unroll") for (int i_ = 0; i_ < 8; ++i_) \
            __builtin_amdgcn_global_load_lds((const unsigned*)(kp_ + (size_t)i_ * 8 * N0 * 2 + ((i_ & 1) ? kofs_o : kofs_e)), (LAS unsigned*)(Kt + i_ * 1024), 16, 0, 0); } while (0)
#define NA_DMA_V(j) do { const char* kp_ = kbase + (size_t)tile_tok(j) * (N0 * 2); \
        _Pragma("unroll") for (int i_ = 0; i_ < 8; ++i_) \
            __builtin_amdgcn_global_load_lds((const unsigned*)(kp_ + 2048 + (size_t)i_ * 8 * N0 * 2 + vofs), (LAS unsigned*)(Vt + i_ * 1024), 16, 0, 0); } while (0)
        bf16x8 qf[4][2];
        {
            const bf16_t* qp = (const bf16_t*)R + (size_t)(qtok0 + l16) * N0 + h * 64 + 8 * q4;
#pragma unroll
            for (int tb = 0; tb < 4; ++tb)
#pragma unroll
                for (int ks = 0; ks < 2; ++ks) qf[tb][ks] = *(const bf16x8*)(qp + (size_t)tb * 16 * N0 + 32 * ks);
        }
        NA_DMA_K(0); NA_DMA_V(0);
        f32x4 O[4][4]; float m[4], l[4];
#pragma unroll
        for (int tb = 0; tb < 4; ++tb) { m[tb] = -1e30f; l[tb] = 0.f;
#pragma unroll
            for (int db = 0; db < 4; ++db) O[db][tb] = (f32x4){0.f, 0.f, 0.f, 0.f}; }
        for (int j = 0; j < nt; ++j) {
            const bool more = (j + 1 < nt);
            const LAS float* rpbrow = rpbL + (r0 + j - r + 7) * 31;
            int l16v = l16, q4v = q4; asm volatile("" : "+v"(l16v), "+v"(q4v));
#define NA_HALF(HF) do { \
            bf16x8 pb[4]; \
            { bf16x8 Kf[2][2]; \
              _Pragma("unroll") for (int k2 = 0; k2 < 2; ++k2) _Pragma("unroll") for (int ks = 0; ks < 2; ++ks) Kf[k2][ks] = *(const LAS bf16x8*)(Kt + (2 * HF + k2) * 2048 + koff[ks]); \
              asm volatile("s_waitcnt lgkmcnt(0)" ::: "memory"); \
              if (HF == 1 && more) NA_DMA_K(j + 1); \
              if (j < nloc) na_scores<true, HF>(Kf, qf, O, m, l, pb, rpbrow, l16v, q4v); else na_scores<false, HF>(Kf, qf, O, m, l, pb, rpbrow, l16v, q4v); } \
            if (HF == 0) { asm volatile("s_waitcnt vmcnt(0)" ::: "memory"); } \
            { bf16x8 Vf[4]; \
              _Pragma("unroll") for (int db = 0; db < 4; ++db) { \
                    const v4i16 lo = __builtin_amdgcn_ds_read_tr16_b64_v4i16((LAS v4i16*)(Vt + (2 * HF) * 2048 + voff[db])); \
                    const v4i16 hi = __builtin_amdgcn_ds_read_tr16_b64_v4i16((LAS v4i16*)(Vt + (2 * HF + 1) * 2048 + voff[db])); \
                    Vf[db] = __builtin_shufflevector(lo, hi, 0, 1, 2, 3, 4, 5, 6, 7); } \
              asm volatile("s_waitcnt lgkmcnt(0)" ::: "memory"); \
              if (HF == 1 && more) NA_DMA_V(j + 1); \
              if (j < nloc) na_pv<true, HF>(Vf, pb, O); else na_pv<false, HF>(Vf, pb, O); } } while (0)
            if (j == 0) asm volatile("s_waitcnt vmcnt(0)" ::: "memory"); else asm volatile("s_waitcnt vmcnt(8)" ::: "memory");
            NA_HALF(0);
            NA_HALF(1);
#undef NA_HALF
        }
#undef NA_DMA_K
#undef NA_DMA_V

#pragma unroll
        for (int tb = 0; tb < 4; ++tb) {
            float lt = l[tb]; lt += __shfl_xor(lt, 16); lt += __shfl_xor(lt, 32);
            const float rl = 1.f / lt;
            const size_t tok = (size_t)(qtok0 + 16 * tb + l16);
#pragma unroll
            for (int db = 0; db < 4; ++db) {
                const int col = h * 64 + 16 * db + 4 * q4;
                const u32x2 zz = *(const u32x2*)((const bf16_t*)R + tok * N0 + 3072 + col);
                const float z0 = __uint_as_float(zz.x << 16), z1 = __uint_as_float(zz.x & 0xffff0000u), z2 = __uint_as_float(zz.y << 16), z3 = __uint_as_float(zz.y & 0xffff0000u);
                const f32x4 o = O[db][tb] * rl;
                u32x2 w; w.x = cvtpk(o[0] * siluf(z0), o[1] * siluf(z1)); w.y = cvtpk(o[2] * siluf(z2), o[3] * siluf(z3));
                *(u32x2*)(Y + tok * D + col) = w; }
        }
    }
}

__device__ __forceinline__ void phase_hgrn_naive(const Params& P, unsigned char* lds, bf16_t* OF, bf16_t* OB) {
    const int tid = threadIdx.x, lane = tid & 63, wave = tid >> 6, l16 = lane & 15, q4 = lane >> 4;
    float* fT = (float*)lds;
    float* kT = fT + 32 * 128; float* qT = kT + 32 * 128; float* vT = qT + 32 * 128; float* oT = vT + 32 * 128;
    const unsigned short* R = (const unsigned short*)(P.ws + WS_R1);
    for (int it = blockIdx.x; it < 256; it += gridDim.x) {
        const int b = it >> 4, h = (it >> 1) & 7, dir = it & 1;
        bf16_t* Odst = dir ? OB : OF;
        float S[32];
#pragma unroll
        for (int i = 0; i < 32; ++i) S[i] = 0.f;
        for (int ci = 0; ci < 8 + 128; ++ci) {
            const bool is_ctx = ci < 8;
            const int len = is_ctx ? CTX : SEQ, sp0 = is_ctx ? ci * 32 : (ci - 8) * 32;
            const size_t rowbase = is_ctx ? (size_t)(NLAT + b * CTX) : (size_t)b * SEQ;
#pragma unroll
            for (int j = 0; j < 8; ++j) {
                const int e = tid + NTHREADS * j, p = e >> 7, c = e & 127;
                const int sp = sp0 + p, ti = dir ? (len - 1 - sp) : sp;
                const unsigned short* rp = R + (rowbase + ti) * N1 + h * 128 + c;
                const float lf2 = h2f(rp[(2 + dir) * 1024]);
                fT[e] = exp2f(lf2); kT[e] = -expm1f(lf2 * 0.6931471805599453f);
                vT[e] = bf2f(rp[1024]); qT[e] = is_ctx ? 0.f : bf2f(rp[0]);
            }
            __syncthreads();
            for (int t = 0; t < 32; ++t) {
                const float v = vT[t * 128 + wave * 16 + l16];
                float o = 0.f;
#pragma unroll
                for (int i4 = 0; i4 < 8; ++i4) {
                    const f32x4 f = *(const f32x4*)(fT + t * 128 + q4 * 32 + i4 * 4), k = *(const f32x4*)(kT + t * 128 + q4 * 32 + i4 * 4), qq = *(const f32x4*)(qT + t * 128 + q4 * 32 + i4 * 4);
                    S[i4 * 4 + 0] = f.x * S[i4 * 4 + 0] + k.x * v; o += S[i4 * 4 + 0] * qq.x;
                    S[i4 * 4 + 1] = f.y * S[i4 * 4 + 1] + k.y * v; o += S[i4 * 4 + 1] * qq.y;
                    S[i4 * 4 + 2] = f.z * S[i4 * 4 + 2] + k.z * v; o += S[i4 * 4 + 2] * qq.z;
                    S[i4 * 4 + 3] = f.w * S[i4 * 4 + 3] + k.w * v; o += S[i4 * 4 + 3] * qq.w;
                }
                o += __shfl_xor(o, 16); o += __shfl_xor(o, 32);
                if (q4 == 0) oT[t * 128 + wave * 16 + l16] = o;
            }
            __syncthreads();
            if (!is_ctx) {
#pragma unroll
                for (int j = 0; j < 8; ++j) {
                    const int e = tid + NTHREADS * j, p = e >> 7, c = e & 127;
                    const int sp = sp0 + p, ti = dir ? (len - 1 - sp) : sp;
                    Odst[(rowbase + ti) * D + h * 128 + c] = (bf16_t)f2bf(oT[e]);
                }
            }
        }
        __syncthreads();
    }
}


__device__ __forceinline__ void phase_hgrn_mfma(const Params& P, unsigned char* lds_, bf16_t* OF, bf16_t* OB) {
    LAS unsigned char* lds = (LAS unsigned char*)lds_;
    const int tid = threadIdx.x, lane = tid & 63, l16 = lane & 15, q4 = lane >> 4;
    const int wave = __builtin_amdgcn_readfirstlane(tid >> 6);
    LAS unsigned char* QT = lds;
    LAS unsigned char* KT = lds + 16384;
    LAS unsigned char* KTT = lds + 32768;
    LAS unsigned char* VT = lds + 49152;
    LAS unsigned char* PT = lds + 65536;
    LAS float* DM = (LAS float*)(lds + 73728);
    LAS float* DL = DM + 128;
    LAS float* TOT = DL + 128;
    const unsigned short* R = (const unsigned short*)(P.ws + WS_R1);
    const int c = tid & 127, qtr = __builtin_amdgcn_readfirstlane(tid >> 7);
    const int cc = c & 31, pc = 32 * (c >> 5) + (((cc & 12) << 1) | ((cc >> 4) << 2) | (cc & 3));
    const int pc_chunk = pc >> 3, pc_in = (pc & 7) * 2;
    for (int it = blockIdx.x; it < 256; it += gridDim.x) {
        const int b = it >> 4, h = (it >> 1) & 7, dir = it & 1;
        bf16_t* Odst = dir ? OB : OF;
        f32x4 S[8];
#pragma unroll
        for (int mb = 0; mb < 8; ++mb) S[mb] = (f32x4){0.f, 0.f, 0.f, 0.f};
        unsigned short lfr[16], qr[16]; u32x4 vr[2];
#define HG_ROW(ci_, p_) ((ci_) < 4 ? (size_t)(NLAT + b * CTX + (dir ? (CTX - 1 - ((ci_) * 64 + (p_))) : ((ci_) * 64 + (p_)))) \
                                   : (size_t)(b * SEQ + (dir ? (SEQ - 1 - (((ci_) - 4) * 64 + (p_))) : (((ci_) - 4) * 64 + (p_)))))
#define HG_LOAD(ci_) do { \
        _Pragma("unroll") for (int j = 0; j < 16; ++j) { const unsigned short* rp = R + HG_ROW(ci_, 16 * qtr + j) * N1 + h * 128 + c; \
            lfr[j] = rp[(2 + dir) * 1024]; qr[j] = ((ci_) >= 4) ? rp[0] : (unsigned short)0; } \
        _Pragma("unroll") for (int i = 0; i < 2; ++i) { const int e = tid + NTHREADS * i; \
            vr[i] = *(const u32x4*)(R + HG_ROW(ci_, e >> 4) * N1 + 1024 + h * 128 + (e & 15) * 8); } } while (0)
        HG_LOAD(0);
        for (int ci = 0; ci < 68; ++ci) {
            const bool is_ctx = ci < 4;
            float A[16]; float a = 0.f;
#pragma unroll
            for (int j = 0; j < 16; ++j) { a += h2f(lfr[j]); A[j] = a; }
            TOT[qtr * 128 + c] = a;
            __syncthreads();
            {
                const float t0 = TOT[c], t1 = TOT[128 + c], t2 = TOT[256 + c], t3 = TOT[384 + c];
                const float off = (qtr > 0 ? t0 : 0.f) + (qtr > 1 ? t1 : 0.f) + (qtr > 2 ? t2 : 0.f);
                const float mid = t0 + t1, last = mid + t2 + t3;
                if (qtr == 0) { DM[c] = __builtin_amdgcn_exp2f(mid); DL[c] = __builtin_amdgcn_exp2f(last - mid); }
                float Eprev = __builtin_amdgcn_exp2f(fminf(fmaxf(mid - off, -100.f), 100.f));
                float kp[16];
#pragma unroll
                for (int j = 0; j < 16; ++j) {
                    const float Ej = __builtin_amdgcn_exp2f(fminf(fmaxf(mid - off - A[j], -100.f), 100.f));
                    kp[j] = Ej - Eprev; Eprev = Ej;
                    const float qp = bf2f(qr[j]) * __builtin_amdgcn_rcpf(Ej);
                    const int byte = (16 * qtr + j) * 256 + ((pc_chunk ^ j) * 16) + pc_in;
                    *(LAS unsigned short*)(QT + byte) = (unsigned short)f2bf(qp);
                    *(LAS unsigned short*)(KT + byte) = (unsigned short)f2bf(kp[j]);
                }
                u32x4 w0, w1;
                w0.x = pk2(kp[0], kp[1]); w0.y = pk2(kp[2], kp[3]); w0.z = pk2(kp[8], kp[9]); w0.w = pk2(kp[10], kp[11]);
                w1.x = pk2(kp[4], kp[5]); w1.y = pk2(kp[6], kp[7]); w1.z = pk2(kp[12], kp[13]); w1.w = pk2(kp[14], kp[15]);
                const int sw = (c >> 1) & 7;
                *(LAS u32x4*)(KTT + c * 128 + (((2 * qtr) ^ sw) * 16)) = w0;
                *(LAS u32x4*)(KTT + c * 128 + (((2 * qtr + 1) ^ sw) * 16)) = w1;
#pragma unroll
                for (int i = 0; i < 2; ++i) { const int e = tid + NTHREADS * i, vrow = e >> 4, ch = e & 15;
                    *(LAS u32x4*)(VT + vrow * 256 + ((((ch >> 1) ^ (vrow & 7))) * 32) + (ch & 1) * 16) = vr[i]; }
            }
            if (ci + 1 < 68) HG_LOAD(ci + 1);
            __syncthreads();
            if (!is_ctx) {
                const int tb = wave >> 1;
                bf16x8 qf[4];
#pragma unroll
                for (int ks = 0; ks < 4; ++ks) qf[ks] = *(const LAS bf16x8*)(QT + (16 * tb + l16) * 256 + (((4 * ks + q4) ^ l16) * 16));
#pragma unroll
                for (int k2 = 0; k2 < 2; ++k2) {
                    const int sb = 2 * (wave & 1) + k2;
                    f32x4 acc = {0.f, 0.f, 0.f, 0.f};
                    if (sb <= tb) {
#pragma unroll
                        for (int ks = 0; ks < 4; ++ks) { const bf16x8 kf = *(const LAS bf16x8*)(KT + (16 * sb + l16) * 256 + (((4 * ks + q4) ^ l16) * 16)); acc = mfma16(kf, qf[ks], acc); }
                        if (sb == tb) {
#pragma unroll
                            for (int e = 0; e < 4; ++e) if (4 * q4 + e > l16) acc[e] = 0.f;
                        }
                    }
                    u32x2 w; w.x = cvtpk(acc[0], acc[1]); w.y = cvtpk(acc[2], acc[3]);
                    const int t = 16 * tb + l16;
                    *(LAS u32x2*)(PT + t * 128 + (((2 * sb + (q4 & 1)) ^ ((t >> 1) & 7)) * 16) + 8 * (q4 >> 1)) = w;
                }
            }
            __syncthreads();
            {
#pragma unroll
                for (int mb = 0; mb < 8; ++mb) S[mb] *= *(const LAS f32x4*)(DM + 16 * mb + 4 * q4);
                bf16x8 vf[2];
#pragma unroll
                for (int ks2 = 0; ks2 < 2; ++ks2) {
                    const int row0 = 32 * ks2 + 16 * (q4 >> 1) + 4 * (q4 & 1) + (l16 >> 2);
                    const int un = (wave ^ (4 * (q4 & 1) + (l16 >> 2))) * 32 + (l16 & 3) * 8;
                    const v4i16 lo = __builtin_amdgcn_ds_read_tr16_b64_v4i16((LAS v4i16*)(VT + row0 * 256 + un));
                    const v4i16 hi = __builtin_amdgcn_ds_read_tr16_b64_v4i16((LAS v4i16*)(VT + (row0 + 8) * 256 + un));
                    vf[ks2] = __builtin_shufflevector(lo, hi, 0, 1, 2, 3, 4, 5, 6, 7);
                }
                if (!is_ctx) {
                    f32x4 o[4];
#pragma unroll
                    for (int tb = 0; tb < 4; ++tb) o[tb] = (f32x4){0.f, 0.f, 0.f, 0.f};
#pragma unroll
                    for (int ks = 0; ks < 4; ++ks) {
                        const bf16x8 sb16 = pack8(S[2 * ks], S[2 * ks + 1]);
#pragma unroll
                        for (int tb = 0; tb < 4; ++tb) { const bf16x8 qf = *(const LAS bf16x8*)(QT + (16 * tb + l16) * 256 + (((4 * ks + q4) ^ l16) * 16)); o[tb] = mfma16(sb16, qf, o[tb]); }
                    }
#pragma unroll
                    for (int ks2 = 0; ks2 < 2; ++ks2)
#pragma unroll
                        for (int tb = 0; tb < 4; ++tb) {
                            if (ks2 == 1 && tb < 2) continue;
                            const bf16x8 pf = *(const LAS bf16x8*)(PT + (16 * tb + l16) * 128 + (((4 * ks2 + q4) ^ ((l16 >> 1) & 7)) * 16)); o[tb] = mfma16(vf[ks2], pf, o[tb]); }
#pragma unroll
                    for (int tb = 0; tb < 4; ++tb) { const size_t row = HG_ROW(ci, 16 * tb + l16);
                        u32x2 w; w.x = cvtpk(o[tb][0], o[tb][1]); w.y = cvtpk(o[tb][2], o[tb][3]);
                        *(u32x2*)(Odst + row * D + h * 128 + 16 * wave + 4 * q4) = w; }
                }
#pragma unroll
                for (int mb = 0; mb < 8; ++mb) {
#pragma unroll
                    for (int ks2 = 0; ks2 < 2; ++ks2) { const bf16x8 kt = *(const LAS bf16x8*)(KTT + (16 * mb + l16) * 128 + (((4 * ks2 + q4) ^ ((l16 >> 1) & 7)) * 16)); S[mb] = mfma16(kt, vf[ks2], S[mb]); }
                    S[mb] *= *(const LAS f32x4*)(DL + 16 * mb + 4 * q4);
                }
            }
            __syncthreads();
        }
#undef HG_LOAD
#undef HG_ROW
    }
}

__device__ __forceinline__ void phase_readout(const Params& P, bf16_t* OF, const bf16_t* OB) {
    const int tid = threadIdx.x, lane = tid & 63, wave = tid >> 6;
    const int gw = blockIdx.x * NWAVES + wave, NGW = gridDim.x * NWAVES;
    const bf16_t* R = (const bf16_t*)(P.ws + WS_R1);
    float hw[16];
#pragma unroll
    for (int i = 0; i < 16; ++i) hw[i] = P.hg_norm_w[(lane * 16 + i) & 127];
    for (int row = gw; row < NLAT; row += NGW) {
        float o[16], g[16], t[8];
        unpack8(*(const u32x4*)(OF + (size_t)row * D + lane * 16), o); unpack8(*(const u32x4*)(OF + (size_t)row * D + lane * 16 + 8), o + 8);
        unpack8(*(const u32x4*)(OB + (size_t)row * D + lane * 16), t);
#pragma unroll
        for (int i = 0; i < 8; ++i) o[i] += t[i];
        unpack8(*(const u32x4*)(OB + (size_t)row * D + lane * 16 + 8), t);
#pragma unroll
        for (int i = 0; i < 8; ++i) o[8 + i] += t[i];
        unpack8(*(const u32x4*)(R + (size_t)row * N1 + 4096 + lane * 16), g); unpack8(*(const u32x4*)(R + (size_t)row * N1 + 4096 + lane * 16 + 8), g + 8);
        float ss = 0.f;
#pragma unroll
        for (int i = 0; i < 16; ++i) ss += o[i] * o[i];
        ss += __shfl_xor(ss, 1); ss += __shfl_xor(ss, 2); ss += __shfl_xor(ss, 4);
        const float rstd = 1.f / sqrtf(ss * (1.f / 128.f) + EPS);
        float y[16];
#pragma unroll
        for (int i = 0; i < 16; ++i) y[i] = o[i] * rstd * hw[i] * siluf(g[i]);
        u32x4 w0, w1;
        w0.x = pk2(y[0], y[1]); w0.y = pk2(y[2], y[3]); w0.z = pk2(y[4], y[5]); w0.w = pk2(y[6], y[7]);
        w1.x = pk2(y[8], y[9]); w1.y = pk2(y[10], y[11]); w1.z = pk2(y[12], y[13]); w1.w = pk2(y[14], y[15]);
        *(u32x4*)(OF + (size_t)row * D + lane * 16) = w0; *(u32x4*)(OF + (size_t)row * D + lane * 16 + 8) = w1;
    }
}

__device__ __forceinline__ void phase_final(const Params& P) {
    const int tid = threadIdx.x, lane = tid & 63, wave = tid >> 6;
    const int gw = blockIdx.x * NWAVES + wave, NGW = gridDim.x * NWAVES;
    const float* X1 = (const float*)(P.ws + WS_X1);
    for (int row = gw; row < NLAT; row += NGW) {
        f32x4 v[4]; float ss = 0.f;
#pragma unroll
        for (int j = 0; j < 4; ++j) { v[j] = *(const f32x4*)(X1 + (size_t)row * D + lane * 4 + 256 * j); ss += (v[j].x * v[j].x + v[j].y * v[j].y) + (v[j].z * v[j].z + v[j].w * v[j].w); }
        const float rstd = 1.f / sqrtf(wave_sum(ss) * (1.f / D) + EPS);
#pragma unroll
        for (int j = 0; j < 4; ++j) { const f32x4 w = *(const f32x4*)(P.final_norm_w + lane * 4 + 256 * j); *(f32x4*)(P.out + (size_t)row * D + lane * 4 + 256 * j) = (v[j] * rstd) * w; }
    }
}

constexpr int NPHASE = 11;
__global__ void __launch_bounds__(NTHREADS, 2) fwd_megakernel(Params P) {
    extern __shared__ __attribute__((aligned(16))) unsigned char lds[];
    cg::grid_group grid = cg::this_grid();
    unsigned char* ws = P.ws;
    bf16_t* H = (bf16_t*)P.out;
    bf16_t* OF = (bf16_t*)P.out;
    bf16_t* OB = (bf16_t*)P.out + (size_t)NLAT * D;
    float* X1 = (float*)(ws + WS_X1);
    const int lo = P.ph_lo, hi = P.ph_hi;
#define IN(k) (lo <= (k) && (k) < hi)
#define SEAM(k) do { if (IN(k) && IN((k) + 1)) grid.sync(); } while (0)
    if (IN(0)) phase_prologue(P, lds);
    SEAM(0);
    if (IN(1)) phase_modulate(P, 0, P.x, P.ctx, H);
    SEAM(1);
    if (IN(2)) { pg8::Gemm g{H, (const bf16_t*)(ws + WS_W0T), MTOT, N0, D}; pg8::StaticOrder S; S.init(MTOT, N0, (int)gridDim.x, (int)blockIdx.x);
        pg8::EpiQKVZ E{(bf16_t*)(ws + WS_R1)}; pg8::gemm_phase<pg8::EpiQKVZ, pg8::StaticOrder, true, true>((PG8_LAS unsigned char*)lds, g, S, E); }
    SEAM(2);
    if (IN(3)) phase_na_mfma(P, lds, H);
    SEAM(3);
    if (IN(4)) { pg8::Gemm g{H, (const bf16_t*)(ws + WS_WO0T), MTOT, D, D}; pg8::StaticOrder S; S.init(MTOT, D, (int)gridDim.x, (int)blockIdx.x);
        pg8::EpiRes E{P.x, P.ctx, (const float*)(ws + WS_MOD), X1}; pg8::gemm_phase<pg8::EpiRes, pg8::StaticOrder, true, true>((PG8_LAS unsigned char*)lds, g, S, E); }
    SEAM(4);
    if (IN(5)) phase_modulate(P, 1, X1, X1 + (size_t)NLAT * D, H);
    SEAM(5);
    if (IN(6)) { pg8::Gemm g{H, (const bf16_t*)(ws + WS_W1T), MTOT, N1, D}; pg8::StaticOrder S; S.init(MTOT, N1, (int)gridDim.x, (int)blockIdx.x);
        pg8::EpiHG E{(unsigned short*)(ws + WS_R1), (const float*)(ws + WS_LB)}; pg8::gemm_phase<pg8::EpiHG, pg8::StaticOrder, true, true>((PG8_LAS unsigned char*)lds, g, S, E); }
    SEAM(6);
    if (IN(7)) phase_hgrn_mfma(P, lds, OF, OB);
    SEAM(7);
    if (IN(8)) phase_readout(P, OF, OB);
    SEAM(8);
    if (IN(9)) { pg8::Gemm g{OF, (const bf16_t*)(ws + WS_WO1T), NLAT, D, D}; pg8::StaticOrder S; S.init(NLAT, D, (int)gridDim.x, (int)blockIdx.x);
        pg8::EpiRes E{X1, X1 + (size_t)NLAT * D, (const float*)(ws + WS_MOD) + 17 * 3072, X1}; pg8::gemm_phase<pg8::EpiRes, pg8::StaticOrder, true, true>((PG8_LAS unsigned char*)lds, g, S, E); }
    SEAM(9);
    if (IN(10)) phase_final(P);
#undef IN
#undef SEAM
}

extern "C" void kernel_launch(void* const* d_in, const int* in_sizes, int n_in, void* d_out, int out_size, void* d_ws, size_t ws_size, hipStream_t stream) {
    static int grid = 0;
    if (grid == 0) {
        if (n_in != 15 || out_size != NLAT * D || ws_size < WS_END) { fprintf(stderr, "kernel_launch: unexpected sizes n_in %d out %d ws %zu\n", n_in, out_size, ws_size); grid = -1; return; }
        int dev = 0, cus = 0, per_cu = 0;
        (void)hipGetDevice(&dev);
        (void)hipDeviceGetAttribute(&cus, hipDeviceAttributeMultiprocessorCount, dev);
        (void)hipFuncSetAttribute((const void*)fwd_megakernel, hipFuncAttributeMaxDynamicSharedMemorySize, LDS_BYTES);
        (void)hipOccupancyMaxActiveBlocksPerMultiprocessor(&per_cu, (const void*)fwd_megakernel, NTHREADS, LDS_BYTES);
        if (per_cu < 1) per_cu = 1;
        (void)hipGetLastError();
        grid = cus * per_cu;
    }
    if (grid < 0) return;
    Params p{};
    p.x = (const float*)d_in[0]; p.c = (const float*)d_in[1]; p.ctx = (const float*)d_in[2]; p.c_ctx = (const float*)d_in[3];
    p.ada_w = (const float*)d_in[4]; p.ada_b = (const float*)d_in[5]; p.norm_w = (const float*)d_in[6]; p.na_w_in = (const float*)d_in[7];
    p.na_rpb = (const float*)d_in[8]; p.na_w_out = (const float*)d_in[9]; p.hg_w_in = (const float*)d_in[10]; p.hg_lower = (const float*)d_in[11];
    p.hg_norm_w = (const float*)d_in[12]; p.hg_w_out = (const float*)d_in[13]; p.final_norm_w = (const float*)d_in[14];
    p.out = (float*)d_out; p.ws = (unsigned char*)d_ws; p.ph_lo = 0; p.ph_hi = NPHASE;
    void* args[] = {&p};
    hipError_t e = hipLaunchCooperativeKernel((const void*)fwd_megakernel, dim3(grid), dim3(NTHREADS), args, LDS_BYTES, stream);
    if (e != hipSuccess) fprintf(stderr, "cooperative launch failed: %s (grid %d)\n", hipGetErrorString(e), grid);
}
```

```cpp
#include <hip/hip_runtime.h>
#include <hip/hip_cooperative_groups.h>
#include <cstdio>
#include <cstdint>
namespace cg = cooperative_groups;

typedef unsigned short bf16_t;
typedef float f32x4 __attribute__((ext_vector_type(4)));
typedef unsigned u32x4 __attribute__((ext_vector_type(4)));
typedef unsigned u32x2 __attribute__((ext_vector_type(2)));

constexpr int D = 1024, NB = 16, SEQ = 4096, CTX = 256;
constexpr int NLAT = NB * SEQ;
constexpr int NCTX = NB * CTX;
constexpr int MTOT = NLAT + NCTX;
constexpr int N0 = 4096, N1 = 5120;
constexpr float EPS = 1e-6f;
constexpr float LOG2E = 1.4426950408889634f;
constexpr float QSCALE0 = 0.125f * LOG2E;
constexpr float QSCALE1 = 0.08838834764831845f;
constexpr int NTHREADS = 512, NWAVES = 8;

constexpr size_t MiB = 1u << 20;
constexpr size_t WS_MOD = 1 * MiB;
constexpr size_t WS_LB = 1 * MiB + 512 * 1024;
constexpr size_t WS_W0T = 2 * MiB, WS_WO0T = 10 * MiB, WS_W1T = 12 * MiB, WS_WO1T = 22 * MiB;
constexpr size_t WS_X1 = 32 * MiB;
constexpr size_t WS_R1 = 304 * MiB;
constexpr size_t WS_END = 984 * MiB;
static_assert(WS_X1 + (size_t)MTOT * D * 4 <= WS_R1 && WS_R1 + (size_t)MTOT * N1 * 2 <= WS_END, "ws map");

constexpr int LDS_BYTES = 147456;

struct Params {
    const float *x, *c, *ctx, *c_ctx, *ada_w, *ada_b, *norm_w, *na_w_in, *na_rpb, *na_w_out, *hg_w_in, *hg_lower, *hg_norm_w, *hg_w_out, *final_norm_w;
    float* out; unsigned char* ws; int ph_lo, ph_hi;
};

__device__ __forceinline__ float bf2f(bf16_t v) { return __uint_as_float((unsigned)v << 16); }
__device__ __forceinline__ unsigned f2bf(float f) { unsigned u = __float_as_uint(f); return (u + 0x7fffu + ((u >> 16) & 1u)) >> 16; }
__device__ __forceinline__ unsigned pk2(float lo, float hi) { return f2bf(lo) | (f2bf(hi) << 16); }
typedef float f32x2_t __attribute__((ext_vector_type(2))); typedef __bf16 bf16x2_t __attribute__((ext_vector_type(2)));
__device__ __forceinline__ unsigned cvtpk(float lo, float hi) { f32x2_t v = {lo, hi}; bf16x2_t b = __builtin_convertvector(v, bf16x2_t); return __builtin_bit_cast(unsigned, b); }
__device__ __forceinline__ float h2f(unsigned short v) { return (float)__builtin_bit_cast(_Float16, v); }
__device__ __forceinline__ unsigned short f2h(float f) { return __builtin_bit_cast(unsigned short, (_Float16)f); }
__device__ __forceinline__ float siluf(float v) { return v / (1.f + __expf(-v)); }
__device__ __forceinline__ float wave_sum(float v) {
#pragma unroll
    for (int o = 1; o < 64; o <<= 1) v += __shfl_xor(v, o);
    return v;
}
__device__ __forceinline__ void unpack8(const u32x4 w, float* f) {
    f[0] = __uint_as_float(w.x << 16); f[1] = __uint_as_float(w.x & 0xffff0000u);
    f[2] = __uint_as_float(w.y << 16); f[3] = __uint_as_float(w.y & 0xffff0000u);
    f[4] = __uint_as_float(w.z << 16); f[5] = __uint_as_float(w.z & 0xffff0000u);
    f[6] = __uint_as_float(w.w << 16); f[7] = __uint_as_float(w.w & 0xffff0000u);
}

__device__ __forceinline__ void transpose_item(const float* W, int K, int N, bf16_t* WT, float* scr, int item, int lane) {
    const int nblk = N / 32, kb = item / nblk, nb = item % nblk, k0 = 64 * kb, n0 = 32 * nb;
#pragma unroll 8
    for (int i = 0; i < 32; ++i) { const int kk = 2 * i + (lane >> 5); scr[kk * 33 + (lane & 31)] = W[(size_t)(k0 + kk) * N + n0 + (lane & 31)]; }
    __builtin_amdgcn_wave_barrier();
    const int c = lane & 7;
#pragma unroll
    for (int j = 0; j < 4; ++j) { const int n = (lane >> 3) + 8 * j; const float* s = scr + (8 * c) * 33 + n;
        u32x4 o; o.x = pk2(s[0 * 33], s[1 * 33]); o.y = pk2(s[2 * 33], s[3 * 33]); o.z = pk2(s[4 * 33], s[5 * 33]); o.w = pk2(s[6 * 33], s[7 * 33]);
        *(u32x4*)(WT + (size_t)(n0 + n) * K + k0 + 8 * c) = o; }
    __builtin_amdgcn_wave_barrier();
}

__device__ __forceinline__ void phase_prologue(const Params& P, unsigned char* lds) {
    const int tid = threadIdx.x, lane = tid & 63, wave = tid >> 6;
    unsigned char* ws = P.ws;
    {
        float* scr = (float*)(lds) + wave * (64 * 33);
        const int gw = blockIdx.x * NWAVES + wave, NGW = gridDim.x * NWAVES;
        constexpr int I0 = (D / 64) * (N0 / 32), IO = (D / 64) * (D / 32), I1 = (D / 64) * (N1 / 32);
        constexpr int NIT = I0 + IO + I1 + IO;
        for (int it = gw; it < NIT; it += NGW) {
            int r = it;
            if (r < I0) { transpose_item(P.na_w_in, D, N0, (bf16_t*)(ws + WS_W0T), scr, r, lane); continue; } r -= I0;
            if (r < IO) { transpose_item(P.na_w_out, D, D, (bf16_t*)(ws + WS_WO0T), scr, r, lane); continue; } r -= IO;
            if (r < I1) { transpose_item(P.hg_w_in, D, N1, (bf16_t*)(ws + WS_W1T), scr, r, lane); continue; } r -= I1;
            transpose_item(P.hg_w_out, D, D, (bf16_t*)(ws + WS_WO1T), scr, r, lane);
        }
    }
    __syncthreads();
    {
        float* sc = (float*)lds;
        float* red = (float*)(lds + 17 * 1024 * 4);
        for (int e = tid; e < 17 * 1024; e += NTHREADS) { const int r = e >> 10, k = e & 1023; const float v = (r < 16) ? P.c[r * 1024 + k] : P.c_ctx[k]; sc[e] = siluf(v); }
        __syncthreads();
        float* mod = (float*)(ws + WS_MOD);
        for (int it = blockIdx.x; it < 2 * 48; it += gridDim.x) {
            const int l = it / 48, n0 = (it % 48) * 64;
            const float* W = P.ada_w + (size_t)l * 1024 * 3072 + n0 + lane;
            float acc[17];
#pragma unroll
            for (int r = 0; r < 17; ++r) acc[r] = 0.f;
            const int kb = wave * 128;
#pragma unroll 4
            for (int k = 0; k < 128; ++k) { const float w = W[(size_t)(kb + k) * 3072];
#pragma unroll
                for (int r = 0; r < 17; ++r) acc[r] += sc[r * 1024 + kb + k] * w; }
#pragma unroll
            for (int r = 0; r < 17; ++r) red[(wave * 17 + r) * 64 + lane] = acc[r];
            __syncthreads();
            for (int e = tid; e < 17 * 64; e += NTHREADS) { const int r = e >> 6, n = e & 63; float s = P.ada_b[l * 3072 + n0 + n];
#pragma unroll
                for (int w = 0; w < 8; ++w) s += red[(w * 17 + r) * 64 + n];
                mod[(size_t)(l * 17 + r) * 3072 + n0 + n] = s; }
            __syncthreads();
        }
    }
    if (blockIdx.x == gridDim.x - 1) {
        float* lb = (float*)(ws + WS_LB);
        for (int cidx = tid; cidx < 1024; cidx += NTHREADS) { const float l0 = P.hg_lower[cidx], l1 = P.hg_lower[1024 + cidx]; const float mx = fmaxf(l0, l1);
            const float e0 = __expf(l0 - mx), e1 = __expf(l1 - mx); const float p0 = e0 / (e0 + e1), p1 = e1 / (e0 + e1); lb[cidx] = (p0 + p1) - p0; }
    }
}

__device__ __forceinline__ void phase_modulate(const Params& P, int layer, const float* xlat, const float* xctx, bf16_t* H, const bf16_t* delta) {
    const int tid = threadIdx.x, lane = tid & 63, wave = tid >> 6;
    const int gw = blockIdx.x * NWAVES + wave, NGW = gridDim.x * NWAVES;
    const float* mod = (const float*)(P.ws + WS_MOD) + (size_t)layer * 17 * 3072;
    const float* nw = P.norm_w + layer * 1024;
    const int per = (MTOT + NGW - 1) / NGW, rbeg = gw * per, rend = min(rbeg + per, MTOT);
    if (rbeg >= rend) return;
    f32x4 g[4], sh[4]; int cur_br = -1;
    f32x4 v0[4], v1[4], v2[4]; u32x2 d0[4], d1[4], d2[4];
#define MOD_LOAD(vv, dd, row) do { if ((row) < rend) { const float* s_ = ((row) < NLAT) ? xlat + (size_t)(row) * D : xctx + (size_t)((row) - NLAT) * D; \
        _Pragma("unroll") for (int j = 0; j < 4; ++j) { vv[j] = *(const f32x4*)(s_ + lane * 4 + 256 * j); dd[j] = delta ? *(const u32x2*)(delta + (size_t)(row) * D + lane * 4 + 256 * j) : (u32x2){0u, 0u}; } } } while (0)
#define MOD_ROW(vv, dd, row) do { if ((row) < rend) { \
        const int br = ((row) < NLAT) ? ((row) >> 12) : 16; \
        if (br != cur_br) { cur_br = br; const float* shp = mod + (size_t)br * 3072; const float* scl = shp + 1024; \
            _Pragma("unroll") for (int j = 0; j < 4; ++j) { const int c0 = lane * 4 + 256 * j; g[j] = *(const f32x4*)(nw + c0) * (*(const f32x4*)(scl + c0) + 1.f); sh[j] = *(const f32x4*)(shp + c0); } } \
        float ss = 0.f; \
        _Pragma("unroll") for (int j = 0; j < 4; ++j) { \
            vv[j].x += __uint_as_float(dd[j].x << 16); vv[j].y += __uint_as_float(dd[j].x & 0xffff0000u); vv[j].z += __uint_as_float(dd[j].y << 16); vv[j].w += __uint_as_float(dd[j].y & 0xffff0000u); \
            ss += (vv[j].x * vv[j].x + vv[j].y * vv[j].y) + (vv[j].z * vv[j].z + vv[j].w * vv[j].w); } \
        const float rstd = 1.f / sqrtf(wave_sum(ss) * (1.f / D) + EPS); \
        _Pragma("unroll") for (int j = 0; j < 4; ++j) { const int c0 = lane * 4 + 256 * j; const f32x4 h = (vv[j] * rstd) * g[j] + sh[j]; \
            u32x2 o; o.x = cvtpk(h.x, h.y); o.y = cvtpk(h.z, h.w); *(u32x2*)(H + (size_t)(row) * D + c0) = o; } } } while (0)
    MOD_LOAD(v0, d0, rbeg); MOD_LOAD(v1, d1, rbeg + 1);
    for (int row = rbeg; row < rend; row += 3) {
        MOD_LOAD(v2, d2, row + 2); MOD_ROW(v0, d0, row);
        MOD_LOAD(v0, d0, row + 3); MOD_ROW(v1, d1, row + 1);
        MOD_LOAD(v1, d1, row + 4); MOD_ROW(v2, d2, row + 2);
    }
#undef MOD_ROW
#undef MOD_LOAD
}

template <int MODE> __device__ __forceinline__ void epi_elem(const Params& P, int row, int col, float acc) {
    unsigned char* ws = P.ws;
    if (MODE == 0) {
        bf16_t* O = (bf16_t*)(ws + WS_R1);
        O[(size_t)row * N0 + col] = (bf16_t)f2bf(col < 1024 ? acc * QSCALE0 : acc);
    } else if (MODE == 1) {
        float* X1 = (float*)(ws + WS_X1);
        const float* mod = (const float*)(ws + WS_MOD);
        const int br = (row < NLAT) ? (row >> 12) : 16;
        const float xin = (row < NLAT) ? P.x[(size_t)row * D + col] : P.ctx[(size_t)(row - NLAT) * D + col];
        X1[(size_t)row * D + col] = xin + mod[(size_t)br * 3072 + 2048 + col] * acc;
    } else if (MODE == 2) {
        bf16_t* O = (bf16_t*)(ws + WS_R1);
        const int grp = col >> 10;
        unsigned short o;
        if (grp == 0) o = (unsigned short)f2bf(siluf(acc) * QSCALE1);
        else if (grp == 2 || grp == 3) { const float lb = ((const float*)(ws + WS_LB))[col & 1023]; const float f = lb + (1.f - lb) / (1.f + __expf(-acc)); o = f2h(__log2f(f)); }
        else o = (unsigned short)f2bf(acc);
        O[(size_t)row * N1 + col] = o;
    } else {
        float* X1 = (float*)(ws + WS_X1);
        const float* mod = (const float*)(ws + WS_MOD) + (size_t)17 * 3072;
        const int br = row >> 12;
        X1[(size_t)row * D + col] += mod[(size_t)br * 3072 + 2048 + col] * acc;
    }
}

namespace pg8 {
#define PG8_LAS __attribute__((address_space(3)))
typedef unsigned short bf16_t;
typedef short bf16x8 __attribute__((ext_vector_type(8)));
typedef float f32x4 __attribute__((ext_vector_type(4)));
typedef unsigned u32x4 __attribute__((ext_vector_type(4)));
constexpr int BM = 256, BK = 64, HALF = 128, HTB = HALF * BK * 2  , STAGE_BYTES = 8 * HTB, NXCD = 8, WGM = 8;

__host__ __device__ __forceinline__ int lds_byte(int r, int c) { const int st = (r >> 4) * 2 + (c >> 5), rr = r & 15, cc = c & 31, ob = rr * 64 + cc * 2; return st * 1024 + (ob ^ (((ob >> 9) & 1) << 5)); }
__host__ __device__ __forceinline__ void stage_rc(int b, int& R, int& C) { const int st = b / 1024, sb = b % 1024, swz = sb ^ (((sb >> 9) & 1) << 5); R = (st >> 1) * 16 + swz / 64; C = (st & 1) * 32 + (swz % 64) / 2; }
__host__ __device__ __forceinline__ int perm32(int rho) { const int n = rho >> 4, i = rho & 15; return 8 * (i >> 2) + 4 * n + (i & 3); }

struct Unit { int pm, pn; };
struct Gemm { const bf16_t* A; const bf16_t* Bt; int M, N, K; };

struct StaticOrder {
    int nM, nN, nwg, G, c;
    __host__ __device__ void init(int M, int N, int G_, int c_) { nM = M / BM; nN = N / BM; nwg = nM * nN; G = G_; c = c_; }
    __host__ __device__ bool next(int i, Unit& u) const {
        const long L = (long)i * G + c; if (L >= nwg) return false;
        int wgid = (int)L; { const int q = nwg / NXCD, r = nwg % NXCD, xcd = wgid % NXCD, off = wgid / NXCD; wgid = (xcd < r ? xcd * (q + 1) : r * (q + 1) + (xcd - r) * q) + off; }
        const int nig = WGM * nN, gid = wgid / nig, fm = gid * WGM, gsz = (nM - fm) < WGM ? (nM - fm) : WGM;
        u.pm = fm + ((wgid % nig) % gsz); u.pn = (wgid % nig) / gsz; return true;
    }
    __device__ __forceinline__ void a_ready(const Unit&) const {}
    __device__ __forceinline__ void done(const Unit&) const {}
};


typedef float f32x2_t_ __attribute__((ext_vector_type(2))); typedef __bf16 bf16x2_t_ __attribute__((ext_vector_type(2)));
__device__ __forceinline__ unsigned cvt_pk_bf16(float lo, float hi) { f32x2_t_ v = {lo, hi}; bf16x2_t_ b = __builtin_convertvector(v, bf16x2_t_); return __builtin_bit_cast(unsigned, b); }
__device__ __forceinline__ unsigned cvt_pk_f16(float lo, float hi) { return (unsigned)__builtin_bit_cast(unsigned short, (_Float16)lo) | ((unsigned)__builtin_bit_cast(unsigned short, (_Float16)hi) << 16); }
struct EpiQKVZ {
    static constexpr bool PERM = true, AFTER_DRAIN = false;
    bf16_t* O;
    __device__ __forceinline__ void operator()(const f32x4 (&acc)[2][2][4][2], const Unit& u, int wr, int wc, int fr, int fq) const {
        const int row0 = u.pm * BM + wr * 64 + fr, col0 = u.pn * BM + wc * 32 + 8 * fq;
        const float sc = (u.pn < 4) ? QSCALE0 : 1.f;
#pragma unroll
        for (int ai = 0; ai < 2; ++ai)
#pragma unroll
            for (int m = 0; m < 4; ++m) { bf16_t* rowp = O + (size_t)(row0 + ai * HALF + m * 16) * N0 + col0;
#pragma unroll
                for (int bj = 0; bj < 2; ++bj) { const f32x4 v0 = acc[ai][bj][m][0] * sc, v1 = acc[ai][bj][m][1] * sc;
                    u32x4 w; w.x = cvt_pk_bf16(v0[0], v0[1]); w.y = cvt_pk_bf16(v0[2], v0[3]); w.z = cvt_pk_bf16(v1[0], v1[1]); w.w = cvt_pk_bf16(v1[2], v1[3]);
                    *(u32x4*)(rowp + bj * HALF) = w; } }
    }
};
struct EpiRes {
    static constexpr bool PERM = true, AFTER_DRAIN = false;
    bf16_t* Dl; const float* mod;
    __device__ __forceinline__ void operator()(const f32x4 (&acc)[2][2][4][2], const Unit& u, int wr, int wc, int fr, int fq) const {
        const int rowt = u.pm * BM; const int br = (rowt < NLAT) ? (rowt >> 12) : 16;
        const int row0 = rowt + wr * 64 + fr, col0 = u.pn * BM + wc * 32 + 8 * fq;
        f32x4 g[2][2];
#pragma unroll
        for (int bj = 0; bj < 2; ++bj)
#pragma unroll
            for (int n = 0; n < 2; ++n) g[bj][n] = *(const f32x4*)(mod + (size_t)br * 3072 + 2048 + col0 + bj * HALF + 4 * n);
#pragma unroll
        for (int ai = 0; ai < 2; ++ai)
#pragma unroll
            for (int m = 0; m < 4; ++m) { bf16_t* rowp = Dl + (size_t)(row0 + ai * HALF + m * 16) * D + col0;
#pragma unroll
                for (int bj = 0; bj < 2; ++bj) { const f32x4 v0 = acc[ai][bj][m][0] * g[bj][0], v1 = acc[ai][bj][m][1] * g[bj][1];
                    u32x4 w; w.x = cvt_pk_bf16(v0[0], v0[1]); w.y = cvt_pk_bf16(v0[2], v0[3]); w.z = cvt_pk_bf16(v1[0], v1[1]); w.w = cvt_pk_bf16(v1[2], v1[3]);
                    *(u32x4*)(rowp + bj * HALF) = w; } }
    }
};
struct EpiHG {
    static constexpr bool PERM = true, AFTER_DRAIN = false;
    unsigned short* O; const float* lb; int row_off, pn_off;
    __device__ __forceinline__ void operator()(const f32x4 (&acc)[2][2][4][2], const Unit& u, int wr, int wc, int fr, int fq) const {
        const int pn = u.pn + pn_off;
        const int row0 = row_off + u.pm * BM + wr * 64 + fr, col0 = pn * BM + wc * 32 + 8 * fq;
        const int grp = pn >> 2;
        if (grp == 2 || grp == 3) {
#pragma unroll
            for (int bj = 0; bj < 2; ++bj) {
                const f32x4 l0 = *(const f32x4*)(lb + ((col0 + bj * HALF) & 1023)), l1 = *(const f32x4*)(lb + ((col0 + bj * HALF) & 1023) + 4);
#pragma unroll
                for (int ai = 0; ai < 2; ++ai)
#pragma unroll
                    for (int m = 0; m < 4; ++m) { unsigned short* rowp = O + (size_t)(row0 + ai * HALF + m * 16) * N1 + col0 + bj * HALF;
                        const f32x4 v0 = acc[ai][bj][m][0], v1 = acc[ai][bj][m][1]; float r[8];
#pragma unroll
                        for (int e = 0; e < 4; ++e) { const float f0 = l0[e] + (1.f - l0[e]) * __builtin_amdgcn_rcpf(1.f + __expf(-v0[e])); r[e] = __log2f(f0);
                            const float f1 = l1[e] + (1.f - l1[e]) * __builtin_amdgcn_rcpf(1.f + __expf(-v1[e])); r[4 + e] = __log2f(f1); }
                        u32x4 w; w.x = cvt_pk_f16(r[0], r[1]); w.y = cvt_pk_f16(r[2], r[3]); w.z = cvt_pk_f16(r[4], r[5]); w.w = cvt_pk_f16(r[6], r[7]);
                        *(u32x4*)rowp = w; }
            }
        } else {
#pragma unroll
            for (int ai = 0; ai < 2; ++ai)
#pragma unroll
                for (int m = 0; m < 4; ++m) { unsigned short* rowp = O + (size_t)(row0 + ai * HALF + m * 16) * N1 + col0;
#pragma unroll
                    for (int bj = 0; bj < 2; ++bj) { f32x4 v0 = acc[ai][bj][m][0], v1 = acc[ai][bj][m][1];
                        if (grp == 0) {
#pragma unroll
                            for (int e = 0; e < 4; ++e) { v0[e] = v0[e] * QSCALE1 * __builtin_amdgcn_rcpf(1.f + __expf(-v0[e])); v1[e] = v1[e] * QSCALE1 * __builtin_amdgcn_rcpf(1.f + __expf(-v1[e])); } }
                        u32x4 w; w.x = cvt_pk_bf16(v0[0], v0[1]); w.y = cvt_pk_bf16(v0[2], v0[3]); w.z = cvt_pk_bf16(v1[0], v1[1]); w.w = cvt_pk_bf16(v1[2], v1[3]);
                        *(u32x4*)(rowp + bj * HALF) = w; } }
        }
    }
};
template <class Epi, class Sched, bool ALIGN_EPI = false, bool SP2 = false>
__device__ __forceinline__ void gemm_phase(PG8_LAS unsigned char* lds, const Gemm g, const Sched& S, const Epi& E) {
    const int tid = threadIdx.x, wid = __builtin_amdgcn_readfirstlane(tid >> 6), lane = tid & 63, wr = wid >> 2, wc = wid & 3, fr = lane & 15, fq = lane >> 4;
    const int K = g.K, nt = K / BK;
    unsigned voffA[2], voffB[2];
#pragma unroll
    for (int i = 0; i < 2; ++i) { int R, C; stage_rc(tid * 16 + i * 8192, R, C); const int Rb = Epi::PERM ? ((R & ~31) + perm32(R & 31)) : R;
        voffA[i] = (unsigned)(R * K + C) * 2u; voffB[i] = (unsigned)(Rb * K + C) * 2u; }
    const size_t kstep = (size_t)(BK * 2);
    const size_t hstep = (size_t)HALF * K * 2;
    const size_t tstep = 2 * hstep;
    const unsigned ldsw = (unsigned)wid * 1024u;
    const int aoff = lds_byte(wr * 64 + fr, fq * 8), boff = lds_byte(wc * 32 + fr, fq * 8);
#define PG8_SA(b, h) (((b) * 2 + (h)) * HTB)
#define PG8_SB(b, h) ((4 + (b) * 2 + (h)) * HTB)
#define PG8_STAGE(bufoff, gbase, voff) do { _Pragma("unroll") for (int _i = 0; _i < 2; ++_i) \
        __builtin_amdgcn_global_load_lds((const unsigned*)((const char*)(gbase) + (voff)[_i]), (PG8_LAS unsigned*)(lds + (bufoff) + ldsw + _i * 8192), 16, 0, 0); } while (0)
#define PG8_LDA(dst, b, h) do { _Pragma("unroll") for (int m = 0; m < 4; ++m) _Pragma("unroll") for (int k = 0; k < 2; ++k) dst[m][k] = *(const PG8_LAS bf16x8*)(lds + PG8_SA(b, h) + aoff + m * 2048 + k * 1024); } while (0)
#define PG8_LDB(dst, b, h) do { _Pragma("unroll") for (int n = 0; n < 2; ++n) _Pragma("unroll") for (int k = 0; k < 2; ++k) dst[n][k] = *(const PG8_LAS bf16x8*)(lds + PG8_SB(b, h) + boff + n * 2048 + k * 1024); } while (0)
#define PG8_MMA(ai, bj, At, Bt) do { __builtin_amdgcn_s_setprio(1); _Pragma("unroll") for (int m = 0; m < 4; ++m) _Pragma("unroll") for (int n = 0; n < 2; ++n) _Pragma("unroll") for (int k = 0; k < 2; ++k) \
        acc[ai][bj][m][n] = __builtin_amdgcn_mfma_f32_16x16x32_bf16(Bt[n][k], At[m][k], acc[ai][bj][m][n], 0, 0, 0); __builtin_amdgcn_s_setprio(0); } while (0)
#define PG8_WAIT_V(n) asm volatile("s_waitcnt vmcnt(" #n ")" ::: "memory")
#define PG8_WAIT_L(n) asm volatile("s_waitcnt lgkmcnt(" #n ")" ::: "memory")
#define PG8_BAR __builtin_amdgcn_s_barrier()
#define PG8_SCHED __builtin_amdgcn_sched_barrier(0)
    Unit cur, nxt; int ui = 0;
    if (!S.next(0, cur)) return;
    f32x4 acc[2][2][4][2];
#pragma unroll
    for (int a = 0; a < 2; ++a)
#pragma unroll
        for (int b = 0; b < 2; ++b)
#pragma unroll
            for (int m = 0; m < 4; ++m)
#pragma unroll
                for (int n = 0; n < 2; ++n) acc[a][b][m][n] = (f32x4){0.f, 0.f, 0.f, 0.f};
    bf16x8 At[4][2], B0[2][2], B1[2][2];
    const char* cA = (const char*)g.A + (size_t)cur.pm * tstep; const char* cB = (const char*)g.Bt + (size_t)cur.pn * tstep;
    S.a_ready(cur);
    if constexpr (SP2) {
        PG8_STAGE(PG8_SB(0, 0), cB, voffB); PG8_STAGE(PG8_SB(0, 1), cB + hstep, voffB); PG8_STAGE(PG8_SA(0, 0), cA, voffA); PG8_STAGE(PG8_SA(0, 1), cA + hstep, voffA);
        if (wr == 1) PG8_BAR;
        PG8_WAIT_V(2); PG8_BAR;
        PG8_STAGE(PG8_SB(1, 0), cB + kstep, voffB); PG8_STAGE(PG8_SA(1, 0), cA + kstep, voffA); PG8_STAGE(PG8_SB(1, 1), cB + hstep + kstep, voffB);
        PG8_WAIT_V(6); PG8_BAR;
    } else {
        PG8_STAGE(PG8_SB(0, 0), cB, voffB); PG8_STAGE(PG8_SA(0, 0), cA, voffA); PG8_STAGE(PG8_SB(0, 1), cB + hstep, voffB); PG8_STAGE(PG8_SA(0, 1), cA + hstep, voffA);
        if (wr == 1) PG8_BAR;
        PG8_WAIT_V(4); PG8_BAR;
        PG8_STAGE(PG8_SB(1, 0), cB + kstep, voffB); PG8_STAGE(PG8_SA(1, 0), cA + kstep, voffA); PG8_STAGE(PG8_SB(1, 1), cB + hstep + kstep, voffB);
        PG8_WAIT_V(6); PG8_BAR;
    }
    for (;;) {
        const bool has_next = S.next(ui + 1, nxt);
        const char* nA = has_next ? (const char*)g.A + (size_t)nxt.pm * tstep : cA; const char* nB = has_next ? (const char*)g.Bt + (size_t)nxt.pn * tstep : cB;
        for (int t = 0; t < nt; t += 2) {
            const bool last = (t == nt - 2);
            const char* a1 = cA + (size_t)(t + 1) * kstep;
            const char* a2 = last ? nA : cA + (size_t)(t + 2) * kstep; const char* b2 = last ? nB : cB + (size_t)(t + 2) * kstep;
            const char* a3 = a2 + kstep; const char* b3 = b2 + kstep;
            if (last && has_next) S.a_ready(nxt);
            if constexpr (SP2) {
            PG8_LDB(B0, 0, 0); PG8_LDB(B1, 0, 1); PG8_SCHED; PG8_LDA(At, 0, 0); PG8_STAGE(PG8_SA(1, 1), a1 + hstep, voffA);
            PG8_WAIT_V(8); PG8_WAIT_L(0); PG8_BAR; PG8_MMA(0, 0, At, B0); PG8_MMA(0, 1, At, B1); PG8_BAR; PG8_SCHED;
            PG8_LDA(At, 0, 1); PG8_STAGE(PG8_SB(0, 0), b2, voffB); PG8_STAGE(PG8_SB(0, 1), b2 + hstep, voffB); PG8_STAGE(PG8_SA(0, 0), a2, voffA);
            PG8_WAIT_V(8); PG8_WAIT_L(0); PG8_BAR; PG8_MMA(1, 0, At, B0); PG8_MMA(1, 1, At, B1); PG8_BAR; PG8_SCHED;
            PG8_LDB(B0, 1, 0); PG8_LDB(B1, 1, 1); PG8_SCHED; PG8_LDA(At, 1, 0); PG8_STAGE(PG8_SA(0, 1), a2 + hstep, voffA);
            PG8_WAIT_V(8); PG8_WAIT_L(0); PG8_BAR; PG8_MMA(0, 0, At, B0); PG8_MMA(0, 1, At, B1); PG8_BAR; PG8_SCHED;
            PG8_LDA(At, 1, 1); PG8_STAGE(PG8_SB(1, 0), b3, voffB); PG8_STAGE(PG8_SB(1, 1), b3 + hstep, voffB); PG8_STAGE(PG8_SA(1, 0), a3, voffA);
            PG8_WAIT_V(8); PG8_WAIT_L(0); PG8_BAR; PG8_MMA(1, 0, At, B0); PG8_MMA(1, 1, At, B1); PG8_BAR; PG8_SCHED;
            } else {
            PG8_LDB(B0, 0, 0); PG8_SCHED; PG8_LDA(At, 0, 0); PG8_STAGE(PG8_SA(1, 1), a1 + hstep, voffA);
            PG8_WAIT_L(8); PG8_BAR; PG8_WAIT_L(0); PG8_MMA(0, 0, At, B0); PG8_BAR; PG8_SCHED;
            PG8_LDB(B1, 0, 1); PG8_STAGE(PG8_SB(0, 0), b2, voffB);
            PG8_BAR; PG8_WAIT_L(0); PG8_MMA(0, 1, At, B1); PG8_BAR;
            PG8_LDA(At, 0, 1); PG8_STAGE(PG8_SA(0, 0), a2, voffA);
            PG8_BAR; PG8_WAIT_L(0); PG8_MMA(1, 0, At, B0); PG8_BAR; PG8_SCHED;
            PG8_STAGE(PG8_SB(0, 1), b2 + hstep, voffB);
            PG8_WAIT_V(6); PG8_BAR; PG8_MMA(1, 1, At, B1); PG8_BAR;
            PG8_LDB(B0, 1, 0); PG8_SCHED; PG8_LDA(At, 1, 0); PG8_STAGE(PG8_SA(0, 1), a2 + hstep, voffA);
            PG8_WAIT_L(8); PG8_BAR; PG8_WAIT_L(0); PG8_MMA(0, 0, At, B0); PG8_BAR; PG8_SCHED;
            PG8_LDB(B1, 1, 1); PG8_STAGE(PG8_SB(1, 0), b3, voffB);
            PG8_BAR; PG8_WAIT_L(0); PG8_MMA(0, 1, At, B1); PG8_BAR;
            PG8_LDA(At, 1, 1); PG8_STAGE(PG8_SA(1, 0), a3, voffA);
            PG8_BAR; PG8_WAIT_L(0); PG8_MMA(1, 0, At, B0); PG8_BAR; PG8_SCHED;
            PG8_STAGE(PG8_SB(1, 1), b3 + hstep, voffB);
            PG8_WAIT_V(6); PG8_BAR; PG8_MMA(1, 1, At, B1); PG8_BAR;
            }
        }
        if constexpr (ALIGN_EPI) { if (wr == 0) PG8_BAR; }
        if constexpr (!Epi::AFTER_DRAIN) { E(acc, cur, wr, wc, fr, fq); S.done(cur); }
        if (!has_next) break;
#pragma unroll
        for (int a = 0; a < 2; ++a)
#pragma unroll
            for (int b = 0; b < 2; ++b)
#pragma unroll
                for (int m = 0; m < 4; ++m)
#pragma unroll
                    for (int n = 0; n < 2; ++n) acc[a][b][m][n] = (f32x4){0.f, 0.f, 0.f, 0.f};
        cur = nxt; cA = nA; cB = nB; ++ui;
        if constexpr (ALIGN_EPI) { if (wr == 1) PG8_BAR; }
    }
    PG8_WAIT_V(0);
    if constexpr (!ALIGN_EPI) { if (wr == 0) PG8_BAR; }
    PG8_BAR;
    if constexpr (Epi::AFTER_DRAIN) { E.fused(acc, cur, wr, wc, fr, fq, lds, wid, lane); S.done(cur); }
#undef PG8_SA
#undef PG8_SB
#undef PG8_STAGE
#undef PG8_LDA
#undef PG8_LDB
#undef PG8_MMA
#undef PG8_WAIT_V
#undef PG8_WAIT_L
#undef PG8_BAR
#undef PG8_SCHED
}
}

template <int MODE> __device__ __forceinline__ void gemm_naive(const Params& P, const bf16_t* A, const bf16_t* Bt, int M, int N, int K, unsigned char* lds) {
    float* As = (float*)lds;
    float* Bs = As + 32 * 132;
    const int tid = threadIdx.x, ty = tid >> 5, tx = tid & 31;
    const int nTn = N / 128, ntiles = (M / 128) * nTn;
    for (int t = blockIdx.x; t < ntiles; t += gridDim.x) {
        const int tm = t / nTn, tn = t % nTn;
        float acc[8][4];
#pragma unroll
        for (int i = 0; i < 8; ++i)
#pragma unroll
            for (int j = 0; j < 4; ++j) acc[i][j] = 0.f;
        for (int k0 = 0; k0 < K; k0 += 32) {
            {
                const int r = tid >> 2, kc = (tid & 3) * 8;
                float f[8];
                unpack8(*(const u32x4*)(A + (size_t)(tm * 128 + r) * K + k0 + kc), f);
#pragma unroll
                for (int i = 0; i < 8; ++i) As[(kc + i) * 132 + r] = f[i];
                unpack8(*(const u32x4*)(Bt + (size_t)(tn * 128 + r) * K + k0 + kc), f);
#pragma unroll
                for (int i = 0; i < 8; ++i) Bs[(kc + i) * 132 + r] = f[i];
            }
            __syncthreads();
#pragma unroll 8
            for (int k = 0; k < 32; ++k) {
                const f32x4 a0 = *(const f32x4*)(As + k * 132 + ty * 8), a1 = *(const f32x4*)(As + k * 132 + ty * 8 + 4), b = *(const f32x4*)(Bs + k * 132 + tx * 4);
                const float a[8] = {a0.x, a0.y, a0.z, a0.w, a1.x, a1.y, a1.z, a1.w}; const float bb[4] = {b.x, b.y, b.z, b.w};
#pragma unroll
                for (int i = 0; i < 8; ++i)
#pragma unroll
                    for (int j = 0; j < 4; ++j) acc[i][j] += a[i] * bb[j];
            }
            __syncthreads();
        }
#pragma unroll
        for (int i = 0; i < 8; ++i)
#pragma unroll
            for (int j = 0; j < 4; ++j) epi_elem<MODE>(P, tm * 128 + ty * 8 + i, tn * 128 + tx * 4 + j, acc[i][j]);
    }
}

__device__ __forceinline__ void phase_na_naive(const Params& P, unsigned char* lds, bf16_t* Y) {
    const int tid = threadIdx.x, lane = tid & 63, wave = tid >> 6;
    float* rpbL = (float*)lds;
    for (int e = tid; e < 16 * 15 * 31; e += NTHREADS) rpbL[e] = P.na_rpb[e] * LOG2E;
    __syncthreads();
    const bf16_t* R = (const bf16_t*)(P.ws + WS_R1);
    const int gw = blockIdx.x * NWAVES + wave, NGW = gridDim.x * NWAVES;
    for (int u = gw; u < 16384 + 1024; u += NGW) {
        int b, h, r = 0, qtok, nloc, r0 = 0, cs = 0;
        if (u < 16384) { r = u & 63; h = (u >> 6) & 15; b = u >> 10; qtok = b * SEQ + r * 64 + lane; nloc = 128;
            r0 = min(max(r - 4, 0), 56); cs = min(max(lane - 8, 0), 48); }
        else { const int v = u - 16384; const int qb = v & 3; h = (v >> 2) & 15; b = v >> 6; qtok = NLAT + b * CTX + qb * 64 + lane; nloc = 0; }
        float q[64], O[64];
        {
            const bf16_t* qp = R + (size_t)qtok * N0 + h * 64;
#pragma unroll
            for (int i = 0; i < 8; ++i) unpack8(*(const u32x4*)(qp + 8 * i), q + 8 * i);
        }
#pragma unroll
        for (int d = 0; d < 64; ++d) O[d] = 0.f;
        float m = -1e30f, l = 0.f;
        const int nk = nloc + CTX;
        for (int kk = 0; kk < nk; ++kk) {
            int ktok; float s;
            if (kk < nloc) { const int kr = kk >> 4, j = kk & 15; ktok = b * SEQ + (r0 + kr) * 64 + cs + j; s = rpbL[h * 465 + (r0 + kr - r + 7) * 31 + (cs + j - lane + 15)]; }
            else { ktok = NLAT + b * CTX + (kk - nloc); s = 0.f; }
            const bf16_t* kp = R + (size_t)ktok * N0 + 1024 + h * 64;
#pragma unroll
            for (int i = 0; i < 8; ++i) { float f[8]; unpack8(*(const u32x4*)(kp + 8 * i), f);
#pragma unroll
                for (int j2 = 0; j2 < 8; ++j2) s += q[8 * i + j2] * f[j2]; }
            const float mn = fmaxf(m, s), alpha = exp2f(m - mn), p = exp2f(s - mn);
            l = l * alpha + p; m = mn;
            const bf16_t* vp = kp + 1024;
#pragma unroll
            for (int i = 0; i < 8; ++i) { float f[8]; unpack8(*(const u32x4*)(vp + 8 * i), f);
#pragma unroll
                for (int j2 = 0; j2 < 8; ++j2) O[8 * i + j2] = O[8 * i + j2] * alpha + p * f[j2]; }
        }
        const float rl = 1.f / l;
        const bf16_t* zp = R + (size_t)qtok * N0 + 3072 + h * 64;
        bf16_t* yp = Y + (size_t)qtok * D + h * 64;
#pragma unroll
        for (int i = 0; i < 8; ++i) { float z[8]; unpack8(*(const u32x4*)(zp + 8 * i), z);
            u32x4 o;
            o.x = pk2(O[8 * i + 0] * rl * siluf(z[0]), O[8 * i + 1] * rl * siluf(z[1]));
            o.y = pk2(O[8 * i + 2] * rl * siluf(z[2]), O[8 * i + 3] * rl * siluf(z[3]));
            o.z = pk2(O[8 * i + 4] * rl * siluf(z[4]), O[8 * i + 5] * rl * siluf(z[5]));
            o.w = pk2(O[8 * i + 6] * rl * siluf(z[6]), O[8 * i + 7] * rl * siluf(z[7]));
            *(u32x4*)(yp + 8 * i) = o; }
    }
}


typedef short bf16x8 __attribute__((ext_vector_type(8)));
typedef short v4i16 __attribute__((ext_vector_type(4)));
#define LAS __attribute__((address_space(3)))
__device__ __forceinline__ f32x4 mfma16(bf16x8 a, bf16x8 b, f32x4 c) { return __builtin_amdgcn_mfma_f32_16x16x32_bf16(a, b, c, 0, 0, 0); }
__device__ __forceinline__ bf16x8 pack8(const f32x4 a, const f32x4 b) { u32x4 w; w.x = cvtpk(a[0], a[1]); w.y = cvtpk(a[2], a[3]); w.z = cvtpk(b[0], b[1]); w.w = cvtpk(b[2], b[3]); return __builtin_bit_cast(bf16x8, w); }

__device__ __forceinline__ float max_q4(float v) {
    const unsigned u = __float_as_uint(v);
    auto r = __builtin_amdgcn_permlane16_swap(u, u, false, false);
    const float a = fmaxf(__uint_as_float(r[0]), __uint_as_float(r[1]));
    const unsigned ua = __float_as_uint(a);
    auto s = __builtin_amdgcn_permlane32_swap(ua, ua, false, false);
    return fmaxf(__uint_as_float(s[0]), __uint_as_float(s[1]));
}
template <bool LOCAL, int HALF>
__device__ __forceinline__ void na_step(const LAS unsigned char* Kt, const LAS unsigned char* Vt, const int (&koff)[2][2], const int (&voff)[4], const bf16x8 (&qf)[2][2],
                                        f32x4 (&O)[4][2], float (&m)[2], float (&l)[2], const LAS float* rpl, int l16, int q4) {
    constexpr int NKB = LOCAL ? 2 : 4;
    f32x4 s[2][NKB];
    float mx[2];
#pragma unroll
    for (int tl = 0; tl < 2; ++tl) {
        const int tb = 2 * HALF + tl;
        const int base = LOCAL ? (tb == 0 ? 0 : tb == 1 ? 8 : tb == 2 ? 24 : 32) : 0;
        const int sv = (base >> 3) & 1;
        const int qc = 16 * tb + l16, cs = min(max(qc - 8, 0), 48), dtb = 4 * q4 - cs;
        float bs[2][4];
        if (LOCAL) {
#pragma unroll
            for (int k2 = 0; k2 < 2; ++k2)
#pragma unroll
                for (int e = 0; e < 4; ++e) bs[k2][e] = rpl[(base - 16 * tb) + 16 * k2 + e];
            asm volatile("" : "+v"(bs[0][0]), "+v"(bs[0][1]), "+v"(bs[0][2]), "+v"(bs[0][3]), "+v"(bs[1][0]), "+v"(bs[1][1]), "+v"(bs[1][2]), "+v"(bs[1][3]));
        }
        float mxl = -1e30f;
#pragma unroll
        for (int k2 = 0; k2 < NKB; ++k2) {
            f32x4 a = {0.f, 0.f, 0.f, 0.f};
#pragma unroll
            for (int ks = 0; ks < 2; ++ks) {
                const bf16x8 kf = *(const LAS bf16x8*)(Kt + (base + 16 * k2) * 128 + koff[sv][ks]);
                a = mfma16(kf, qf[tl][ks], a);
            }
            if (LOCAL) {
#pragma unroll
                for (int e = 0; e < 4; ++e) { const bool valid = (unsigned)(dtb + (base + 16 * k2 + e)) < 16u; a[e] = valid ? a[e] + bs[k2 & 1][e] : -1e30f; }
            }
            s[tl][k2] = a; mxl = fmaxf(mxl, fmaxf(fmaxf(a[0], a[1]), fmaxf(a[2], a[3])));
        }
        mx[tl] = max_q4(mxl);
    }
    if (__any(mx[0] > m[0] + 8.f || mx[1] > m[1] + 8.f)) {
#pragma unroll
        for (int tl = 0; tl < 2; ++tl) {
            const float mn = fmaxf(m[tl], mx[tl]), alpha = __builtin_amdgcn_exp2f(m[tl] - mn); m[tl] = mn; l[tl] *= alpha;
#pragma unroll
            for (int db = 0; db < 4; ++db) O[db][tl] *= alpha;
        }
    }
    bf16x8 pb[2][NKB / 2];
#pragma unroll
    for (int tl = 0; tl < 2; ++tl) {
        const float mr = m[tl];
        float ps0 = 0.f, ps1 = 0.f;
#pragma unroll
        for (int k2 = 0; k2 < NKB; ++k2) {
#pragma unroll
            for (int e = 0; e < 4; ++e) { const float p = __builtin_amdgcn_exp2f(s[tl][k2][e] - mr); s[tl][k2][e] = p; if (e & 1) ps1 += p; else ps0 += p; }
        }
        l[tl] += ps0 + ps1;
#pragma unroll
        for (int kp = 0; kp < NKB / 2; ++kp) pb[tl][kp] = pack8(s[tl][2 * kp], s[tl][2 * kp + 1]);
    }
#pragma unroll
    for (int tl = 0; tl < 2; ++tl) {
        const int tb = 2 * HALF + tl;
        const int base = LOCAL ? (tb == 0 ? 0 : tb == 1 ? 8 : tb == 2 ? 24 : 32) : 0;
#pragma unroll
        for (int kp = 0; kp < NKB / 2; ++kp)
#pragma unroll
            for (int db = 0; db < 4; ++db) {
                const v4i16 lo = __builtin_amdgcn_ds_read_tr16_b64_v4i16((LAS v4i16*)(Vt + (base + 32 * kp) * 128 + voff[db]));
                const v4i16 hi = __builtin_amdgcn_ds_read_tr16_b64_v4i16((LAS v4i16*)(Vt + (base + 32 * kp + 16) * 128 + voff[db]));
                const bf16x8 vf = __builtin_shufflevector(lo, hi, 0, 1, 2, 3, 4, 5, 6, 7);
                O[db][tl] = mfma16(vf, pb[tl][kp], O[db][tl]);
            }
    }
}

template <int HALF>
__device__ __forceinline__ void na_unit(const Params& P, LAS unsigned char* ring, const LAS float* rpbL, bf16_t* Y, int b, int h, int r, int r0, int kr0, int nl, int qtok0, int lane, int wave) {
    const int l16 = lane & 15, q4 = lane >> 4;
    const char* R = (const char*)(P.ws + WS_R1);
    const int wq = wave & 3; const bool isv = wave >= 4;
    const unsigned rowoff = (unsigned)(16 * wq + (lane >> 3)) * (N0 * 2);
    const unsigned kofs_e = rowoff + (unsigned)(((lane & 7) ^ (lane >> 4)) * 16), kofs_o = rowoff + 8 * N0 * 2 + (unsigned)(((lane & 7) ^ (4 + (lane >> 4))) * 16);
    const unsigned vofs = rowoff + 2048 + (unsigned)((((((lane & 7) >> 1) ^ (lane >> 4)) & 3) << 1 | (lane & 1)) * 16);
    const unsigned src0 = isv ? vofs : kofs_e, src1 = isv ? vofs + 8 * N0 * 2 : kofs_o;
    const int dsto = (isv ? 8192 : 0) + wq * 2048;
    int koff[2][2];
#pragma unroll
    for (int sv = 0; sv < 2; ++sv)
#pragma unroll
        for (int ks = 0; ks < 2; ++ks) koff[sv][ks] = l16 * 128 + (((4 * ks + q4) ^ (((l16 >> 1) + 4 * sv) & 7)) * 16);
    const int vrow = 4 * q4 + (l16 >> 2), vsw = (2 * (q4 & 1) + (l16 >> 3)) & 3;
    int voff[4];
#pragma unroll
    for (int db = 0; db < 4; ++db) voff[db] = vrow * 128 + ((db ^ vsw) * 32) + (l16 & 3) * 8;
    const int nl2 = (nl + 1) >> 1, nsteps = nl2 + 2;
    const char* kbase = R + (size_t)(1024 + h * 64) * 2;
    auto tile_tok = [&](int s, int t) { return (s < nl2) ? (b * SEQ + min(kr0 + 2 * s + t, 63) * 64) : (NLAT + b * CTX + (2 * (s - nl2) + t) * 64); };
#define NA_DMA(s) do { _Pragma("unroll") for (int t_ = 0; t_ < 2; ++t_) { const char* kp_ = kbase + (size_t)tile_tok(s, t_) * (N0 * 2); LAS unsigned char* dst_ = ring + ((s) & 3) * 32768 + t_ * 16384 + dsto; \
        __builtin_amdgcn_global_load_lds((const unsigned*)(kp_ + src0), (LAS unsigned*)(dst_), 16, 0, 0); \
        __builtin_amdgcn_global_load_lds((const unsigned*)(kp_ + src1), (LAS unsigned*)(dst_ + 1024), 16, 0, 0); } } while (0)
    bf16x8 qf[2][2];
    {
        const bf16_t* qp = (const bf16_t*)R + (size_t)(qtok0 + 32 * HALF + l16) * N0 + h * 64 + 8 * q4;
#pragma unroll
        for (int tl = 0; tl < 2; ++tl)
#pragma unroll
            for (int ks = 0; ks < 2; ++ks) qf[tl][ks] = *(const bf16x8*)(qp + (size_t)tl * 16 * N0 + 32 * ks);
    }
    NA_DMA(0); NA_DMA(1);
    u32x2 zz[2][4];
#pragma unroll
    for (int tl = 0; tl < 2; ++tl)
#pragma unroll
        for (int db = 0; db < 4; ++db) zz[tl][db] = *(const u32x2*)((const bf16_t*)R + (size_t)(qtok0 + 32 * HALF + 16 * tl + l16) * N0 + 3072 + h * 64 + 16 * db + 4 * q4);
    f32x4 O[4][2]; float m[2], l[2];
#pragma unroll
    for (int tl = 0; tl < 2; ++tl) { m[tl] = -1e30f; l[tl] = 0.f;
#pragma unroll
        for (int db = 0; db < 4; ++db) O[db][tl] = (f32x4){0.f, 0.f, 0.f, 0.f}; }
#define NA_STEP_BEGIN(s) \
        if ((s) == 0 || (s) + 1 >= nsteps) asm volatile("s_waitcnt vmcnt(0) lgkmcnt(0)" ::: "memory"); else asm volatile("s_waitcnt vmcnt(4) lgkmcnt(0)" ::: "memory"); \
        __builtin_amdgcn_s_barrier(); asm volatile("" ::: "memory"); \
        if ((s) + 2 < nsteps) NA_DMA((s) + 2); \
        const LAS unsigned char* Kt0 = ring + ((s) & 3) * 32768;
    for (int s = 0; s < nl2; ++s) {
        NA_STEP_BEGIN(s)
#pragma unroll
        for (int t = 0; t < 2; ++t) {
            const int ti = 2 * s + t, kr = kr0 + ti;
            if (ti < nl && kr >= r0 && kr < r0 + 8) {
                const LAS unsigned char* Kt = Kt0 + t * 16384; const LAS unsigned char* Vt = Kt + 8192;
                int l16v = l16, q4v = q4; asm volatile("" : "+v"(l16v), "+v"(q4v));
                na_step<true, HALF>(Kt, Vt, koff, voff, qf, O, m, l, rpbL + (kr - r + 7) * 31 + (4 * q4v - l16v + 15), l16v, q4v);
            }
        }
    }
    for (int s = nl2; s < nsteps; ++s) {
        NA_STEP_BEGIN(s)
#pragma unroll
        for (int t = 0; t < 2; ++t) { const LAS unsigned char* Kt = Kt0 + t * 16384; const LAS unsigned char* Vt = Kt + 8192;
            na_step<false, HALF>(Kt, Vt, koff, voff, qf, O, m, l, rpbL, l16, q4); }
    }
#undef NA_STEP_BEGIN
#undef NA_DMA
#pragma unroll
    for (int tl = 0; tl < 2; ++tl) {
        float lt = l[tl]; lt += __shfl_xor(lt, 16); lt += __shfl_xor(lt, 32);
        const float rl = 1.f / lt;
        const size_t tok = (size_t)(qtok0 + 32 * HALF + 16 * tl + l16);
#pragma unroll
        for (int db = 0; db < 4; ++db) {
            const int col = h * 64 + 16 * db + 4 * q4;
            const u32x2 zv = zz[tl][db];
            const float z0 = __uint_as_float(zv.x << 16), z1 = __uint_as_float(zv.x & 0xffff0000u), z2 = __uint_as_float(zv.y << 16), z3 = __uint_as_float(zv.y & 0xffff0000u);
            const f32x4 o = O[db][tl] * rl;
            u32x2 w; w.x = cvtpk(o[0] * siluf(z0), o[1] * siluf(z1)); w.y = cvtpk(o[2] * siluf(z2), o[3] * siluf(z3));
            *(u32x2*)(Y + tok * D + col) = w; }
    }
}

__device__ __forceinline__ void phase_na_mfma(const Params& P, unsigned char* lds_, bf16_t* Y) {
    LAS unsigned char* lds = (LAS unsigned char*)lds_;
    const int tid = threadIdx.x, lane = tid & 63;
    const int wave = __builtin_amdgcn_readfirstlane(tid >> 6), pair = wave >> 1;
    LAS float* rpbL = (LAS float*)(lds + 64);
    LAS unsigned char* ring = lds + 2048;
    const int NITEM = 4096 + 256;
    const int vcu = (gridDim.x % 8 == 0) ? ((int)blockIdx.x % 8) * ((int)gridDim.x / 8) + (int)blockIdx.x / 8 : (int)blockIdx.x;
    for (int it = vcu; it < NITEM; it += gridDim.x) {
        int b, h, r = 0, r0 = 0, kr0 = 0, nl, qtok0;
        __syncthreads();
        if (it < 4096) { const int rq = it & 15; h = (it >> 4) & 15; b = it >> 8; r = rq * 4 + pair; r0 = min(max(r - 4, 0), 56); qtok0 = b * SEQ + r * 64;
            kr0 = min(max(rq * 4 - 4, 0), 56); nl = min(max(rq * 4 + 3 - 4, 0), 56) + 8 - kr0;
            for (int e = tid; e < 465; e += NTHREADS) rpbL[e] = P.na_rpb[h * 465 + e] * LOG2E;
            __syncthreads();
        } else { const int v = it - 4096; b = v >> 4; h = v & 15; nl = 0; qtok0 = NLAT + b * CTX + pair * 64; }
        if (wave & 1) na_unit<1>(P, ring, rpbL, Y, b, h, r, r0, kr0, nl, qtok0, lane, wave);
        else na_unit<0>(P, ring, rpbL, Y, b, h, r, r0, kr0, nl, qtok0, lane, wave);
    }
}

template <int DIR>
__device__ __forceinline__ void hgrn_item(const Params& P, unsigned char* lds_, bf16_t* Odst, const int b, const int h) {
    LAS unsigned char* lds = (LAS unsigned char*)lds_;
    const int tid = threadIdx.x, lane = tid & 63, l16 = lane & 15, q4 = lane >> 4;
    const int wave = __builtin_amdgcn_readfirstlane(tid >> 6);
    LAS unsigned char* QT = lds;
    LAS unsigned char* KT = lds + 16384;
    LAS unsigned char* KTT = lds + 32768;
    LAS unsigned char* VT = lds + 49152;
    LAS unsigned char* PT = lds + 65536;
    LAS float* DM = (LAS float*)(lds + 73728);
    LAS float* DL = DM + 128;
    LAS float* TOT = DL + 128;
#define HG_BAR() do { asm volatile("s_waitcnt lgkmcnt(0)" ::: "memory"); __builtin_amdgcn_s_barrier(); asm volatile("" ::: "memory"); } while (0)
    const unsigned short* R = (const unsigned short*)(P.ws + WS_R1);
    const int c = tid & 127, qtr = __builtin_amdgcn_readfirstlane(tid >> 7);
    const int cc = c & 31, pc = 32 * (c >> 5) + (((cc & 12) << 1) | ((cc >> 4) << 2) | (cc & 3));
    const int pc_chunk = pc >> 3, pc_in = (pc & 7) * 2;
    {
        f32x4 S[8];
#pragma unroll
        for (int mb = 0; mb < 8; ++mb) S[mb] = (f32x4){0.f, 0.f, 0.f, 0.f};
        unsigned short lfr[16], qr[16]; u32x4 vr[2];
#define HG_ROWLOW(ci_) ((ci_) < 4 ? (NLAT + b * CTX + (DIR ? CTX - 64 - (ci_) * 64 : (ci_) * 64)) : (b * SEQ + (DIR ? SEQ - 64 - ((ci_) - 4) * 64 : ((ci_) - 4) * 64)))
        const unsigned toff = (unsigned)((DIR ? 63 - 16 * qtr : 16 * qtr) * N1 + h * 128 + c);
        const unsigned voffg0 = (unsigned)((DIR ? 63 - (tid >> 4) : (tid >> 4)) * N1 + 1024 + h * 128 + (tid & 15) * 8);
        const unsigned ooff0 = (unsigned)((DIR ? 63 - l16 : l16) * D + h * 128 + 16 * wave + 4 * q4);
#define HG_LOAD_LF(ci_) do { const unsigned short* Rc = R + (size_t)HG_ROWLOW(ci_) * N1; \
        _Pragma("unroll") for (int j = 0; j < 16; ++j) lfr[j] = Rc[toff + (unsigned)((2 + DIR) * 1024 + (DIR ? -j : j) * N1)]; } while (0)
#define HG_LOAD_QV(ci_) do { const unsigned short* Rc = R + (size_t)HG_ROWLOW(ci_) * N1; \
        if ((ci_) >= 4) { _Pragma("unroll") for (int j = 0; j < 16; ++j) qr[j] = Rc[toff + (unsigned)((DIR ? -j : j) * N1)]; } \
        else { _Pragma("unroll") for (int j = 0; j < 16; ++j) qr[j] = (unsigned short)0; } \
        _Pragma("unroll") for (int i = 0; i < 2; ++i) vr[i] = *(const u32x4*)(Rc + (voffg0 + (unsigned)((DIR ? -32 : 32) * i * N1))); } while (0)
        HG_LOAD_LF(0); HG_LOAD_QV(0);
        for (int ci = 0; ci < 68; ++ci) {
            const bool is_ctx = ci < 4;
            float A[16]; float a = 0.f;
#pragma unroll
            for (int j = 0; j < 16; ++j) { a += h2f(lfr[j]); A[j] = a; }
            TOT[qtr * 128 + c] = a;
            if (ci + 1 < 68) HG_LOAD_LF(ci + 1);
            HG_BAR();
            {
                const float t0 = TOT[c], t1 = TOT[128 + c], t2 = TOT[256 + c], t3 = TOT[384 + c];
                const float off = (qtr > 0 ? t0 : 0.f) + (qtr > 1 ? t1 : 0.f) + (qtr > 2 ? t2 : 0.f);
                const float mid = t0 + t1, last = mid + t2 + t3;
                if (qtr == 0) { DM[c] = __builtin_amdgcn_exp2f(mid); DL[c] = __builtin_amdgcn_exp2f(last - mid); }
                float Eprev = __builtin_amdgcn_exp2f(fminf(fmaxf(mid - off, -100.f), 100.f));
                float kp[16];
                const int sw = (c >> 1) & 7;
#pragma unroll
                for (int j = 0; j < 16; ++j) {
                    const float Ej = __builtin_amdgcn_exp2f(fminf(fmaxf(mid - off - A[j], -100.f), 100.f));
                    kp[j] = Ej - Eprev; Eprev = Ej;
                    if ((j & 3) == 3) {
                        u32x2 w; w.x = cvtpk(kp[j - 3], kp[j - 2]); w.y = cvtpk(kp[j - 1], kp[j]);
                        *(LAS u32x2*)(KTT + c * 128 + (((2 * qtr + ((j >> 2) & 1)) ^ sw) * 16) + 8 * (j >> 3)) = w; }
                    const float qp = bf2f(qr[j]) * __builtin_amdgcn_rcpf(Ej);
                    const int byte = (16 * qtr + j) * 256 + ((pc_chunk ^ j) * 16) + pc_in;
                    const unsigned qk = cvtpk(qp, kp[j]);
                    *(LAS unsigned short*)(QT + byte) = (unsigned short)qk;
                    *(LAS unsigned short*)(KT + byte) = (unsigned short)(qk >> 16);
                }
#pragma unroll
                for (int i = 0; i < 2; ++i) { const int e = tid + NTHREADS * i, vrow = e >> 4, ch = e & 15;
                    *(LAS u32x4*)(VT + vrow * 256 + ((((ch >> 1) ^ (vrow & 7))) * 32) + (ch & 1) * 16) = vr[i]; }
            }
            if (ci + 1 < 68) HG_LOAD_QV(ci + 1);
            HG_BAR();
            if (!is_ctx) {
                const int tb = wave >> 1;
                bf16x8 qf[4];
#pragma unroll
                for (int ks = 0; ks < 4; ++ks) qf[ks] = *(const LAS bf16x8*)(QT + (16 * tb + l16) * 256 + (((4 * ks + q4) ^ l16) * 16));
#pragma unroll
                for (int k2 = 0; k2 < 2; ++k2) {
                    const int sb = 2 * (wave & 1) + k2;
                    f32x4 acc = {0.f, 0.f, 0.f, 0.f};
                    if (sb <= tb) {
#pragma unroll
                        for (int ks = 0; ks < 4; ++ks) { const bf16x8 kf = *(const LAS bf16x8*)(KT + (16 * sb + l16) * 256 + (((4 * ks + q4) ^ l16) * 16)); acc = mfma16(kf, qf[ks], acc); }
                        if (sb == tb) {
#pragma unroll
                            for (int e = 0; e < 4; ++e) if (4 * q4 + e > l16) acc[e] = 0.f;
                        }
                    }
                    u32x2 w; w.x = cvtpk(acc[0], acc[1]); w.y = cvtpk(acc[2], acc[3]);
                    const int t = 16 * tb + l16;
                    *(LAS u32x2*)(PT + t * 128 + (((2 * sb + (q4 & 1)) ^ ((t >> 1) & 7)) * 16) + 8 * (q4 >> 1)) = w;
                }
            }
            HG_BAR();
            {
#pragma unroll
                for (int mb = 0; mb < 8; ++mb) S[mb] *= *(const LAS f32x4*)(DM + 16 * mb + 4 * q4);
                bf16x8 vf[2];
#pragma unroll
                for (int ks2 = 0; ks2 < 2; ++ks2) {
                    const int row0 = 32 * ks2 + 16 * (q4 >> 1) + 4 * (q4 & 1) + (l16 >> 2);
                    const int un = (wave ^ (4 * (q4 & 1) + (l16 >> 2))) * 32 + (l16 & 3) * 8;
                    const v4i16 lo = __builtin_amdgcn_ds_read_tr16_b64_v4i16((LAS v4i16*)(VT + row0 * 256 + un));
                    const v4i16 hi = __builtin_amdgcn_ds_read_tr16_b64_v4i16((LAS v4i16*)(VT + (row0 + 8) * 256 + un));
                    vf[ks2] = __builtin_shufflevector(lo, hi, 0, 1, 2, 3, 4, 5, 6, 7);
                }
                if (!is_ctx) {
                    f32x4 o[4];
#pragma unroll
                    for (int tb = 0; tb < 4; ++tb) o[tb] = (f32x4){0.f, 0.f, 0.f, 0.f};
#pragma unroll
                    for (int ks = 0; ks < 4; ++ks) {
                        const bf16x8 sb16 = pack8(S[2 * ks], S[2 * ks + 1]);
#pragma unroll
                        for (int tb = 0; tb < 4; ++tb) { const bf16x8 qf = *(const LAS bf16x8*)(QT + (16 * tb + l16) * 256 + (((4 * ks + q4) ^ l16) * 16)); o[tb] = mfma16(sb16, qf, o[tb]); }
                    }
#pragma unroll
                    for (int ks2 = 0; ks2 < 2; ++ks2)
#pragma unroll
                        for (int tb = 0; tb < 4; ++tb) {
                            if (ks2 == 1 && tb < 2) continue;
                            const bf16x8 pf = *(const LAS bf16x8*)(PT + (16 * tb + l16) * 128 + (((4 * ks2 + q4) ^ ((l16 >> 1) & 7)) * 16)); o[tb] = mfma16(vf[ks2], pf, o[tb]); }
#pragma unroll
                    for (int tb = 0; tb < 4; ++tb) { u32x2 w; w.x = cvtpk(o[tb][0], o[tb][1]); w.y = cvtpk(o[tb][2], o[tb][3]);
                        *(u32x2*)(Odst + (size_t)HG_ROWLOW(ci) * D + (ooff0 + (unsigned)((DIR ? -16 : 16) * tb * D))) = w; }
                }
#pragma unroll
                for (int mb = 0; mb < 8; ++mb) {
#pragma unroll
                    for (int ks2 = 0; ks2 < 2; ++ks2) { const bf16x8 kt = *(const LAS bf16x8*)(KTT + (16 * mb + l16) * 128 + (((4 * ks2 + q4) ^ ((l16 >> 1) & 7)) * 16)); S[mb] = mfma16(kt, vf[ks2], S[mb]); }
                    S[mb] *= *(const LAS f32x4*)(DL + 16 * mb + 4 * q4);
                }
            }
            HG_BAR();
        }
#undef HG_LOAD_LF
#undef HG_LOAD_QV
#undef HG_BAR
#undef HG_ROWLOW
    }
}
template <int DIR, int HX>
__device__ __forceinline__ void hgrn_item_ws(const Params& P, unsigned char* lds_, bf16_t* Odst, const int b, const int h) {
    LAS unsigned char* lds = (LAS unsigned char*)lds_;
    const int tid = threadIdx.x, lane = tid & 63, l16 = lane & 15, q4 = lane >> 4;
    const int wave = __builtin_amdgcn_readfirstlane(tid >> 6);
    LAS unsigned char* PT = lds + 131072;
    LAS float* DMs = (LAS float*)(lds + 139264);
    LAS float* DLs = DMs + 256;
    LAS float* TOT = DLs + 256;
#define HG_BAR() do { asm volatile("s_waitcnt lgkmcnt(0)" ::: "memory"); __builtin_amdgcn_s_barrier(); asm volatile("" ::: "memory"); } while (0)
#define HG_ROWLOW(ci_) ((ci_) < 4 ? (NLAT + b * CTX + (DIR ? CTX - 64 - (ci_) * 64 : (ci_) * 64)) : (b * SEQ + (DIR ? SEQ - 64 - ((ci_) - 4) * 64 : ((ci_) - 4) * 64)))
    const unsigned short* R = (const unsigned short*)(P.ws + WS_R1);
    if (wave < 4) {
        const int cp = tid & 63, c0 = 2 * cp, qtr = wave;
        const int cc = c0 & 31, pc = 32 * (c0 >> 5) + (((cc & 12) << 1) | ((cc >> 4) << 2) | (cc & 3));
        const int pc_chunk = pc >> 3, pc_in = (pc & 7) * 2;
        const int sw = cp & 7;
        const unsigned toff = (unsigned)((DIR ? 63 - 16 * qtr : 16 * qtr) * N1 + h * 128 + c0);
        const unsigned voffg0 = (unsigned)((DIR ? 63 - (tid >> 4) : (tid >> 4)) * N1 + 1024 + h * 128 + (tid & 15) * 8);
        LAS float* TOT4 = TOT;
        unsigned lfA[16], qA[16], lfB[16], qB[16]; u32x4 vA[4], vB[4];
#define HG_LOAD(lfr, qr, vr, ci_) do { const unsigned short* Rc = R + (size_t)HG_ROWLOW(ci_) * N1; \
        { unsigned o_ = toff + (unsigned)((2 + DIR) * 1024); \
          _Pragma("unroll") for (int j = 0; j < 16; ++j) { lfr[j] = *(const unsigned*)(Rc + o_); o_ += (unsigned)(DIR ? -N1 : N1); asm volatile("" : "+v"(o_)); } } \
        if ((ci_) >= 4) { unsigned o_ = toff; \
          _Pragma("unroll") for (int j = 0; j < 16; ++j) { qr[j] = *(const unsigned*)(Rc + o_); o_ += (unsigned)(DIR ? -N1 : N1); asm volatile("" : "+v"(o_)); } } \
        else { _Pragma("unroll") for (int j = 0; j < 16; ++j) qr[j] = 0u; } \
        { unsigned o_ = voffg0; \
          _Pragma("unroll") for (int i = 0; i < 4; ++i) { vr[i] = *(const u32x4*)(Rc + o_); o_ += (unsigned)((DIR ? -16 : 16) * N1); asm volatile("" : "+v"(o_)); } } } while (0)
#define HG_GBODY(lfr, qr, vr, k) do { \
            if (HX != 1 && (k) < 68) {          \
                float a0 = 0.f, a1 = 0.f; \
                _Pragma("unroll") for (int j = 0; j < 16; ++j) { a0 += h2f((unsigned short)lfr[j]); a1 += h2f((unsigned short)(lfr[j] >> 16)); } \
                *(LAS f32x2_t*)(TOT4 + qtr * 128 + c0) = (f32x2_t){a0, a1}; \
            } \
            HG_BAR(); \
            if (HX != 1 && (k) < 68) {          \
                LAS unsigned char* QT = lds + ((k) & 1) * 65536; LAS unsigned char* KT = QT + 16384; LAS unsigned char* KTT = QT + 32768; LAS unsigned char* VT = QT + 49152; \
                const f32x2_t t0 = *(const LAS f32x2_t*)(TOT4 + c0), t1 = *(const LAS f32x2_t*)(TOT4 + 128 + c0), t2 = *(const LAS f32x2_t*)(TOT4 + 256 + c0), t3 = *(const LAS f32x2_t*)(TOT4 + 384 + c0); \
                const f32x2_t z2 = {0.f, 0.f}; \
                const f32x2_t off = (qtr > 0 ? t0 : z2) + (qtr > 1 ? t1 : z2) + (qtr > 2 ? t2 : z2), mid = t0 + t1, last = mid + t2 + t3; \
                if (qtr == 0) { *(LAS f32x2_t*)(DMs + ((k) & 1) * 128 + c0) = (f32x2_t){__builtin_amdgcn_exp2f(mid.x), __builtin_amdgcn_exp2f(mid.y)}; \
                                *(LAS f32x2_t*)(DLs + ((k) & 1) * 128 + c0) = (f32x2_t){__builtin_amdgcn_exp2f(last.x - mid.x), __builtin_amdgcn_exp2f(last.y - mid.y)}; } \
                float run0 = mid.x - off.x, run1 = mid.y - off.y; \
                float Ep0 = __builtin_amdgcn_exp2f(fminf(fmaxf(run0, -100.f), 100.f)), Ep1 = __builtin_amdgcn_exp2f(fminf(fmaxf(run1, -100.f), 100.f)); \
                float kp0[4], kp1[4]; \
                _Pragma("unroll") for (int j = 0; j < 16; ++j) { \
                    run0 -= h2f((unsigned short)lfr[j]); run1 -= h2f((unsigned short)(lfr[j] >> 16)); \
                    const float E0 = __builtin_amdgcn_exp2f(fminf(fmaxf(run0, -100.f), 100.f)), E1 = __builtin_amdgcn_exp2f(fminf(fmaxf(run1, -100.f), 100.f)); \
                    kp0[j & 3] = E0 - Ep0; Ep0 = E0; kp1[j & 3] = E1 - Ep1; Ep1 = E1; \
                    const float qp0 = __uint_as_float(qr[j] << 16) * __builtin_amdgcn_rcpf(E0), qp1 = __uint_as_float(qr[j] & 0xffff0000u) * __builtin_amdgcn_rcpf(E1); \
                    const int byte = (16 * qtr + j) * 256 + ((pc_chunk ^ j) * 16) + pc_in; \
                    *(LAS unsigned*)(QT + byte) = cvtpk(qp0, qp1); \
                    *(LAS unsigned*)(KT + byte) = cvtpk(kp0[j & 3], kp1[j & 3]); \
                    if ((j & 3) == 3) {        \
                        u32x2 w0, w1; w0.x = cvtpk(kp0[0], kp0[1]); w0.y = cvtpk(kp0[2], kp0[3]); w1.x = cvtpk(kp1[0], kp1[1]); w1.y = cvtpk(kp1[2], kp1[3]); \
                        const int ko = (((2 * qtr + ((j >> 2) & 1)) ^ sw) * 16) + 8 * (j >> 3); \
                        *(LAS u32x2*)(KTT + c0 * 128 + ko) = w0; *(LAS u32x2*)(KTT + (c0 + 1) * 128 + ko) = w1; \
                        __builtin_amdgcn_sched_barrier(0); } \
                } \
                _Pragma("unroll") for (int i = 0; i < 4; ++i) { const int e = tid + 256 * i, vrow = e >> 4, ch = e & 15; \
                    *(LAS u32x4*)(VT + vrow * 256 + ((((ch >> 1) ^ (vrow & 7))) * 32) + (ch & 1) * 16) = vr[i]; } \
                if ((k) + 2 < 68) HG_LOAD(lfr, qr, vr, (k) + 2); \
            } \
            HG_BAR(); } while (0)
        HG_LOAD(lfA, qA, vA, 0); HG_LOAD(lfB, qB, vB, 1);
        for (int k = 0; k < 68; k += 2) { HG_GBODY(lfA, qA, vA, k); HG_GBODY(lfB, qB, vB, k + 1); }
        HG_GBODY(lfA, qA, vA, 68);
#undef HG_GBODY
#undef HG_LOAD
    } else {
        const int mw = wave - 4;
        __builtin_amdgcn_s_setprio(2);
        f32x4 S[2][8];
#pragma unroll
        for (int vs = 0; vs < 2; ++vs)
#pragma unroll
            for (int mb = 0; mb < 8; ++mb) S[vs][mb] = (f32x4){0.f, 0.f, 0.f, 0.f};
        const unsigned ooff0 = (unsigned)((DIR ? 63 - l16 : l16) * D + h * 128 + 32 * mw + 4 * q4);
        for (int k = 0; k <= 68; ++k) {
            const int kc = k - 1;
            const bool live = (HX != 2) && kc >= 0, is_ctx = kc < 4;
            const LAS unsigned char* QT = lds + (kc & 1) * 65536; const LAS unsigned char* KT = QT + 16384; const LAS unsigned char* KTT = QT + 32768; const LAS unsigned char* VT = QT + 49152;
            if (live && !is_ctx) {
                const int tb = mw;
                bf16x8 qf[4];
#pragma unroll
                for (int ks = 0; ks < 4; ++ks) qf[ks] = *(const LAS bf16x8*)(QT + (16 * tb + l16) * 256 + (((4 * ks + q4) ^ l16) * 16));
#pragma unroll
                for (int sb = 0; sb < 4; ++sb) {
                    f32x4 acc = {0.f, 0.f, 0.f, 0.f};
                    if (sb <= tb) {
#pragma unroll
                        for (int ks = 0; ks < 4; ++ks) { const bf16x8 kf = *(const LAS bf16x8*)(KT + (16 * sb + l16) * 256 + (((4 * ks + q4) ^ l16) * 16)); acc = mfma16(kf, qf[ks], acc); }
                        if (sb == tb) {
#pragma unroll
                            for (int e = 0; e < 4; ++e) if (4 * q4 + e > l16) acc[e] = 0.f;
                        }
                    }
                    u32x2 w; w.x = cvtpk(acc[0], acc[1]); w.y = cvtpk(acc[2], acc[3]);
                    const int t = 16 * tb + l16;
                    *(LAS u32x2*)(PT + t * 128 + (((2 * sb + (q4 & 1)) ^ ((t >> 1) & 7)) * 16) + 8 * (q4 >> 1)) = w;
                }
            }
            HG_BAR();
            if (live) {
                const LAS float* DM = DMs + (kc & 1) * 128; const LAS float* DL = DLs + (kc & 1) * 128;
#pragma unroll
                for (int mb = 0; mb < 8; ++mb) { const f32x4 dm = *(const LAS f32x4*)(DM + 16 * mb + 4 * q4); S[0][mb] *= dm; S[1][mb] *= dm; }
                bf16x8 vf[2][2];
#pragma unroll
                for (int vs = 0; vs < 2; ++vs)
#pragma unroll
                    for (int ks2 = 0; ks2 < 2; ++ks2) {
                        const int row0 = 32 * ks2 + 16 * (q4 >> 1) + 4 * (q4 & 1) + (l16 >> 2);
                        const int un = ((2 * mw + vs) ^ (4 * (q4 & 1) + (l16 >> 2))) * 32 + (l16 & 3) * 8;
                        const v4i16 lo = __builtin_amdgcn_ds_read_tr16_b64_v4i16((LAS v4i16*)(VT + row0 * 256 + un));
                        const v4i16 hi = __builtin_amdgcn_ds_read_tr16_b64_v4i16((LAS v4i16*)(VT + (row0 + 8) * 256 + un));
                        vf[vs][ks2] = __builtin_shufflevector(lo, hi, 0, 1, 2, 3, 4, 5, 6, 7);
                    }
                if (!is_ctx) {
                    f32x4 o[2][4];
#pragma unroll
                    for (int vs = 0; vs < 2; ++vs)
#pragma unroll
                        for (int tb = 0; tb < 4; ++tb) o[vs][tb] = (f32x4){0.f, 0.f, 0.f, 0.f};
#pragma unroll
                    for (int ks = 0; ks < 4; ++ks) {
                        const bf16x8 s0 = pack8(S[0][2 * ks], S[0][2 * ks + 1]), s1 = pack8(S[1][2 * ks], S[1][2 * ks + 1]);
#pragma unroll
                        for (int tb = 0; tb < 4; ++tb) { const bf16x8 qf = *(const LAS bf16x8*)(QT + (16 * tb + l16) * 256 + (((4 * ks + q4) ^ l16) * 16));
                            o[0][tb] = mfma16(s0, qf, o[0][tb]); o[1][tb] = mfma16(s1, qf, o[1][tb]); }
                    }
#pragma unroll
                    for (int ks2 = 0; ks2 < 2; ++ks2)
#pragma unroll
                        for (int tb = 0; tb < 4; ++tb) {
                            if (ks2 == 1 && tb < 2) continue;
                            const bf16x8 pf = *(const LAS bf16x8*)(PT + (16 * tb + l16) * 128 + (((4 * ks2 + q4) ^ ((l16 >> 1) & 7)) * 16));
                            o[0][tb] = mfma16(vf[0][ks2], pf, o[0][tb]); o[1][tb] = mfma16(vf[1][ks2], pf, o[1][tb]); }
                    bf16_t* Oc = Odst + (size_t)HG_ROWLOW(kc) * D;
#pragma unroll
                    for (int vs = 0; vs < 2; ++vs)
#pragma unroll
                        for (int tb = 0; tb < 4; ++tb) { u32x2 w; w.x = cvtpk(o[vs][tb][0], o[vs][tb][1]); w.y = cvtpk(o[vs][tb][2], o[vs][tb][3]);
                            *(u32x2*)(Oc + (ooff0 + (unsigned)((DIR ? -16 : 16) * tb * D) + 16 * vs)) = w; }
                }
#pragma unroll
                for (int mb = 0; mb < 8; ++mb) {
#pragma unroll
                    for (int ks2 = 0; ks2 < 2; ++ks2) { const bf16x8 kt = *(const LAS bf16x8*)(KTT + (16 * mb + l16) * 128 + (((4 * ks2 + q4) ^ ((l16 >> 1) & 7)) * 16));
                        S[0][mb] = mfma16(kt, vf[0][ks2], S[0][mb]); S[1][mb] = mfma16(kt, vf[1][ks2], S[1][mb]); }
                    const f32x4 dl = *(const LAS f32x4*)(DL + 16 * mb + 4 * q4); S[0][mb] *= dl; S[1][mb] *= dl;
                }
            }
            HG_BAR();
        }
        __builtin_amdgcn_s_setprio(0);
    }
#undef HG_BAR
#undef HG_ROWLOW
}
template <int HX>
__device__ __forceinline__ void phase_hgrn_mfma(const Params& P, unsigned char* lds_, bf16_t* OF, bf16_t* OB) {
    for (int it = blockIdx.x; it < 256; it += gridDim.x) {
        const int b = it >> 4, h = (it >> 1) & 7, dir = it & 1;
        if (dir) hgrn_item_ws<1, HX>(P, lds_, OB, b, h); else hgrn_item_ws<0, HX>(P, lds_, OF, b, h);
        __syncthreads();
    }
}

__device__ __forceinline__ void phase_readout(const Params& P, bf16_t* OF, const bf16_t* OB) {
    const int tid = threadIdx.x, lane = tid & 63, wave = tid >> 6;
    const int gw = blockIdx.x * NWAVES + wave, NGW = gridDim.x * NWAVES;
    const bf16_t* R = (const bf16_t*)(P.ws + WS_R1);
    float hw[16];
#pragma unroll
    for (int i = 0; i < 16; ++i) hw[i] = P.hg_norm_w[(lane * 16 + i) & 127];
    const int per = (NLAT + NGW - 1) / NGW, rbeg = gw * per, rend = min(rbeg + per, NLAT);
    if (rbeg >= rend) return;
    u32x4 c[6], n[6];
#define RO_LOAD(dst, row) do { dst[0] = *(const u32x4*)(OF + (size_t)(row) * D + lane * 16); dst[1] = *(const u32x4*)(OF + (size_t)(row) * D + lane * 16 + 8); \
        dst[2] = *(const u32x4*)(OB + (size_t)(row) * D + lane * 16); dst[3] = *(const u32x4*)(OB + (size_t)(row) * D + lane * 16 + 8); \
        dst[4] = *(const u32x4*)(R + (size_t)(row) * N1 + 4096 + lane * 16); dst[5] = *(const u32x4*)(R + (size_t)(row) * N1 + 4096 + lane * 16 + 8); } while (0)
    RO_LOAD(c, rbeg);
    for (int row = rbeg; row < rend; ++row) {
        if (row + 1 < rend) RO_LOAD(n, row + 1);
        float o[16], g[16], t[16];
        unpack8(c[0], o); unpack8(c[1], o + 8); unpack8(c[2], t); unpack8(c[3], t + 8); unpack8(c[4], g); unpack8(c[5], g + 8);
        float ss = 0.f;
#pragma unroll
        for (int i = 0; i < 16; ++i) { o[i] += t[i]; ss += o[i] * o[i]; }
        ss += __shfl_xor(ss, 1); ss += __shfl_xor(ss, 2); ss += __shfl_xor(ss, 4);
        const float rstd = 1.f / sqrtf(ss * (1.f / 128.f) + EPS);
        float y[16];
#pragma unroll
        for (int i = 0; i < 16; ++i) y[i] = o[i] * rstd * hw[i] * g[i] * __builtin_amdgcn_rcpf(1.f + __expf(-g[i]));
        u32x4 w0, w1;
        w0.x = cvtpk(y[0], y[1]); w0.y = cvtpk(y[2], y[3]); w0.z = cvtpk(y[4], y[5]); w0.w = cvtpk(y[6], y[7]);
        w1.x = cvtpk(y[8], y[9]); w1.y = cvtpk(y[10], y[11]); w1.z = cvtpk(y[12], y[13]); w1.w = cvtpk(y[14], y[15]);
        *(u32x4*)(OF + (size_t)row * D + lane * 16) = w0; *(u32x4*)(OF + (size_t)row * D + lane * 16 + 8) = w1;
#pragma unroll
        for (int i = 0; i < 6; ++i) c[i] = n[i];
    }
#undef RO_LOAD
}

__device__ __forceinline__ void phase_final(const Params& P, const bf16_t* D0, const bf16_t* D1) {
    const int tid = threadIdx.x, lane = tid & 63, wave = tid >> 6;
    const int gw = blockIdx.x * NWAVES + wave, NGW = gridDim.x * NWAVES;
    const int per = (NLAT + NGW - 1) / NGW, rbeg = gw * per, rend = min(rbeg + per, NLAT);
    if (rbeg >= rend) return;
    f32x4 w[4], v0[4], v1[4], v2[4]; u32x2 a0[4], b0[4], a1[4], b1[4], a2[4], b2[4];
#define FIN_LOAD(vv, aa, bb, row) do { if ((row) < rend) { _Pragma("unroll") for (int j = 0; j < 4; ++j) { const size_t o_ = (size_t)(row) * D + lane * 4 + 256 * j; \
        vv[j] = *(const f32x4*)(P.x + o_); aa[j] = *(const u32x2*)(D0 + o_); bb[j] = *(const u32x2*)(D1 + o_); } } } while (0)
#define FIN_ROW(vv, aa, bb, row) do { if ((row) < rend) { float ss = 0.f; \
        _Pragma("unroll") for (int j = 0; j < 4; ++j) { \
            vv[j].x += __uint_as_float(aa[j].x << 16) + __uint_as_float(bb[j].x << 16); vv[j].y += __uint_as_float(aa[j].x & 0xffff0000u) + __uint_as_float(bb[j].x & 0xffff0000u); \
            vv[j].z += __uint_as_float(aa[j].y << 16) + __uint_as_float(bb[j].y << 16); vv[j].w += __uint_as_float(aa[j].y & 0xffff0000u) + __uint_as_float(bb[j].y & 0xffff0000u); \
            ss += (vv[j].x * vv[j].x + vv[j].y * vv[j].y) + (vv[j].z * vv[j].z + vv[j].w * vv[j].w); } \
        const float rstd = 1.f / sqrtf(wave_sum(ss) * (1.f / D) + EPS); \
        _Pragma("unroll") for (int j = 0; j < 4; ++j) *(f32x4*)(P.out + (size_t)(row) * D + lane * 4 + 256 * j) = (vv[j] * rstd) * w[j]; } } while (0)
#pragma unroll
    for (int j = 0; j < 4; ++j) w[j] = *(const f32x4*)(P.final_norm_w + lane * 4 + 256 * j);
    FIN_LOAD(v0, a0, b0, rbeg); FIN_LOAD(v1, a1, b1, rbeg + 1);
    for (int row = rbeg; row < rend; row += 3) {
        FIN_LOAD(v2, a2, b2, row + 2); FIN_ROW(v0, a0, b0, row);
        FIN_LOAD(v0, a0, b0, row + 3); FIN_ROW(v1, a1, b1, row + 1);
        FIN_LOAD(v1, a1, b1, row + 4); FIN_ROW(v2, a2, b2, row + 2);
    }
#undef FIN_ROW
#undef FIN_LOAD
}

#define XB_TMO      128
#define XB_XCNT(j)  (256  + 64 * (j))
#define XB_XSUB(j)  (1280 + 64 * (j))
#define XB_XGEN(j)  (2304 + 64 * (j))
#define XB_TOP      3328
#define XB_TOPGEN   3392
#define XCD_BAR_WORDS 3456
#define XB_SPIN_CAP (1u << 22)

__device__ __forceinline__ unsigned xb_ld(unsigned* p)              { return __hip_atomic_load(p, __ATOMIC_RELAXED, __HIP_MEMORY_SCOPE_AGENT); }
__device__ __forceinline__ unsigned xb_add(unsigned* p, unsigned v) { return __hip_atomic_fetch_add(p, v, __ATOMIC_RELAXED, __HIP_MEMORY_SCOPE_AGENT); }
__device__ __forceinline__ unsigned xb_xcc_id() { return (unsigned)__builtin_amdgcn_s_getreg((3 << 11) | 20) & 0xFu; }
#define XB_SPIN(cond, bar) do { unsigned _sp = 0; while (cond) { __builtin_amdgcn_s_sleep(1); \
    if ((++_sp & 255u) == 0u) { if (xb_ld(&(bar)[XB_TMO])) break; if (_sp > XB_SPIN_CAP) { atomicAdd(&(bar)[XB_TMO], 1u); break; } } } } while (0)

struct XcdBarrier {
    unsigned* bar; unsigned x;
    volatile LAS unsigned* st;
};

__device__ __forceinline__ XcdBarrier xcd_barrier_post(unsigned* bar, volatile LAS unsigned* st) {
    XcdBarrier b; b.bar = bar; b.x = xb_xcc_id(); b.st = st;
    if (threadIdx.x == 0) (void)xb_add(&bar[XB_XCNT(b.x)], 1u);
    return b;
}
__device__ __forceinline__ void xcd_barrier_complete(unsigned* bar, unsigned x, unsigned& nloc, unsigned& nx) {
    const unsigned G = gridDim.x * gridDim.y * gridDim.z;
    unsigned sum, cnt, mine, sp = 0u;
    for (;;) {
        sum = 0u; cnt = 0u; mine = 0u;
#pragma unroll
        for (unsigned j = 0; j < 16; ++j) { const unsigned c = xb_ld(&bar[XB_XCNT(j)]); sum += c; cnt += (c > 0u) ? 1u : 0u; mine = (j == x) ? c : mine; }
        if (sum == G) break;
        __builtin_amdgcn_s_sleep(1);
        if ((++sp & 255u) == 0u) { if (xb_ld(&bar[XB_TMO])) break; if (sp > XB_SPIN_CAP) { atomicAdd(&bar[XB_TMO], 1u); break; } }
    }
    nloc = mine > 0u ? mine : 1u; nx = cnt > 0u ? cnt : 1u;
}

__device__ __forceinline__ void xcd_barrier(const XcdBarrier& b) {
    asm volatile("s_waitcnt vmcnt(0)" ::: "memory");
    __syncthreads();
    if (threadIdx.x == 0) {
        unsigned* bar = b.bar;
        __builtin_amdgcn_s_waitcnt(0);
        unsigned nloc = b.st[0], nx = b.st[1];
        if (nloc == 0u) { xcd_barrier_complete(bar, b.x, nloc, nx); b.st[0] = nloc; b.st[1] = nx; }
        const unsigned old = xb_add(&bar[XB_XSUB(b.x)], 1u);
        const unsigned gen = old / nloc;
        if (old + 1u == (gen + 1u) * nloc) {
            __builtin_amdgcn_fence(__ATOMIC_RELEASE, "agent");
            asm volatile("s_waitcnt vmcnt(0)" ::: "memory");
            const unsigned og = xb_add(&bar[XB_TOP], 1u);
            const unsigned tg = og / nx;
            if (og + 1u == (tg + 1u) * nx) xb_add(&bar[XB_TOPGEN], 1u);
            else XB_SPIN(xb_ld(&bar[XB_TOPGEN]) == tg, bar);
            __builtin_amdgcn_fence(__ATOMIC_ACQUIRE, "agent");
            xb_add(&bar[XB_XGEN(b.x)], 1u);
            asm volatile("s_waitcnt vmcnt(0)" ::: "memory");
        } else {
            XB_SPIN(xb_ld(&bar[XB_XGEN(b.x)]) == gen, bar);
            __builtin_amdgcn_fence(__ATOMIC_ACQUIRE, "agent");
            asm volatile("s_waitcnt vmcnt(0)" ::: "memory");
        }
    }
    __syncthreads();
}

constexpr int NPHASE = 11;
__global__ void __launch_bounds__(NTHREADS, 2) fwd_megakernel(Params P) {
    extern __shared__ __attribute__((aligned(16))) unsigned char lds[];
    cg::grid_group grid = cg::this_grid();
    unsigned char* ws = P.ws;
    bf16_t* H = (bf16_t*)P.out;
    bf16_t* OF = (bf16_t*)P.out;
    bf16_t* OB = (bf16_t*)P.out + (size_t)NLAT * D;
    bf16_t* D0 = (bf16_t*)(ws + WS_X1);
    bf16_t* D1 = D0 + (size_t)MTOT * D;
    const int lo = P.ph_lo, hi = P.ph_hi;
    volatile LAS unsigned* bst = (volatile LAS unsigned*)((LAS unsigned char*)lds + LDS_BYTES - 64);
    if (threadIdx.x == 0) { bst[0] = 0u; bst[1] = 0u; }
    __syncthreads();
    if (lo > hi) grid.sync();
    const XcdBarrier xbar = xcd_barrier_post((unsigned*)ws, bst);
#define IN(k) (lo <= (k) && (k) < hi)
#define SEAM(k) do { if (IN(k) && IN((k) + 1)) xcd_barrier(xbar); STAMP(k); } while (0)
#if defined(DIAG_A)
    volatile unsigned long long* tsL = (volatile unsigned long long*)(lds + LDS_BYTES - 256);
#define STAMP(k) do { if (blockIdx.x == 0 && threadIdx.x == 0) tsL[(k) + 1] = __builtin_amdgcn_s_memrealtime(); } while (0)
    if (blockIdx.x == 0 && threadIdx.x == 0) tsL[0] = __builtin_amdgcn_s_memrealtime();
#else
#define STAMP(k) do {} while (0)
#endif
    if (IN(0)) phase_prologue(P, lds);
    SEAM(0);
    if (IN(1)) phase_modulate(P, 0, P.x, P.ctx, H, nullptr);
    SEAM(1);
    if (IN(2)) { pg8::Gemm g{H, (const bf16_t*)(ws + WS_W0T), MTOT, N0, D}; pg8::StaticOrder S; S.init(MTOT, N0, (int)gridDim.x, (int)blockIdx.x);
        pg8::EpiQKVZ E{(bf16_t*)(ws + WS_R1)}; pg8::gemm_phase<pg8::EpiQKVZ, pg8::StaticOrder, true, true>((PG8_LAS unsigned char*)lds, g, S, E); }
    SEAM(2);
    if (IN(3)) phase_na_mfma(P, lds, H);
    SEAM(3);
    if (IN(4)) { pg8::Gemm g{H, (const bf16_t*)(ws + WS_WO0T), MTOT, D, D}; pg8::StaticOrder S; S.init(MTOT, D, (int)gridDim.x, (int)blockIdx.x);
        pg8::EpiRes E{D0, (const float*)(ws + WS_MOD)}; pg8::gemm_phase<pg8::EpiRes, pg8::StaticOrder, true, true>((PG8_LAS unsigned char*)lds, g, S, E); }
    SEAM(4);
    if (IN(5)) phase_modulate(P, 1, P.x, P.ctx, H, D0);
    SEAM(5);
    if (IN(6)) {
        { pg8::Gemm g{H, (const bf16_t*)(ws + WS_W1T), NLAT, N1, D}; pg8::StaticOrder S; S.init(NLAT, N1, (int)gridDim.x, (int)blockIdx.x);
          pg8::EpiHG E{(unsigned short*)(ws + WS_R1), (const float*)(ws + WS_LB), 0, 0}; pg8::gemm_phase<pg8::EpiHG, pg8::StaticOrder, true, true>((PG8_LAS unsigned char*)lds, g, S, E); }
        { pg8::Gemm g{H + (size_t)NLAT * D, (const bf16_t*)(ws + WS_W1T) + (size_t)1024 * D, NCTX, 3072, D}; pg8::StaticOrder S; S.init(NCTX, 3072, (int)gridDim.x, (int)blockIdx.x);
          pg8::EpiHG E{(unsigned short*)(ws + WS_R1), (const float*)(ws + WS_LB), NLAT, 4}; pg8::gemm_phase<pg8::EpiHG, pg8::StaticOrder, true, true>((PG8_LAS unsigned char*)lds, g, S, E); }
    }
    SEAM(6);
#if defined(HG_XMODE)
    if (IN(7)) { phase_hgrn_mfma<HG_XMODE>(P, lds, OF, OB); xcd_barrier(xbar);
        if (blockIdx.x == 0 && threadIdx.x == 0) tsL[20] = __builtin_amdgcn_s_memrealtime(); }
#endif
    if (IN(7)) phase_hgrn_mfma<0>(P, lds, OF, OB);
    SEAM(7);
    if (IN(8)) phase_readout(P, OF, OB);
    SEAM(8);
    if (IN(9)) { pg8::Gemm g{OF, (const bf16_t*)(ws + WS_WO1T), NLAT, D, D}; pg8::StaticOrder S; S.init(NLAT, D, (int)gridDim.x, (int)blockIdx.x);
        pg8::EpiRes E{D1, (const float*)(ws + WS_MOD) + 17 * 3072}; pg8::gemm_phase<pg8::EpiRes, pg8::StaticOrder, true, true>((PG8_LAS unsigned char*)lds, g, S, E); }
    SEAM(9);
    if (IN(10)) phase_final(P, D0, D1);
#if defined(DIAG_A)
    if (blockIdx.x == 0 && threadIdx.x == 0) {
        const unsigned long long ta = (tsL[DIAG_A + 1] - tsL[DIAG_A]) / 100ull, tb = (tsL[DIAG_B + 1] - tsL[DIAG_B]) / 100ull;
#if defined(HG_XMODE)
        const unsigned long long spin = (tsL[20] - tsL[7]) * 50ull + 0ull * tb + 0ull * ta, t0 = __builtin_amdgcn_s_memrealtime();
#else
        const unsigned long long spin = (tsL[DIAG_A + 1] - tsL[DIAG_A]) * 50ull + 0ull * tb + 0ull * ta, t0 = __builtin_amdgcn_s_memrealtime();
#endif
        while (__builtin_amdgcn_s_memrealtime() - t0 < spin) __builtin_amdgcn_s_sleep(32);
    }
#endif
#undef IN
#undef SEAM
#undef STAMP
}

extern "C" void kernel_launch(void* const* d_in, const int* in_sizes, int n_in, void* d_out, int out_size, void* d_ws, size_t ws_size, hipStream_t stream) {
    static int grid = 0;
    if (grid == 0) {
        if (n_in != 15 || out_size != NLAT * D || ws_size < WS_END) { fprintf(stderr, "kernel_launch: unexpected sizes n_in %d out %d ws %zu\n", n_in, out_size, ws_size); grid = -1; return; }
        int dev = 0, cus = 0, per_cu = 0;
        (void)hipGetDevice(&dev);
        (void)hipDeviceGetAttribute(&cus, hipDeviceAttributeMultiprocessorCount, dev);
        (void)hipFuncSetAttribute((const void*)fwd_megakernel, hipFuncAttributeMaxDynamicSharedMemorySize, LDS_BYTES);
        (void)hipOccupancyMaxActiveBlocksPerMultiprocessor(&per_cu, (const void*)fwd_megakernel, NTHREADS, LDS_BYTES);
        if (per_cu < 1) per_cu = 1;
        (void)hipGetLastError();
        grid = cus * per_cu;
    }
    if (grid < 0) return;
    Params p{};
    p.x = (const float*)d_in[0]; p.c = (const float*)d_in[1]; p.ctx = (const float*)d_in[2]; p.c_ctx = (const float*)d_in[3];
    p.ada_w = (const float*)d_in[4]; p.ada_b = (const float*)d_in[5]; p.norm_w = (const float*)d_in[6]; p.na_w_in = (const float*)d_in[7];
    p.na_rpb = (const float*)d_in[8]; p.na_w_out = (const float*)d_in[9]; p.hg_w_in = (const float*)d_in[10]; p.hg_lower = (const float*)d_in[11];
    p.hg_norm_w = (const float*)d_in[12]; p.hg_w_out = (const float*)d_in[13]; p.final_norm_w = (const float*)d_in[14];
    p.out = (float*)d_out; p.ws = (unsigned char*)d_ws; p.ph_lo = 0; p.ph_hi = NPHASE;
    if (hipMemsetAsync(d_ws, 0, 65536, stream) != hipSuccess) { fprintf(stderr, "kernel_launch: memset failed\n"); return; }
    void* args[] = {&p};
    hipError_t e = hipLaunchCooperativeKernel((const void*)fwd_megakernel, dim3(grid), dim3(NTHREADS), args, LDS_BYTES, stream);
    if (e != hipSuccess) fprintf(stderr, "cooperative launch failed: %s (grid %d)\n", hipGetErrorString(e), grid);
}
```

```cpp
#include <hip/hip_runtime.h>
#include <hip/hip_cooperative_groups.h>
#include <cstdio>
#include <cstdint>
namespace cg = cooperative_groups;

typedef unsigned short bf16_t;
typedef float f32x4 __attribute__((ext_vector_type(4)));
typedef unsigned u32x4 __attribute__((ext_vector_type(4)));
typedef unsigned u32x2 __attribute__((ext_vector_type(2)));

constexpr int D = 1024, NB = 16, SEQ = 4096, CTX = 256;
constexpr int NLAT = NB * SEQ;
constexpr int NCTX = NB * CTX;
constexpr int MTOT = NLAT + NCTX;
constexpr int N0 = 4096, N1 = 5120;
constexpr float EPS = 1e-6f;
constexpr float LOG2E = 1.4426950408889634f;
constexpr float QSCALE0 = 0.125f * LOG2E;
constexpr float QSCALE1 = 0.08838834764831845f;
constexpr int NTHREADS = 512, NWAVES = 8;

constexpr size_t MiB = 1u << 20;
constexpr size_t WS_MOD = 1 * MiB;
constexpr size_t WS_LB = 1 * MiB + 512 * 1024;
constexpr size_t WS_W0T = 2 * MiB, WS_WO0T = 10 * MiB, WS_W1T = 12 * MiB, WS_WO1T = 22 * MiB;
constexpr size_t WS_X1 = 32 * MiB;
constexpr size_t WS_R1 = 304 * MiB;
constexpr size_t WS_END = 984 * MiB;
static_assert(WS_X1 + (size_t)MTOT * D * 4 <= WS_R1 && WS_R1 + (size_t)MTOT * N1 * 2 <= WS_END, "ws map");

constexpr int LDS_BYTES = 147456;

struct Params {
    const float *x, *c, *ctx, *c_ctx, *ada_w, *ada_b, *norm_w, *na_w_in, *na_rpb, *na_w_out, *hg_w_in, *hg_lower, *hg_norm_w, *hg_w_out, *final_norm_w;
    float* out; unsigned char* ws; int ph_lo, ph_hi;
};

__device__ __forceinline__ float bf2f(bf16_t v) { return __uint_as_float((unsigned)v << 16); }
__device__ __forceinline__ unsigned f2bf(float f) { unsigned u = __float_as_uint(f); return (u + 0x7fffu + ((u >> 16) & 1u)) >> 16; }
__device__ __forceinline__ unsigned pk2(float lo, float hi) { return f2bf(lo) | (f2bf(hi) << 16); }
typedef float f32x2_t __attribute__((ext_vector_type(2))); typedef __bf16 bf16x2_t __attribute__((ext_vector_type(2)));
__device__ __forceinline__ unsigned cvtpk(float lo, float hi) { f32x2_t v = {lo, hi}; bf16x2_t b = __builtin_convertvector(v, bf16x2_t); return __builtin_bit_cast(unsigned, b); }
__device__ __forceinline__ float h2f(unsigned short v) { return (float)__builtin_bit_cast(_Float16, v); }
__device__ __forceinline__ unsigned short f2h(float f) { return __builtin_bit_cast(unsigned short, (_Float16)f); }
__device__ __forceinline__ float siluf(float v) { return v / (1.f + __expf(-v)); }
__device__ __forceinline__ float wave_sum(float v) {
#pragma unroll
    for (int o = 1; o < 64; o <<= 1) v += __shfl_xor(v, o);
    return v;
}
__device__ __forceinline__ void unpack8(const u32x4 w, float* f) {
    f[0] = __uint_as_float(w.x << 16); f[1] = __uint_as_float(w.x & 0xffff0000u);
    f[2] = __uint_as_float(w.y << 16); f[3] = __uint_as_float(w.y & 0xffff0000u);
    f[4] = __uint_as_float(w.z << 16); f[5] = __uint_as_float(w.z & 0xffff0000u);
    f[6] = __uint_as_float(w.w << 16); f[7] = __uint_as_float(w.w & 0xffff0000u);
}

__device__ __forceinline__ void transpose_item(const float* W, int K, int N, bf16_t* WT, float* scr, int item, int lane) {
    const int nblk = N / 32, kb = item / nblk, nb = item % nblk, k0 = 64 * kb, n0 = 32 * nb;
#pragma unroll 8
    for (int i = 0; i < 32; ++i) { const int kk = 2 * i + (lane >> 5); scr[kk * 33 + (lane & 31)] = W[(size_t)(k0 + kk) * N + n0 + (lane & 31)]; }
    __builtin_amdgcn_wave_barrier();
    const int c = lane & 7;
#pragma unroll
    for (int j = 0; j < 4; ++j) { const int n = (lane >> 3) + 8 * j; const float* s = scr + (8 * c) * 33 + n;
        u32x4 o; o.x = pk2(s[0 * 33], s[1 * 33]); o.y = pk2(s[2 * 33], s[3 * 33]); o.z = pk2(s[4 * 33], s[5 * 33]); o.w = pk2(s[6 * 33], s[7 * 33]);
        *(u32x4*)(WT + (size_t)(n0 + n) * K + k0 + 8 * c) = o; }
    __builtin_amdgcn_wave_barrier();
}

__device__ __forceinline__ void phase_prologue(const Params& P, unsigned char* lds) {
    const int tid = threadIdx.x, lane = tid & 63, wave = tid >> 6;
    unsigned char* ws = P.ws;
    {
        float* scr = (float*)(lds) + wave * (64 * 33);
        const int gw = blockIdx.x * NWAVES + wave, NGW = gridDim.x * NWAVES;
        constexpr int I0 = (D / 64) * (N0 / 32), IO = (D / 64) * (D / 32), I1 = (D / 64) * (N1 / 32);
        constexpr int NIT = I0 + IO + I1 + IO;
        for (int it = gw; it < NIT; it += NGW) {
            int r = it;
            if (r < I0) { transpose_item(P.na_w_in, D, N0, (bf16_t*)(ws + WS_W0T), scr, r, lane); continue; } r -= I0;
            if (r < IO) { transpose_item(P.na_w_out, D, D, (bf16_t*)(ws + WS_WO0T), scr, r, lane); continue; } r -= IO;
            if (r < I1) { transpose_item(P.hg_w_in, D, N1, (bf16_t*)(ws + WS_W1T), scr, r, lane); continue; } r -= I1;
            transpose_item(P.hg_w_out, D, D, (bf16_t*)(ws + WS_WO1T), scr, r, lane);
        }
    }
    __syncthreads();
    {
        float* sc = (float*)lds;
        float* red = (float*)(lds + 17 * 1024 * 4);
        for (int e = tid; e < 17 * 1024; e += NTHREADS) { const int r = e >> 10, k = e & 1023; const float v = (r < 16) ? P.c[r * 1024 + k] : P.c_ctx[k]; sc[e] = siluf(v); }
        __syncthreads();
        float* mod = (float*)(ws + WS_MOD);
        for (int it = blockIdx.x; it < 2 * 48; it += gridDim.x) {
            const int l = it / 48, n0 = (it % 48) * 64;
            const float* W = P.ada_w + (size_t)l * 1024 * 3072 + n0 + lane;
            float acc[17];
#pragma unroll
            for (int r = 0; r < 17; ++r) acc[r] = 0.f;
            const int kb = wave * 128;
#pragma unroll 4
            for (int k = 0; k < 128; ++k) { const float w = W[(size_t)(kb + k) * 3072];
#pragma unroll
                for (int r = 0; r < 17; ++r) acc[r] += sc[r * 1024 + kb + k] * w; }
#pragma unroll
            for (int r = 0; r < 17; ++r) red[(wave * 17 + r) * 64 + lane] = acc[r];
            __syncthreads();
            for (int e = tid; e < 17 * 64; e += NTHREADS) { const int r = e >> 6, n = e & 63; float s = P.ada_b[l * 3072 + n0 + n];
#pragma unroll
                for (int w = 0; w < 8; ++w) s += red[(w * 17 + r) * 64 + n];
                mod[(size_t)(l * 17 + r) * 3072 + n0 + n] = s; }
            __syncthreads();
        }
    }
    if (blockIdx.x == gridDim.x - 1) {
        float* lb = (float*)(ws + WS_LB);
        for (int cidx = tid; cidx < 1024; cidx += NTHREADS) { const float l0 = P.hg_lower[cidx], l1 = P.hg_lower[1024 + cidx]; const float mx = fmaxf(l0, l1);
            const float e0 = __expf(l0 - mx), e1 = __expf(l1 - mx); const float p0 = e0 / (e0 + e1), p1 = e1 / (e0 + e1); lb[cidx] = (p0 + p1) - p0; }
    }
}

__device__ __forceinline__ void phase_modulate(const Params& P, int layer, const float* xlat, const float* xctx, bf16_t* H, const bf16_t* delta) {
    const int tid = threadIdx.x, lane = tid & 63, wave = tid >> 6;
    const int gw = blockIdx.x * NWAVES + wave, NGW = gridDim.x * NWAVES;
    const float* mod = (const float*)(P.ws + WS_MOD) + (size_t)layer * 17 * 3072;
    const float* nw = P.norm_w + layer * 1024;
    const int per = (MTOT + NGW - 1) / NGW, rbeg = gw * per, rend = min(rbeg + per, MTOT);
    if (rbeg >= rend) return;
    f32x4 g[4], sh[4]; int cur_br = -1;
    auto src_of = [&](int row) { return (row < NLAT) ? xlat + (size_t)row * D : xctx + (size_t)(row - NLAT) * D; };
    f32x4 v[4], nv[4]; u32x2 dv[4], ndv[4];
#pragma unroll
    for (int j = 0; j < 4; ++j) { v[j] = *(const f32x4*)(src_of(rbeg) + lane * 4 + 256 * j); dv[j] = delta ? *(const u32x2*)(delta + (size_t)rbeg * D + lane * 4 + 256 * j) : (u32x2){0u, 0u}; }
    for (int row = rbeg; row < rend; ++row) {
        if (row + 1 < rend) {
#pragma unroll
            for (int j = 0; j < 4; ++j) { nv[j] = *(const f32x4*)(src_of(row + 1) + lane * 4 + 256 * j); ndv[j] = delta ? *(const u32x2*)(delta + (size_t)(row + 1) * D + lane * 4 + 256 * j) : (u32x2){0u, 0u}; }
        }
        if (delta) {
#pragma unroll
            for (int j = 0; j < 4; ++j) { v[j].x += __uint_as_float(dv[j].x << 16); v[j].y += __uint_as_float(dv[j].x & 0xffff0000u); v[j].z += __uint_as_float(dv[j].y << 16); v[j].w += __uint_as_float(dv[j].y & 0xffff0000u); }
        }
        const int br = (row < NLAT) ? (row >> 12) : 16;
        if (br != cur_br) { cur_br = br; const float* shp = mod + (size_t)br * 3072; const float* scl = shp + 1024;
#pragma unroll
            for (int j = 0; j < 4; ++j) { const int c0 = lane * 4 + 256 * j; g[j] = *(const f32x4*)(nw + c0) * (*(const f32x4*)(scl + c0) + 1.f); sh[j] = *(const f32x4*)(shp + c0); } }
        float ss = 0.f;
#pragma unroll
        for (int j = 0; j < 4; ++j) ss += (v[j].x * v[j].x + v[j].y * v[j].y) + (v[j].z * v[j].z + v[j].w * v[j].w);
        const float rstd = 1.f / sqrtf(wave_sum(ss) * (1.f / D) + EPS);
#pragma unroll
        for (int j = 0; j < 4; ++j) { const int c0 = lane * 4 + 256 * j; const f32x4 h = (v[j] * rstd) * g[j] + sh[j];
            u32x2 o; o.x = cvtpk(h.x, h.y); o.y = cvtpk(h.z, h.w); *(u32x2*)(H + (size_t)row * D + c0) = o; }
#pragma unroll
        for (int j = 0; j < 4; ++j) { v[j] = nv[j]; dv[j] = ndv[j]; }
    }
}

template <int MODE> __device__ __forceinline__ void epi_elem(const Params& P, int row, int col, float acc) {
    unsigned char* ws = P.ws;
    if (MODE == 0) {
        bf16_t* O = (bf16_t*)(ws + WS_R1);
        O[(size_t)row * N0 + col] = (bf16_t)f2bf(col < 1024 ? acc * QSCALE0 : acc);
    } else if (MODE == 1) {
        float* X1 = (float*)(ws + WS_X1);
        const float* mod = (const float*)(ws + WS_MOD);
        const int br = (row < NLAT) ? (row >> 12) : 16;
        const float xin = (row < NLAT) ? P.x[(size_t)row * D + col] : P.ctx[(size_t)(row - NLAT) * D + col];
        X1[(size_t)row * D + col] = xin + mod[(size_t)br * 3072 + 2048 + col] * acc;
    } else if (MODE == 2) {
        bf16_t* O = (bf16_t*)(ws + WS_R1);
        const int grp = col >> 10;
        unsigned short o;
        if (grp == 0) o = (unsigned short)f2bf(siluf(acc) * QSCALE1);
        else if (grp == 2 || grp == 3) { const float lb = ((const float*)(ws + WS_LB))[col & 1023]; const float f = lb + (1.f - lb) / (1.f + __expf(-acc)); o = f2h(__log2f(f)); }
        else o = (unsigned short)f2bf(acc);
        O[(size_t)row * N1 + col] = o;
    } else {
        float* X1 = (float*)(ws + WS_X1);
        const float* mod = (const float*)(ws + WS_MOD) + (size_t)17 * 3072;
        const int br = row >> 12;
        X1[(size_t)row * D + col] += mod[(size_t)br * 3072 + 2048 + col] * acc;
    }
}

namespace pg8 {
#define PG8_LAS __attribute__((address_space(3)))
typedef unsigned short bf16_t;
typedef short bf16x8 __attribute__((ext_vector_type(8)));
typedef float f32x4 __attribute__((ext_vector_type(4)));
typedef unsigned u32x4 __attribute__((ext_vector_type(4)));
constexpr int BM = 256, BK = 64, HALF = 128, HTB = HALF * BK * 2  , STAGE_BYTES = 8 * HTB, NXCD = 8, WGM = 8;

__host__ __device__ __forceinline__ int lds_byte(int r, int c) { const int st = (r >> 4) * 2 + (c >> 5), rr = r & 15, cc = c & 31, ob = rr * 64 + cc * 2; return st * 1024 + (ob ^ (((ob >> 9) & 1) << 5)); }
__host__ __device__ __forceinline__ void stage_rc(int b, int& R, int& C) { const int st = b / 1024, sb = b % 1024, swz = sb ^ (((sb >> 9) & 1) << 5); R = (st >> 1) * 16 + swz / 64; C = (st & 1) * 32 + (swz % 64) / 2; }
__host__ __device__ __forceinline__ int perm32(int rho) { const int n = rho >> 4, i = rho & 15; return 8 * (i >> 2) + 4 * n + (i & 3); }

struct Unit { int pm, pn; };
struct Gemm { const bf16_t* A; const bf16_t* Bt; int M, N, K; };

struct StaticOrder {
    int nM, nN, nwg, G, c;
    __host__ __device__ void init(int M, int N, int G_, int c_) { nM = M / BM; nN = N / BM; nwg = nM * nN; G = G_; c = c_; }
    __host__ __device__ bool next(int i, Unit& u) const {
        const long L = (long)i * G + c; if (L >= nwg) return false;
        int wgid = (int)L; { const int q = nwg / NXCD, r = nwg % NXCD, xcd = wgid % NXCD, off = wgid / NXCD; wgid = (xcd < r ? xcd * (q + 1) : r * (q + 1) + (xcd - r) * q) + off; }
        const int nig = WGM * nN, gid = wgid / nig, fm = gid * WGM, gsz = (nM - fm) < WGM ? (nM - fm) : WGM;
        u.pm = fm + ((wgid % nig) % gsz); u.pn = (wgid % nig) / gsz; return true;
    }
    __device__ __forceinline__ void a_ready(const Unit&) const {}
    __device__ __forceinline__ void done(const Unit&) const {}
};


typedef float f32x2_t_ __attribute__((ext_vector_type(2))); typedef __bf16 bf16x2_t_ __attribute__((ext_vector_type(2)));
__device__ __forceinline__ unsigned cvt_pk_bf16(float lo, float hi) { f32x2_t_ v = {lo, hi}; bf16x2_t_ b = __builtin_convertvector(v, bf16x2_t_); return __builtin_bit_cast(unsigned, b); }
__device__ __forceinline__ unsigned cvt_pk_f16(float lo, float hi) { return (unsigned)__builtin_bit_cast(unsigned short, (_Float16)lo) | ((unsigned)__builtin_bit_cast(unsigned short, (_Float16)hi) << 16); }
struct EpiQKVZ {
    static constexpr bool PERM = true, AFTER_DRAIN = false;
    bf16_t* O;
    __device__ __forceinline__ void operator()(const f32x4 (&acc)[2][2][4][2], const Unit& u, int wr, int wc, int fr, int fq) const {
        const int row0 = u.pm * BM + wr * 64 + fr, col0 = u.pn * BM + wc * 32 + 8 * fq;
        const float sc = (u.pn < 4) ? QSCALE0 : 1.f;
#pragma unroll
        for (int ai = 0; ai < 2; ++ai)
#pragma unroll
            for (int m = 0; m < 4; ++m) { bf16_t* rowp = O + (size_t)(row0 + ai * HALF + m * 16) * N0 + col0;
#pragma unroll
                for (int bj = 0; bj < 2; ++bj) { const f32x4 v0 = acc[ai][bj][m][0] * sc, v1 = acc[ai][bj][m][1] * sc;
                    u32x4 w; w.x = cvt_pk_bf16(v0[0], v0[1]); w.y = cvt_pk_bf16(v0[2], v0[3]); w.z = cvt_pk_bf16(v1[0], v1[1]); w.w = cvt_pk_bf16(v1[2], v1[3]);
                    *(u32x4*)(rowp + bj * HALF) = w; } }
    }
};
struct EpiRes {
    static constexpr bool PERM = true, AFTER_DRAIN = false;
    bf16_t* Dl; const float* mod;
    __device__ __forceinline__ void operator()(const f32x4 (&acc)[2][2][4][2], const Unit& u, int wr, int wc, int fr, int fq) const {
        const int rowt = u.pm * BM; const int br = (rowt < NLAT) ? (rowt >> 12) : 16;
        const int row0 = rowt + wr * 64 + fr, col0 = u.pn * BM + wc * 32 + 8 * fq;
        f32x4 g[2][2];
#pragma unroll
        for (int bj = 0; bj < 2; ++bj)
#pragma unroll
            for (int n = 0; n < 2; ++n) g[bj][n] = *(const f32x4*)(mod + (size_t)br * 3072 + 2048 + col0 + bj * HALF + 4 * n);
#pragma unroll
        for (int ai = 0; ai < 2; ++ai)
#pragma unroll
            for (int m = 0; m < 4; ++m) { bf16_t* rowp = Dl + (size_t)(row0 + ai * HALF + m * 16) * D + col0;
#pragma unroll
                for (int bj = 0; bj < 2; ++bj) { const f32x4 v0 = acc[ai][bj][m][0] * g[bj][0], v1 = acc[ai][bj][m][1] * g[bj][1];
                    u32x4 w; w.x = cvt_pk_bf16(v0[0], v0[1]); w.y = cvt_pk_bf16(v0[2], v0[3]); w.z = cvt_pk_bf16(v1[0], v1[1]); w.w = cvt_pk_bf16(v1[2], v1[3]);
                    *(u32x4*)(rowp + bj * HALF) = w; } }
    }
};
struct EpiHG {
    static constexpr bool PERM = true, AFTER_DRAIN = false;
    unsigned short* O; const float* lb; int row_off, pn_off;
    __device__ __forceinline__ void operator()(const f32x4 (&acc)[2][2][4][2], const Unit& u, int wr, int wc, int fr, int fq) const {
        const int pn = u.pn + pn_off;
        const int row0 = row_off + u.pm * BM + wr * 64 + fr, col0 = pn * BM + wc * 32 + 8 * fq;
        const int grp = pn >> 2;
        if (grp == 2 || grp == 3) {
#pragma unroll
            for (int bj = 0; bj < 2; ++bj) {
                const f32x4 l0 = *(const f32x4*)(lb + ((col0 + bj * HALF) & 1023)), l1 = *(const f32x4*)(lb + ((col0 + bj * HALF) & 1023) + 4);
#pragma unroll
                for (int ai = 0; ai < 2; ++ai)
#pragma unroll
                    for (int m = 0; m < 4; ++m) { unsigned short* rowp = O + (size_t)(row0 + ai * HALF + m * 16) * N1 + col0 + bj * HALF;
                        const f32x4 v0 = acc[ai][bj][m][0], v1 = acc[ai][bj][m][1]; float r[8];
#pragma unroll
                        for (int e = 0; e < 4; ++e) { const float f0 = l0[e] + (1.f - l0[e]) * __builtin_amdgcn_rcpf(1.f + __expf(-v0[e])); r[e] = __log2f(f0);
                            const float f1 = l1[e] + (1.f - l1[e]) * __builtin_amdgcn_rcpf(1.f + __expf(-v1[e])); r[4 + e] = __log2f(f1); }
                        u32x4 w; w.x = cvt_pk_f16(r[0], r[1]); w.y = cvt_pk_f16(r[2], r[3]); w.z = cvt_pk_f16(r[4], r[5]); w.w = cvt_pk_f16(r[6], r[7]);
                        *(u32x4*)rowp = w; }
            }
        } else {
#pragma unroll
            for (int ai = 0; ai < 2; ++ai)
#pragma unroll
                for (int m = 0; m < 4; ++m) { unsigned short* rowp = O + (size_t)(row0 + ai * HALF + m * 16) * N1 + col0;
#pragma unroll
                    for (int bj = 0; bj < 2; ++bj) { f32x4 v0 = acc[ai][bj][m][0], v1 = acc[ai][bj][m][1];
                        if (grp == 0) {
#pragma unroll
                            for (int e = 0; e < 4; ++e) { v0[e] = v0[e] * QSCALE1 * __builtin_amdgcn_rcpf(1.f + __expf(-v0[e])); v1[e] = v1[e] * QSCALE1 * __builtin_amdgcn_rcpf(1.f + __expf(-v1[e])); } }
                        u32x4 w; w.x = cvt_pk_bf16(v0[0], v0[1]); w.y = cvt_pk_bf16(v0[2], v0[3]); w.z = cvt_pk_bf16(v1[0], v1[1]); w.w = cvt_pk_bf16(v1[2], v1[3]);
                        *(u32x4*)(rowp + bj * HALF) = w; } }
        }
    }
};
template <class Epi, class Sched, bool ALIGN_EPI = false, bool SP2 = false>
__device__ __forceinline__ void gemm_phase(PG8_LAS unsigned char* lds, const Gemm g, const Sched& S, const Epi& E) {
    const int tid = threadIdx.x, wid = __builtin_amdgcn_readfirstlane(tid >> 6), lane = tid & 63, wr = wid >> 2, wc = wid & 3, fr = lane & 15, fq = lane >> 4;
    const int K = g.K, nt = K / BK;
    unsigned voffA[2], voffB[2];
#pragma unroll
    for (int i = 0; i < 2; ++i) { int R, C; stage_rc(tid * 16 + i * 8192, R, C); const int Rb = Epi::PERM ? ((R & ~31) + perm32(R & 31)) : R;
        voffA[i] = (unsigned)(R * K + C) * 2u; voffB[i] = (unsigned)(Rb * K + C) * 2u; }
    const size_t kstep = (size_t)(BK * 2);
    const size_t hstep = (size_t)HALF * K * 2;
    const size_t tstep = 2 * hstep;
    const unsigned ldsw = (unsigned)wid * 1024u;
    const int aoff = lds_byte(wr * 64 + fr, fq * 8), boff = lds_byte(wc * 32 + fr, fq * 8);
#define PG8_SA(b, h) (((b) * 2 + (h)) * HTB)
#define PG8_SB(b, h) ((4 + (b) * 2 + (h)) * HTB)
#define PG8_STAGE(bufoff, gbase, voff) do { _Pragma("unroll") for (int _i = 0; _i < 2; ++_i) \
        __builtin_amdgcn_global_load_lds((const unsigned*)((const char*)(gbase) + (voff)[_i]), (PG8_LAS unsigned*)(lds + (bufoff) + ldsw + _i * 8192), 16, 0, 0); } while (0)
#define PG8_LDA(dst, b, h) do { _Pragma("unroll") for (int m = 0; m < 4; ++m) _Pragma("unroll") for (int k = 0; k < 2; ++k) dst[m][k] = *(const PG8_LAS bf16x8*)(lds + PG8_SA(b, h) + aoff + m * 2048 + k * 1024); } while (0)
#define PG8_LDB(dst, b, h) do { _Pragma("unroll") for (int n = 0; n < 2; ++n) _Pragma("unroll") for (int k = 0; k < 2; ++k) dst[n][k] = *(const PG8_LAS bf16x8*)(lds + PG8_SB(b, h) + boff + n * 2048 + k * 1024); } while (0)
#define PG8_MMA(ai, bj, At, Bt) do { __builtin_amdgcn_s_setprio(1); _Pragma("unroll") for (int m = 0; m < 4; ++m) _Pragma("unroll") for (int n = 0; n < 2; ++n) _Pragma("unroll") for (int k = 0; k < 2; ++k) \
        acc[ai][bj][m][n] = __builtin_amdgcn_mfma_f32_16x16x32_bf16(Bt[n][k], At[m][k], acc[ai][bj][m][n], 0, 0, 0); __builtin_amdgcn_s_setprio(0); } while (0)
#define PG8_WAIT_V(n) asm volatile("s_waitcnt vmcnt(" #n ")" ::: "memory")
#define PG8_WAIT_L(n) asm volatile("s_waitcnt lgkmcnt(" #n ")" ::: "memory")
#define PG8_BAR __builtin_amdgcn_s_barrier()
#define PG8_SCHED __builtin_amdgcn_sched_barrier(0)
    Unit cur, nxt; int ui = 0;
    if (!S.next(0, cur)) return;
    f32x4 acc[2][2][4][2];
#pragma unroll
    for (int a = 0; a < 2; ++a)
#pragma unroll
        for (int b = 0; b < 2; ++b)
#pragma unroll
            for (int m = 0; m < 4; ++m)
#pragma unroll
                for (int n = 0; n < 2; ++n) acc[a][b][m][n] = (f32x4){0.f, 0.f, 0.f, 0.f};
    bf16x8 At[4][2], B0[2][2], B1[2][2];
    const char* cA = (const char*)g.A + (size_t)cur.pm * tstep; const char* cB = (const char*)g.Bt + (size_t)cur.pn * tstep;
    S.a_ready(cur);
    if constexpr (SP2) {
        PG8_STAGE(PG8_SB(0, 0), cB, voffB); PG8_STAGE(PG8_SB(0, 1), cB + hstep, voffB); PG8_STAGE(PG8_SA(0, 0), cA, voffA); PG8_STAGE(PG8_SA(0, 1), cA + hstep, voffA);
        if (wr == 1) PG8_BAR;
        PG8_WAIT_V(2); PG8_BAR;
        PG8_STAGE(PG8_SB(1, 0), cB + kstep, voffB); PG8_STAGE(PG8_SA(1, 0), cA + kstep, voffA); PG8_STAGE(PG8_SB(1, 1), cB + hstep + kstep, voffB);
        PG8_WAIT_V(6); PG8_BAR;
    } else {
        PG8_STAGE(PG8_SB(0, 0), cB, voffB); PG8_STAGE(PG8_SA(0, 0), cA, voffA); PG8_STAGE(PG8_SB(0, 1), cB + hstep, voffB); PG8_STAGE(PG8_SA(0, 1), cA + hstep, voffA);
        if (wr == 1) PG8_BAR;
        PG8_WAIT_V(4); PG8_BAR;
        PG8_STAGE(PG8_SB(1, 0), cB + kstep, voffB); PG8_STAGE(PG8_SA(1, 0), cA + kstep, voffA); PG8_STAGE(PG8_SB(1, 1), cB + hstep + kstep, voffB);
        PG8_WAIT_V(6); PG8_BAR;
    }
    for (;;) {
        const bool has_next = S.next(ui + 1, nxt);
        const char* nA = has_next ? (const char*)g.A + (size_t)nxt.pm * tstep : cA; const char* nB = has_next ? (const char*)g.Bt + (size_t)nxt.pn * tstep : cB;
        for (int t = 0; t < nt; t += 2) {
            const bool last = (t == nt - 2);
            const char* a1 = cA + (size_t)(t + 1) * kstep;
            const char* a2 = last ? nA : cA + (size_t)(t + 2) * kstep; const char* b2 = last ? nB : cB + (size_t)(t + 2) * kstep;
            const char* a3 = a2 + kstep; const char* b3 = b2 + kstep;
            if (last && has_next) S.a_ready(nxt);
            if constexpr (SP2) {
            PG8_LDB(B0, 0, 0); PG8_LDB(B1, 0, 1); PG8_SCHED; PG8_LDA(At, 0, 0); PG8_STAGE(PG8_SA(1, 1), a1 + hstep, voffA);
            PG8_WAIT_V(8); PG8_WAIT_L(0); PG8_BAR; PG8_MMA(0, 0, At, B0); PG8_MMA(0, 1, At, B1); PG8_BAR; PG8_SCHED;
            PG8_LDA(At, 0, 1); PG8_STAGE(PG8_SB(0, 0), b2, voffB); PG8_STAGE(PG8_SB(0, 1), b2 + hstep, voffB); PG8_STAGE(PG8_SA(0, 0), a2, voffA);
            PG8_WAIT_V(8); PG8_WAIT_L(0); PG8_BAR; PG8_MMA(1, 0, At, B0); PG8_MMA(1, 1, At, B1); PG8_BAR; PG8_SCHED;
            PG8_LDB(B0, 1, 0); PG8_LDB(B1, 1, 1); PG8_SCHED; PG8_LDA(At, 1, 0); PG8_STAGE(PG8_SA(0, 1), a2 + hstep, voffA);
            PG8_WAIT_V(8); PG8_WAIT_L(0); PG8_BAR; PG8_MMA(0, 0, At, B0); PG8_MMA(0, 1, At, B1); PG8_BAR; PG8_SCHED;
            PG8_LDA(At, 1, 1); PG8_STAGE(PG8_SB(1, 0), b3, voffB); PG8_STAGE(PG8_SB(1, 1), b3 + hstep, voffB); PG8_STAGE(PG8_SA(1, 0), a3, voffA);
            PG8_WAIT_V(8); PG8_WAIT_L(0); PG8_BAR; PG8_MMA(1, 0, At, B0); PG8_MMA(1, 1, At, B1); PG8_BAR; PG8_SCHED;
            } else {
            PG8_LDB(B0, 0, 0); PG8_SCHED; PG8_LDA(At, 0, 0); PG8_STAGE(PG8_SA(1, 1), a1 + hstep, voffA);
            PG8_WAIT_L(8); PG8_BAR; PG8_WAIT_L(0); PG8_MMA(0, 0, At, B0); PG8_BAR; PG8_SCHED;
            PG8_LDB(B1, 0, 1); PG8_STAGE(PG8_SB(0, 0), b2, voffB);
            PG8_BAR; PG8_WAIT_L(0); PG8_MMA(0, 1, At, B1); PG8_BAR;
            PG8_LDA(At, 0, 1); PG8_STAGE(PG8_SA(0, 0), a2, voffA);
            PG8_BAR; PG8_WAIT_L(0); PG8_MMA(1, 0, At, B0); PG8_BAR; PG8_SCHED;
            PG8_STAGE(PG8_SB(0, 1), b2 + hstep, voffB);
            PG8_WAIT_V(6); PG8_BAR; PG8_MMA(1, 1, At, B1); PG8_BAR;
            PG8_LDB(B0, 1, 0); PG8_SCHED; PG8_LDA(At, 1, 0); PG8_STAGE(PG8_SA(0, 1), a2 + hstep, voffA);
            PG8_WAIT_L(8); PG8_BAR; PG8_WAIT_L(0); PG8_MMA(0, 0, At, B0); PG8_BAR; PG8_SCHED;
            PG8_LDB(B1, 1, 1); PG8_STAGE(PG8_SB(1, 0), b3, voffB);
            PG8_BAR; PG8_WAIT_L(0); PG8_MMA(0, 1, At, B1); PG8_BAR;
            PG8_LDA(At, 1, 1); PG8_STAGE(PG8_SA(1, 0), a3, voffA);
            PG8_BAR; PG8_WAIT_L(0); PG8_MMA(1, 0, At, B0); PG8_BAR; PG8_SCHED;
            PG8_STAGE(PG8_SB(1, 1), b3 + hstep, voffB);
            PG8_WAIT_V(6); PG8_BAR; PG8_MMA(1, 1, At, B1); PG8_BAR;
            }
        }
        if constexpr (ALIGN_EPI) { if (wr == 0) PG8_BAR; }
        if constexpr (!Epi::AFTER_DRAIN) { E(acc, cur, wr, wc, fr, fq); S.done(cur); }
        if (!has_next) break;
#pragma unroll
        for (int a = 0; a < 2; ++a)
#pragma unroll
            for (int b = 0; b < 2; ++b)
#pragma unroll
                for (int m = 0; m < 4; ++m)
#pragma unroll
                    for (int n = 0; n < 2; ++n) acc[a][b][m][n] = (f32x4){0.f, 0.f, 0.f, 0.f};
        cur = nxt; cA = nA; cB = nB; ++ui;
        if constexpr (ALIGN_EPI) { if (wr == 1) PG8_BAR; }
    }
    PG8_WAIT_V(0);
    if constexpr (!ALIGN_EPI) { if (wr == 0) PG8_BAR; }
    PG8_BAR;
    if constexpr (Epi::AFTER_DRAIN) { E.fused(acc, cur, wr, wc, fr, fq, lds, wid, lane); S.done(cur); }
#undef PG8_SA
#undef PG8_SB
#undef PG8_STAGE
#undef PG8_LDA
#undef PG8_LDB
#undef PG8_MMA
#undef PG8_WAIT_V
#undef PG8_WAIT_L
#undef PG8_BAR
#undef PG8_SCHED
}
}

template <int MODE> __device__ __forceinline__ void gemm_naive(const Params& P, const bf16_t* A, const bf16_t* Bt, int M, int N, int K, unsigned char* lds) {
    float* As = (float*)lds;
    float* Bs = As + 32 * 132;
    const int tid = threadIdx.x, ty = tid >> 5, tx = tid & 31;
    const int nTn = N / 128, ntiles = (M / 128) * nTn;
    for (int t = blockIdx.x; t < ntiles; t += gridDim.x) {
        const int tm = t / nTn, tn = t % nTn;
        float acc[8][4];
#pragma unroll
        for (int i = 0; i < 8; ++i)
#pragma unroll
            for (int j = 0; j < 4; ++j) acc[i][j] = 0.f;
        for (int k0 = 0; k0 < K; k0 += 32) {
            {
                const int r = tid >> 2, kc = (tid & 3) * 8;
                float f[8];
                unpack8(*(const u32x4*)(A + (size_t)(tm * 128 + r) * K + k0 + kc), f);
#pragma unroll
                for (int i = 0; i < 8; ++i) As[(kc + i) * 132 + r] = f[i];
                unpack8(*(const u32x4*)(Bt + (size_t)(tn * 128 + r) * K + k0 + kc), f);
#pragma unroll
                for (int i = 0; i < 8; ++i) Bs[(kc + i) * 132 + r] = f[i];
            }
            __syncthreads();
#pragma unroll 8
            for (int k = 0; k < 32; ++k) {
                const f32x4 a0 = *(const f32x4*)(As + k * 132 + ty * 8), a1 = *(const f32x4*)(As + k * 132 + ty * 8 + 4), b = *(const f32x4*)(Bs + k * 132 + tx * 4);
                const float a[8] = {a0.x, a0.y, a0.z, a0.w, a1.x, a1.y, a1.z, a1.w}; const float bb[4] = {b.x, b.y, b.z, b.w};
#pragma unroll
                for (int i = 0; i < 8; ++i)
#pragma unroll
                    for (int j = 0; j < 4; ++j) acc[i][j] += a[i] * bb[j];
            }
            __syncthreads();
        }
#pragma unroll
        for (int i = 0; i < 8; ++i)
#pragma unroll
            for (int j = 0; j < 4; ++j) epi_elem<MODE>(P, tm * 128 + ty * 8 + i, tn * 128 + tx * 4 + j, acc[i][j]);
    }
}

__device__ __forceinline__ void phase_na_naive(const Params& P, unsigned char* lds, bf16_t* Y) {
    const int tid = threadIdx.x, lane = tid & 63, wave = tid >> 6;
    float* rpbL = (float*)lds;
    for (int e = tid; e < 16 * 15 * 31; e += NTHREADS) rpbL[e] = P.na_rpb[e] * LOG2E;
    __syncthreads();
    const bf16_t* R = (const bf16_t*)(P.ws + WS_R1);
    const int gw = blockIdx.x * NWAVES + wave, NGW = gridDim.x * NWAVES;
    for (int u = gw; u < 16384 + 1024; u += NGW) {
        int b, h, r = 0, qtok, nloc, r0 = 0, cs = 0;
        if (u < 16384) { r = u & 63; h = (u >> 6) & 15; b = u >> 10; qtok = b * SEQ + r * 64 + lane; nloc = 128;
            r0 = min(max(r - 4, 0), 56); cs = min(max(lane - 8, 0), 48); }
        else { const int v = u - 16384; const int qb = v & 3; h = (v >> 2) & 15; b = v >> 6; qtok = NLAT + b * CTX + qb * 64 + lane; nloc = 0; }
        float q[64], O[64];
        {
            const bf16_t* qp = R + (size_t)qtok * N0 + h * 64;
#pragma unroll
            for (int i = 0; i < 8; ++i) unpack8(*(const u32x4*)(qp + 8 * i), q + 8 * i);
        }
#pragma unroll
        for (int d = 0; d < 64; ++d) O[d] = 0.f;
        float m = -1e30f, l = 0.f;
        const int nk = nloc + CTX;
        for (int kk = 0; kk < nk; ++kk) {
            int ktok; float s;
            if (kk < nloc) { const int kr = kk >> 4, j = kk & 15; ktok = b * SEQ + (r0 + kr) * 64 + cs + j; s = rpbL[h * 465 + (r0 + kr - r + 7) * 31 + (cs + j - lane + 15)]; }
            else { ktok = NLAT + b * CTX + (kk - nloc); s = 0.f; }
            const bf16_t* kp = R + (size_t)ktok * N0 + 1024 + h * 64;
#pragma unroll
            for (int i = 0; i < 8; ++i) { float f[8]; unpack8(*(const u32x4*)(kp + 8 * i), f);
#pragma unroll
                for (int j2 = 0; j2 < 8; ++j2) s += q[8 * i + j2] * f[j2]; }
            const float mn = fmaxf(m, s), alpha = exp2f(m - mn), p = exp2f(s - mn);
            l = l * alpha + p; m = mn;
            const bf16_t* vp = kp + 1024;
#pragma unroll
            for (int i = 0; i < 8; ++i) { float f[8]; unpack8(*(const u32x4*)(vp + 8 * i), f);
#pragma unroll
                for (int j2 = 0; j2 < 8; ++j2) O[8 * i + j2] = O[8 * i + j2] * alpha + p * f[j2]; }
        }
        const float rl = 1.f / l;
        const bf16_t* zp = R + (size_t)qtok * N0 + 3072 + h * 64;
        bf16_t* yp = Y + (size_t)qtok * D + h * 64;
#pragma unroll
        for (int i = 0; i < 8; ++i) { float z[8]; unpack8(*(const u32x4*)(zp + 8 * i), z);
            u32x4 o;
            o.x = pk2(O[8 * i + 0] * rl * siluf(z[0]), O[8 * i + 1] * rl * siluf(z[1]));
            o.y = pk2(O[8 * i + 2] * rl * siluf(z[2]), O[8 * i + 3] * rl * siluf(z[3]));
            o.z = pk2(O[8 * i + 4] * rl * siluf(z[4]), O[8 * i + 5] * rl * siluf(z[5]));
            o.w = pk2(O[8 * i + 6] * rl * siluf(z[6]), O[8 * i + 7] * rl * siluf(z[7]));
            *(u32x4*)(yp + 8 * i) = o; }
    }
}


typedef short bf16x8 __attribute__((ext_vector_type(8)));
typedef short v4i16 __attribute__((ext_vector_type(4)));
#define LAS __attribute__((address_space(3)))
__device__ __forceinline__ f32x4 mfma16(bf16x8 a, bf16x8 b, f32x4 c) { return __builtin_amdgcn_mfma_f32_16x16x32_bf16(a, b, c, 0, 0, 0); }
__device__ __forceinline__ bf16x8 pack8(const f32x4 a, const f32x4 b) { u32x4 w; w.x = cvtpk(a[0], a[1]); w.y = cvtpk(a[2], a[3]); w.z = cvtpk(b[0], b[1]); w.w = cvtpk(b[2], b[3]); return __builtin_bit_cast(bf16x8, w); }

__device__ __forceinline__ float max_q4(float v) {
    const unsigned u = __float_as_uint(v);
    auto r = __builtin_amdgcn_permlane16_swap(u, u, false, false);
    const float a = fmaxf(__uint_as_float(r[0]), __uint_as_float(r[1]));
    const unsigned ua = __float_as_uint(a);
    auto s = __builtin_amdgcn_permlane32_swap(ua, ua, false, false);
    return fmaxf(__uint_as_float(s[0]), __uint_as_float(s[1]));
}
template <bool LOCAL, int HALF>
__device__ __forceinline__ void na_step(const LAS unsigned char* Kt, const LAS unsigned char* Vt, const int (&koff)[2][2], const int (&voff)[4], const bf16x8 (&qf)[2][2],
                                        f32x4 (&O)[4][2], float (&m)[2], float (&l)[2], const LAS float* rpl, int l16, int q4) {
    constexpr int NKB = LOCAL ? 2 : 4;
    f32x4 s[2][NKB];
    float mx[2];
#pragma unroll
    for (int tl = 0; tl < 2; ++tl) {
        const int tb = 2 * HALF + tl;
        const int base = LOCAL ? (tb == 0 ? 0 : tb == 1 ? 8 : tb == 2 ? 24 : 32) : 0;
        const int sv = (base >> 3) & 1;
        const int qc = 16 * tb + l16, cs = min(max(qc - 8, 0), 48), dtb = 4 * q4 - cs;
        float bs[2][4];
        if (LOCAL) {
#pragma unroll
            for (int k2 = 0; k2 < 2; ++k2)
#pragma unroll
                for (int e = 0; e < 4; ++e) bs[k2][e] = rpl[(base - 16 * tb) + 16 * k2 + e];
            asm volatile("" : "+v"(bs[0][0]), "+v"(bs[0][1]), "+v"(bs[0][2]), "+v"(bs[0][3]), "+v"(bs[1][0]), "+v"(bs[1][1]), "+v"(bs[1][2]), "+v"(bs[1][3]));
        }
        float mxl = -1e30f;
#pragma unroll
        for (int k2 = 0; k2 < NKB; ++k2) {
            f32x4 a = {0.f, 0.f, 0.f, 0.f};
#pragma unroll
            for (int ks = 0; ks < 2; ++ks) {
                const bf16x8 kf = *(const LAS bf16x8*)(Kt + (base + 16 * k2) * 128 + koff[sv][ks]);
                a = mfma16(kf, qf[tl][ks], a);
            }
            if (LOCAL) {
#pragma unroll
                for (int e = 0; e < 4; ++e) { const bool valid = (unsigned)(dtb + (base + 16 * k2 + e)) < 16u; a[e] = valid ? a[e] + bs[k2 & 1][e] : -1e30f; }
            }
            s[tl][k2] = a; mxl = fmaxf(mxl, fmaxf(fmaxf(a[0], a[1]), fmaxf(a[2], a[3])));
        }
        mx[tl] = max_q4(mxl);
    }
    if (__any(mx[0] > m[0] + 8.f || mx[1] > m[1] + 8.f)) {
#pragma unroll
        for (int tl = 0; tl < 2; ++tl) {
            const float mn = fmaxf(m[tl], mx[tl]), alpha = __builtin_amdgcn_exp2f(m[tl] - mn); m[tl] = mn; l[tl] *= alpha;
#pragma unroll
            for (int db = 0; db < 4; ++db) O[db][tl] *= alpha;
        }
    }
    bf16x8 pb[2][NKB / 2];
#pragma unroll
    for (int tl = 0; tl < 2; ++tl) {
        const float mr = m[tl];
        float ps0 = 0.f, ps1 = 0.f;
#pragma unroll
        for (int k2 = 0; k2 < NKB; ++k2) {
#pragma unroll
            for (int e = 0; e < 4; ++e) { const float p = __builtin_amdgcn_exp2f(s[tl][k2][e] - mr); s[tl][k2][e] = p; if (e & 1) ps1 += p; else ps0 += p; }
        }
        l[tl] += ps0 + ps1;
#pragma unroll
        for (int kp = 0; kp < NKB / 2; ++kp) pb[tl][kp] = pack8(s[tl][2 * kp], s[tl][2 * kp + 1]);
    }
#pragma unroll
    for (int tl = 0; tl < 2; ++tl) {
        const int tb = 2 * HALF + tl;
        const int base = LOCAL ? (tb == 0 ? 0 : tb == 1 ? 8 : tb == 2 ? 24 : 32) : 0;
#pragma unroll
        for (int kp = 0; kp < NKB / 2; ++kp)
#pragma unroll
            for (int db = 0; db < 4; ++db) {
                const v4i16 lo = __builtin_amdgcn_ds_read_tr16_b64_v4i16((LAS v4i16*)(Vt + (base + 32 * kp) * 128 + voff[db]));
                const v4i16 hi = __builtin_amdgcn_ds_read_tr16_b64_v4i16((LAS v4i16*)(Vt + (base + 32 * kp + 16) * 128 + voff[db]));
                const bf16x8 vf = __builtin_shufflevector(lo, hi, 0, 1, 2, 3, 4, 5, 6, 7);
                O[db][tl] = mfma16(vf, pb[tl][kp], O[db][tl]);
            }
    }
}

template <int HALF>
__device__ __forceinline__ void na_unit(const Params& P, LAS unsigned char* ring, const LAS float* rpbL, bf16_t* Y, int b, int h, int r, int r0, int kr0, int nl, int qtok0, int lane, int wave) {
    const int l16 = lane & 15, q4 = lane >> 4;
    const char* R = (const char*)(P.ws + WS_R1);
    const int wq = wave & 3; const bool isv = wave >= 4;
    const unsigned rowoff = (unsigned)(16 * wq + (lane >> 3)) * (N0 * 2);
    const unsigned kofs_e = rowoff + (unsigned)(((lane & 7) ^ (lane >> 4)) * 16), kofs_o = rowoff + 8 * N0 * 2 + (unsigned)(((lane & 7) ^ (4 + (lane >> 4))) * 16);
    const unsigned vofs = rowoff + 2048 + (unsigned)((((((lane & 7) >> 1) ^ (lane >> 4)) & 3) << 1 | (lane & 1)) * 16);
    const unsigned src0 = isv ? vofs : kofs_e, src1 = isv ? vofs + 8 * N0 * 2 : kofs_o;
    const int dsto = (isv ? 8192 : 0) + wq * 2048;
    int koff[2][2];
#pragma unroll
    for (int sv = 0; sv < 2; ++sv)
#pragma unroll
        for (int ks = 0; ks < 2; ++ks) koff[sv][ks] = l16 * 128 + (((4 * ks + q4) ^ (((l16 >> 1) + 4 * sv) & 7)) * 16);
    const int vrow = 4 * q4 + (l16 >> 2), vsw = (2 * (q4 & 1) + (l16 >> 3)) & 3;
    int voff[4];
#pragma unroll
    for (int db = 0; db < 4; ++db) voff[db] = vrow * 128 + ((db ^ vsw) * 32) + (l16 & 3) * 8;
    const int nl2 = (nl + 1) >> 1, nsteps = nl2 + 2;
    const char* kbase = R + (size_t)(1024 + h * 64) * 2;
    auto tile_tok = [&](int s, int t) { return (s < nl2) ? (b * SEQ + min(kr0 + 2 * s + t, 63) * 64) : (NLAT + b * CTX + (2 * (s - nl2) + t) * 64); };
#define NA_DMA(s) do { _Pragma("unroll") for (int t_ = 0; t_ < 2; ++t_) { const char* kp_ = kbase + (size_t)tile_tok(s, t_) * (N0 * 2); LAS unsigned char* dst_ = ring + ((s) & 3) * 32768 + t_ * 16384 + dsto; \
        __builtin_amdgcn_global_load_lds((const unsigned*)(kp_ + src0), (LAS unsigned*)(dst_), 16, 0, 0); \
        __builtin_amdgcn_global_load_lds((const unsigned*)(kp_ + src1), (LAS unsigned*)(dst_ + 1024), 16, 0, 0); } } while (0)
    bf16x8 qf[2][2];
    {
        const bf16_t* qp = (const bf16_t*)R + (size_t)(qtok0 + 32 * HALF + l16) * N0 + h * 64 + 8 * q4;
#pragma unroll
        for (int tl = 0; tl < 2; ++tl)
#pragma unroll
            for (int ks = 0; ks < 2; ++ks) qf[tl][ks] = *(const bf16x8*)(qp + (size_t)tl * 16 * N0 + 32 * ks);
    }
    NA_DMA(0); NA_DMA(1);
    u32x2 zz[2][4];
#pragma unroll
    for (int tl = 0; tl < 2; ++tl)
#pragma unroll
        for (int db = 0; db < 4; ++db) zz[tl][db] = *(const u32x2*)((const bf16_t*)R + (size_t)(qtok0 + 32 * HALF + 16 * tl + l16) * N0 + 3072 + h * 64 + 16 * db + 4 * q4);
    f32x4 O[4][2]; float m[2], l[2];
#pragma unroll
    for (int tl = 0; tl < 2; ++tl) { m[tl] = -1e30f; l[tl] = 0.f;
#pragma unroll
        for (int db = 0; db < 4; ++db) O[db][tl] = (f32x4){0.f, 0.f, 0.f, 0.f}; }
#define NA_STEP_BEGIN(s) \
        if ((s) == 0 || (s) + 1 >= nsteps) asm volatile("s_waitcnt vmcnt(0) lgkmcnt(0)" ::: "memory"); else asm volatile("s_waitcnt vmcnt(4) lgkmcnt(0)" ::: "memory"); \
        __builtin_amdgcn_s_barrier(); asm volatile("" ::: "memory"); \
        if ((s) + 2 < nsteps) NA_DMA((s) + 2); \
        const LAS unsigned char* Kt0 = ring + ((s) & 3) * 32768;
    for (int s = 0; s < nl2; ++s) {
        NA_STEP_BEGIN(s)
#pragma unroll
        for (int t = 0; t < 2; ++t) {
            const int ti = 2 * s + t, kr = kr0 + ti;
            if (ti < nl && kr >= r0 && kr < r0 + 8) {
                const LAS unsigned char* Kt = Kt0 + t * 16384; const LAS unsigned char* Vt = Kt + 8192;
                int l16v = l16, q4v = q4; asm volatile("" : "+v"(l16v), "+v"(q4v));
                na_step<true, HALF>(Kt, Vt, koff, voff, qf, O, m, l, rpbL + (kr - r + 7) * 31 + (4 * q4v - l16v + 15), l16v, q4v);
            }
        }
    }
    for (int s = nl2; s < nsteps; ++s) {
        NA_STEP_BEGIN(s)
#pragma unroll
        for (int t = 0; t < 2; ++t) { const LAS unsigned char* Kt = Kt0 + t * 16384; const LAS unsigned char* Vt = Kt + 8192;
            na_step<false, HALF>(Kt, Vt, koff, voff, qf, O, m, l, rpbL, l16, q4); }
    }
#undef NA_STEP_BEGIN
#undef NA_DMA
#pragma unroll
    for (int tl = 0; tl < 2; ++tl) {
        float lt = l[tl]; lt += __shfl_xor(lt, 16); lt += __shfl_xor(lt, 32);
        const float rl = 1.f / lt;
        const size_t tok = (size_t)(qtok0 + 32 * HALF + 16 * tl + l16);
#pragma unroll
        for (int db = 0; db < 4; ++db) {
            const int col = h * 64 + 16 * db + 4 * q4;
            const u32x2 zv = zz[tl][db];
            const float z0 = __uint_as_float(zv.x << 16), z1 = __uint_as_float(zv.x & 0xffff0000u), z2 = __uint_as_float(zv.y << 16), z3 = __uint_as_float(zv.y & 0xffff0000u);
            const f32x4 o = O[db][tl] * rl;
            u32x2 w; w.x = cvtpk(o[0] * siluf(z0), o[1] * siluf(z1)); w.y = cvtpk(o[2] * siluf(z2), o[3] * siluf(z3));
            *(u32x2*)(Y + tok * D + col) = w; }
    }
}

__device__ __forceinline__ void phase_na_mfma(const Params& P, unsigned char* lds_, bf16_t* Y) {
    LAS unsigned char* lds = (LAS unsigned char*)lds_;
    const int tid = threadIdx.x, lane = tid & 63;
    const int wave = __builtin_amdgcn_readfirstlane(tid >> 6), pair = wave >> 1;
    LAS float* rpbL = (LAS float*)(lds + 64);
    LAS unsigned char* ring = lds + 2048;
    const int NITEM = 4096 + 256;
    const int vcu = (gridDim.x % 8 == 0) ? ((int)blockIdx.x % 8) * ((int)gridDim.x / 8) + (int)blockIdx.x / 8 : (int)blockIdx.x;
    for (int it = vcu; it < NITEM; it += gridDim.x) {
        int b, h, r = 0, r0 = 0, kr0 = 0, nl, qtok0;
        __syncthreads();
        if (it < 4096) { const int rq = it & 15; h = (it >> 4) & 15; b = it >> 8; r = rq * 4 + pair; r0 = min(max(r - 4, 0), 56); qtok0 = b * SEQ + r * 64;
            kr0 = min(max(rq * 4 - 4, 0), 56); nl = min(max(rq * 4 + 3 - 4, 0), 56) + 8 - kr0;
            for (int e = tid; e < 465; e += NTHREADS) rpbL[e] = P.na_rpb[h * 465 + e] * LOG2E;
            __syncthreads();
        } else { const int v = it - 4096; b = v >> 4; h = v & 15; nl = 0; qtok0 = NLAT + b * CTX + pair * 64; }
        if (wave & 1) na_unit<1>(P, ring, rpbL, Y, b, h, r, r0, kr0, nl, qtok0, lane, wave);
        else na_unit<0>(P, ring, rpbL, Y, b, h, r, r0, kr0, nl, qtok0, lane, wave);
    }
}

template <int DIR>
__device__ __forceinline__ void hgrn_item(const Params& P, unsigned char* lds_, bf16_t* Odst, const int b, const int h) {
    LAS unsigned char* lds = (LAS unsigned char*)lds_;
    const int tid = threadIdx.x, lane = tid & 63, l16 = lane & 15, q4 = lane >> 4;
    const int wave = __builtin_amdgcn_readfirstlane(tid >> 6);
    LAS unsigned char* QT = lds;
    LAS unsigned char* KT = lds + 16384;
    LAS unsigned char* KTT = lds + 32768;
    LAS unsigned char* VT = lds + 49152;
    LAS unsigned char* PT = lds + 65536;
    LAS float* DM = (LAS float*)(lds + 73728);
    LAS float* DL = DM + 128;
    LAS float* TOT = DL + 128;
#define HG_BAR() do { asm volatile("s_waitcnt lgkmcnt(0)" ::: "memory"); __builtin_amdgcn_s_barrier(); asm volatile("" ::: "memory"); } while (0)
    const unsigned short* R = (const unsigned short*)(P.ws + WS_R1);
    const int c = tid & 127, qtr = __builtin_amdgcn_readfirstlane(tid >> 7);
    const int cc = c & 31, pc = 32 * (c >> 5) + (((cc & 12) << 1) | ((cc >> 4) << 2) | (cc & 3));
    const int pc_chunk = pc >> 3, pc_in = (pc & 7) * 2;
    {
        f32x4 S[8];
#pragma unroll
        for (int mb = 0; mb < 8; ++mb) S[mb] = (f32x4){0.f, 0.f, 0.f, 0.f};
        unsigned short lfr[16], qr[16]; u32x4 vr[2];
#define HG_ROWLOW(ci_) ((ci_) < 4 ? (NLAT + b * CTX + (DIR ? CTX - 64 - (ci_) * 64 : (ci_) * 64)) : (b * SEQ + (DIR ? SEQ - 64 - ((ci_) - 4) * 64 : ((ci_) - 4) * 64)))
        const unsigned toff = (unsigned)((DIR ? 63 - 16 * qtr : 16 * qtr) * N1 + h * 128 + c);
        const unsigned voffg0 = (unsigned)((DIR ? 63 - (tid >> 4) : (tid >> 4)) * N1 + 1024 + h * 128 + (tid & 15) * 8);
        const unsigned ooff0 = (unsigned)((DIR ? 63 - l16 : l16) * D + h * 128 + 16 * wave + 4 * q4);
#define HG_LOAD_LF(ci_) do { const unsigned short* Rc = R + (size_t)HG_ROWLOW(ci_) * N1; \
        _Pragma("unroll") for (int j = 0; j < 16; ++j) lfr[j] = Rc[toff + (unsigned)((2 + DIR) * 1024 + (DIR ? -j : j) * N1)]; } while (0)
#define HG_LOAD_QV(ci_) do { const unsigned short* Rc = R + (size_t)HG_ROWLOW(ci_) * N1; \
        if ((ci_) >= 4) { _Pragma("unroll") for (int j = 0; j < 16; ++j) qr[j] = Rc[toff + (unsigned)((DIR ? -j : j) * N1)]; } \
        else { _Pragma("unroll") for (int j = 0; j < 16; ++j) qr[j] = (unsigned short)0; } \
        _Pragma("unroll") for (int i = 0; i < 2; ++i) vr[i] = *(const u32x4*)(Rc + (voffg0 + (unsigned)((DIR ? -32 : 32) * i * N1))); } while (0)
        HG_LOAD_LF(0); HG_LOAD_QV(0);
        for (int ci = 0; ci < 68; ++ci) {
            const bool is_ctx = ci < 4;
            float A[16]; float a = 0.f;
#pragma unroll
            for (int j = 0; j < 16; ++j) { a += h2f(lfr[j]); A[j] = a; }
            TOT[qtr * 128 + c] = a;
            if (ci + 1 < 68) HG_LOAD_LF(ci + 1);
            HG_BAR();
            {
                const float t0 = TOT[c], t1 = TOT[128 + c], t2 = TOT[256 + c], t3 = TOT[384 + c];
                const float off = (qtr > 0 ? t0 : 0.f) + (qtr > 1 ? t1 : 0.f) + (qtr > 2 ? t2 : 0.f);
                const float mid = t0 + t1, last = mid + t2 + t3;
                if (qtr == 0) { DM[c] = __builtin_amdgcn_exp2f(mid); DL[c] = __builtin_amdgcn_exp2f(last - mid); }
                float Eprev = __builtin_amdgcn_exp2f(fminf(fmaxf(mid - off, -100.f), 100.f));
                float kp[16];
                const int sw = (c >> 1) & 7;
#pragma unroll
                for (int j = 0; j < 16; ++j) {
                    const float Ej = __builtin_amdgcn_exp2f(fminf(fmaxf(mid - off - A[j], -100.f), 100.f));
                    kp[j] = Ej - Eprev; Eprev = Ej;
                    if ((j & 3) == 3) {
                        u32x2 w; w.x = cvtpk(kp[j - 3], kp[j - 2]); w.y = cvtpk(kp[j - 1], kp[j]);
                        *(LAS u32x2*)(KTT + c * 128 + (((2 * qtr + ((j >> 2) & 1)) ^ sw) * 16) + 8 * (j >> 3)) = w; }
                    const float qp = bf2f(qr[j]) * __builtin_amdgcn_rcpf(Ej);
                    const int byte = (16 * qtr + j) * 256 + ((pc_chunk ^ j) * 16) + pc_in;
                    const unsigned qk = cvtpk(qp, kp[j]);
                    *(LAS unsigned short*)(QT + byte) = (unsigned short)qk;
                    *(LAS unsigned short*)(KT + byte) = (unsigned short)(qk >> 16);
                }
#pragma unroll
                for (int i = 0; i < 2; ++i) { const int e = tid + NTHREADS * i, vrow = e >> 4, ch = e & 15;
                    *(LAS u32x4*)(VT + vrow * 256 + ((((ch >> 1) ^ (vrow & 7))) * 32) + (ch & 1) * 16) = vr[i]; }
            }
            if (ci + 1 < 68) HG_LOAD_QV(ci + 1);
            HG_BAR();
            if (!is_ctx) {
                const int tb = wave >> 1;
                bf16x8 qf[4];
#pragma unroll
                for (int ks = 0; ks < 4; ++ks) qf[ks] = *(const LAS bf16x8*)(QT + (16 * tb + l16) * 256 + (((4 * ks + q4) ^ l16) * 16));
#pragma unroll
                for (int k2 = 0; k2 < 2; ++k2) {
                    const int sb = 2 * (wave & 1) + k2;
                    f32x4 acc = {0.f, 0.f, 0.f, 0.f};
                    if (sb <= tb) {
#pragma unroll
                        for (int ks = 0; ks < 4; ++ks) { const bf16x8 kf = *(const LAS bf16x8*)(KT + (16 * sb + l16) * 256 + (((4 * ks + q4) ^ l16) * 16)); acc = mfma16(kf, qf[ks], acc); }
                        if (sb == tb) {
#pragma unroll
                            for (int e = 0; e < 4; ++e) if (4 * q4 + e > l16) acc[e] = 0.f;
                        }
                    }
                    u32x2 w; w.x = cvtpk(acc[0], acc[1]); w.y = cvtpk(acc[2], acc[3]);
                    const int t = 16 * tb + l16;
                    *(LAS u32x2*)(PT + t * 128 + (((2 * sb + (q4 & 1)) ^ ((t >> 1) & 7)) * 16) + 8 * (q4 >> 1)) = w;
                }
            }
            HG_BAR();
            {
#pragma unroll
                for (int mb = 0; mb < 8; ++mb) S[mb] *= *(const LAS f32x4*)(DM + 16 * mb + 4 * q4);
                bf16x8 vf[2];
#pragma unroll
                for (int ks2 = 0; ks2 < 2; ++ks2) {
                    const int row0 = 32 * ks2 + 16 * (q4 >> 1) + 4 * (q4 & 1) + (l16 >> 2);
                    const int un = (wave ^ (4 * (q4 & 1) + (l16 >> 2))) * 32 + (l16 & 3) * 8;
                    const v4i16 lo = __builtin_amdgcn_ds_read_tr16_b64_v4i16((LAS v4i16*)(VT + row0 * 256 + un));
                    const v4i16 hi = __builtin_amdgcn_ds_read_tr16_b64_v4i16((LAS v4i16*)(VT + (row0 + 8) * 256 + un));
                    vf[ks2] = __builtin_shufflevector(lo, hi, 0, 1, 2, 3, 4, 5, 6, 7);
                }
                if (!is_ctx) {
                    f32x4 o[4];
#pragma unroll
                    for (int tb = 0; tb < 4; ++tb) o[tb] = (f32x4){0.f, 0.f, 0.f, 0.f};
#pragma unroll
                    for (int ks = 0; ks < 4; ++ks) {
                        const bf16x8 sb16 = pack8(S[2 * ks], S[2 * ks + 1]);
#pragma unroll
                        for (int tb = 0; tb < 4; ++tb) { const bf16x8 qf = *(const LAS bf16x8*)(QT + (16 * tb + l16) * 256 + (((4 * ks + q4) ^ l16) * 16)); o[tb] = mfma16(sb16, qf, o[tb]); }
                    }
#pragma unroll
                    for (int ks2 = 0; ks2 < 2; ++ks2)
#pragma unroll
                        for (int tb = 0; tb < 4; ++tb) {
                            if (ks2 == 1 && tb < 2) continue;
                            const bf16x8 pf = *(const LAS bf16x8*)(PT + (16 * tb + l16) * 128 + (((4 * ks2 + q4) ^ ((l16 >> 1) & 7)) * 16)); o[tb] = mfma16(vf[ks2], pf, o[tb]); }
#pragma unroll
                    for (int tb = 0; tb < 4; ++tb) { u32x2 w; w.x = cvtpk(o[tb][0], o[tb][1]); w.y = cvtpk(o[tb][2], o[tb][3]);
                        *(u32x2*)(Odst + (size_t)HG_ROWLOW(ci) * D + (ooff0 + (unsigned)((DIR ? -16 : 16) * tb * D))) = w; }
                }
#pragma unroll
                for (int mb = 0; mb < 8; ++mb) {
#pragma unroll
                    for (int ks2 = 0; ks2 < 2; ++ks2) { const bf16x8 kt = *(const LAS bf16x8*)(KTT + (16 * mb + l16) * 128 + (((4 * ks2 + q4) ^ ((l16 >> 1) & 7)) * 16)); S[mb] = mfma16(kt, vf[ks2], S[mb]); }
                    S[mb] *= *(const LAS f32x4*)(DL + 16 * mb + 4 * q4);
                }
            }
            HG_BAR();
        }
#undef HG_LOAD_LF
#undef HG_LOAD_QV
#undef HG_BAR
#undef HG_ROWLOW
    }
}
template <int DIR, int HX>
__device__ __forceinline__ void hgrn_item_ws(const Params& P, unsigned char* lds_, bf16_t* Odst, const int b, const int h) {
    LAS unsigned char* lds = (LAS unsigned char*)lds_;
    const int tid = threadIdx.x, lane = tid & 63, l16 = lane & 15, q4 = lane >> 4;
    const int wave = __builtin_amdgcn_readfirstlane(tid >> 6);
    LAS unsigned char* PT = lds + 131072;
    LAS float* DMs = (LAS float*)(lds + 139264);
    LAS float* DLs = DMs + 256;
    LAS float* TOT = DLs + 256;
#define HG_BAR() do { asm volatile("s_waitcnt lgkmcnt(0)" ::: "memory"); __builtin_amdgcn_s_barrier(); asm volatile("" ::: "memory"); } while (0)
#define HG_ROWLOW(ci_) ((ci_) < 4 ? (NLAT + b * CTX + (DIR ? CTX - 64 - (ci_) * 64 : (ci_) * 64)) : (b * SEQ + (DIR ? SEQ - 64 - ((ci_) - 4) * 64 : ((ci_) - 4) * 64)))
    const unsigned short* R = (const unsigned short*)(P.ws + WS_R1);
    if (wave < 4) {
        const int cp = tid & 63, c0 = 2 * cp, qtr = wave;
        const int cc = c0 & 31, pc = 32 * (c0 >> 5) + (((cc & 12) << 1) | ((cc >> 4) << 2) | (cc & 3));
        const int pc_chunk = pc >> 3, pc_in = (pc & 7) * 2;
        const int sw = cp & 7;
        const unsigned toff = (unsigned)((DIR ? 63 - 16 * qtr : 16 * qtr) * N1 + h * 128 + c0);
        const unsigned voffg0 = (unsigned)((DIR ? 63 - (tid >> 4) : (tid >> 4)) * N1 + 1024 + h * 128 + (tid & 15) * 8);
        LAS float* TOT4 = TOT;
        unsigned lfA[16], qA[16], lfB[16], qB[16]; u32x4 vA[4], vB[4];
#define HG_LOAD(lfr, qr, vr, ci_) do { const unsigned short* Rc = R + (size_t)HG_ROWLOW(ci_) * N1; \
        { unsigned o_ = toff + (unsigned)((2 + DIR) * 1024); \
          _Pragma("unroll") for (int j = 0; j < 16; ++j) { lfr[j] = *(const unsigned*)(Rc + o_); o_ += (unsigned)(DIR ? -N1 : N1); asm volatile("" : "+v"(o_)); } } \
        if ((ci_) >= 4) { unsigned o_ = toff; \
          _Pragma("unroll") for (int j = 0; j < 16; ++j) { qr[j] = *(const unsigned*)(Rc + o_); o_ += (unsigned)(DIR ? -N1 : N1); asm volatile("" : "+v"(o_)); } } \
        else { _Pragma("unroll") for (int j = 0; j < 16; ++j) qr[j] = 0u; } \
        { unsigned o_ = voffg0; \
          _Pragma("unroll") for (int i = 0; i < 4; ++i) { vr[i] = *(const u32x4*)(Rc + o_); o_ += (unsigned)((DIR ? -16 : 16) * N1); asm volatile("" : "+v"(o_)); } } } while (0)
#define HG_GBODY(lfr, qr, vr, k) do { \
            if (HX != 1 && (k) < 68) {          \
                float a0 = 0.f, a1 = 0.f; \
                _Pragma("unroll") for (int j = 0; j < 16; ++j) { a0 += h2f((unsigned short)lfr[j]); a1 += h2f((unsigned short)(lfr[j] >> 16)); } \
                *(LAS f32x2_t*)(TOT4 + qtr * 128 + c0) = (f32x2_t){a0, a1}; \
            } \
            HG_BAR(); \
            if (HX != 1 && (k) < 68) {          \
                LAS unsigned char* QT = lds + ((k) & 1) * 65536; LAS unsigned char* KT = QT + 16384; LAS unsigned char* KTT = QT + 32768; LAS unsigned char* VT = QT + 49152; \
                const f32x2_t t0 = *(const LAS f32x2_t*)(TOT4 + c0), t1 = *(const LAS f32x2_t*)(TOT4 + 128 + c0), t2 = *(const LAS f32x2_t*)(TOT4 + 256 + c0), t3 = *(const LAS f32x2_t*)(TOT4 + 384 + c0); \
                const f32x2_t z2 = {0.f, 0.f}; \
                const f32x2_t off = (qtr > 0 ? t0 : z2) + (qtr > 1 ? t1 : z2) + (qtr > 2 ? t2 : z2), mid = t0 + t1, last = mid + t2 + t3; \
                if (qtr == 0) { *(LAS f32x2_t*)(DMs + ((k) & 1) * 128 + c0) = (f32x2_t){__builtin_amdgcn_exp2f(mid.x), __builtin_amdgcn_exp2f(mid.y)}; \
                                *(LAS f32x2_t*)(DLs + ((k) & 1) * 128 + c0) = (f32x2_t){__builtin_amdgcn_exp2f(last.x - mid.x), __builtin_amdgcn_exp2f(last.y - mid.y)}; } \
                float run0 = mid.x - off.x, run1 = mid.y - off.y; \
                float Ep0 = __builtin_amdgcn_exp2f(fminf(fmaxf(run0, -100.f), 100.f)), Ep1 = __builtin_amdgcn_exp2f(fminf(fmaxf(run1, -100.f), 100.f)); \
                float kp0[4], kp1[4]; \
                _Pragma("unroll") for (int j = 0; j < 16; ++j) { \
                    run0 -= h2f((unsigned short)lfr[j]); run1 -= h2f((unsigned short)(lfr[j] >> 16)); \
                    const float E0 = __builtin_amdgcn_exp2f(fminf(fmaxf(run0, -100.f), 100.f)), E1 = __builtin_amdgcn_exp2f(fminf(fmaxf(run1, -100.f), 100.f)); \
                    kp0[j & 3] = E0 - Ep0; Ep0 = E0; kp1[j & 3] = E1 - Ep1; Ep1 = E1; \
                    const float qp0 = __uint_as_float(qr[j] << 16) * __builtin_amdgcn_rcpf(E0), qp1 = __uint_as_float(qr[j] & 0xffff0000u) * __builtin_amdgcn_rcpf(E1); \
                    const int byte = (16 * qtr + j) * 256 + ((pc_chunk ^ j) * 16) + pc_in; \
                    *(LAS unsigned*)(QT + byte) = cvtpk(qp0, qp1); \
                    *(LAS unsigned*)(KT + byte) = cvtpk(kp0[j & 3], kp1[j & 3]); \
                    if ((j & 3) == 3) {        \
                        u32x2 w0, w1; w0.x = cvtpk(kp0[0], kp0[1]); w0.y = cvtpk(kp0[2], kp0[3]); w1.x = cvtpk(kp1[0], kp1[1]); w1.y = cvtpk(kp1[2], kp1[3]); \
                        const int ko = (((2 * qtr + ((j >> 2) & 1)) ^ sw) * 16) + 8 * (j >> 3); \
                        *(LAS u32x2*)(KTT + c0 * 128 + ko) = w0; *(LAS u32x2*)(KTT + (c0 + 1) * 128 + ko) = w1; \
                        __builtin_amdgcn_sched_barrier(0); } \
                } \
                _Pragma("unroll") for (int i = 0; i < 4; ++i) { const int e = tid + 256 * i, vrow = e >> 4, ch = e & 15; \
                    *(LAS u32x4*)(VT + vrow * 256 + ((((ch >> 1) ^ (vrow & 7))) * 32) + (ch & 1) * 16) = vr[i]; } \
                if ((k) + 2 < 68) HG_LOAD(lfr, qr, vr, (k) + 2); \
            } \
            HG_BAR(); } while (0)
        HG_LOAD(lfA, qA, vA, 0); HG_LOAD(lfB, qB, vB, 1);
        for (int k = 0; k < 68; k += 2) { HG_GBODY(lfA, qA, vA, k); HG_GBODY(lfB, qB, vB, k + 1); }
        HG_GBODY(lfA, qA, vA, 68);
#undef HG_GBODY
#undef HG_LOAD
    } else {
        const int mw = wave - 4;
        __builtin_amdgcn_s_setprio(2);
        f32x4 S[2][8];
#pragma unroll
        for (int vs = 0; vs < 2; ++vs)
#pragma unroll
            for (int mb = 0; mb < 8; ++mb) S[vs][mb] = (f32x4){0.f, 0.f, 0.f, 0.f};
        const unsigned ooff0 = (unsigned)((DIR ? 63 - l16 : l16) * D + h * 128 + 32 * mw + 4 * q4);
        for (int k = 0; k <= 68; ++k) {
            const int kc = k - 1;
            const bool live = (HX != 2) && kc >= 0, is_ctx = kc < 4;
            const LAS unsigned char* QT = lds + (kc & 1) * 65536; const LAS unsigned char* KT = QT + 16384; const LAS unsigned char* KTT = QT + 32768; const LAS unsigned char* VT = QT + 49152;
            if (live && !is_ctx) {
                const int tb = mw;
                bf16x8 qf[4];
#pragma unroll
                for (int ks = 0; ks < 4; ++ks) qf[ks] = *(const LAS bf16x8*)(QT + (16 * tb + l16) * 256 + (((4 * ks + q4) ^ l16) * 16));
#pragma unroll
                for (int sb = 0; sb < 4; ++sb) {
                    f32x4 acc = {0.f, 0.f, 0.f, 0.f};
                    if (sb <= tb) {
#pragma unroll
                        for (int ks = 0; ks < 4; ++ks) { const bf16x8 kf = *(const LAS bf16x8*)(KT + (16 * sb + l16) * 256 + (((4 * ks + q4) ^ l16) * 16)); acc = mfma16(kf, qf[ks], acc); }
                        if (sb == tb) {
#pragma unroll
                            for (int e = 0; e < 4; ++e) if (4 * q4 + e > l16) acc[e] = 0.f;
                        }
                    }
                    u32x2 w; w.x = cvtpk(acc[0], acc[1]); w.y = cvtpk(acc[2], acc[3]);
                    const int t = 16 * tb + l16;
                    *(LAS u32x2*)(PT + t * 128 + (((2 * sb + (q4 & 1)) ^ ((t >> 1) & 7)) * 16) + 8 * (q4 >> 1)) = w;
                }
            }
            HG_BAR();
            if (live) {
                const LAS float* DM = DMs + (kc & 1) * 128; const LAS float* DL = DLs + (kc & 1) * 128;
#pragma unroll
                for (int mb = 0; mb < 8; ++mb) { const f32x4 dm = *(const LAS f32x4*)(DM + 16 * mb + 4 * q4); S[0][mb] *= dm; S[1][mb] *= dm; }
                bf16x8 vf[2][2];
#pragma unroll
                for (int vs = 0; vs < 2; ++vs)
#pragma unroll
                    for (int ks2 = 0; ks2 < 2; ++ks2) {
                        const int row0 = 32 * ks2 + 16 * (q4 >> 1) + 4 * (q4 & 1) + (l16 >> 2);
                        const int un = ((2 * mw + vs) ^ (4 * (q4 & 1) + (l16 >> 2))) * 32 + (l16 & 3) * 8;
                        const v4i16 lo = __builtin_amdgcn_ds_read_tr16_b64_v4i16((LAS v4i16*)(VT + row0 * 256 + un));
                        const v4i16 hi = __builtin_amdgcn_ds_read_tr16_b64_v4i16((LAS v4i16*)(VT + (row0 + 8) * 256 + un));
                        vf[vs][ks2] = __builtin_shufflevector(lo, hi, 0, 1, 2, 3, 4, 5, 6, 7);
                    }
                if (!is_ctx) {
                    f32x4 o[2][4];
#pragma unroll
                    for (int vs = 0; vs < 2; ++vs)
#pragma unroll
                        for (int tb = 0; tb < 4; ++tb) o[vs][tb] = (f32x4){0.f, 0.f, 0.f, 0.f};
#pragma unroll
                    for (int ks = 0; ks < 4; ++ks) {
                        const bf16x8 s0 = pack8(S[0][2 * ks], S[0][2 * ks + 1]), s1 = pack8(S[1][2 * ks], S[1][2 * ks + 1]);
#pragma unroll
                        for (int tb = 0; tb < 4; ++tb) { const bf16x8 qf = *(const LAS bf16x8*)(QT + (16 * tb + l16) * 256 + (((4 * ks + q4) ^ l16) * 16));
                            o[0][tb] = mfma16(s0, qf, o[0][tb]); o[1][tb] = mfma16(s1, qf, o[1][tb]); }
                    }
#pragma unroll
                    for (int ks2 = 0; ks2 < 2; ++ks2)
#pragma unroll
                        for (int tb = 0; tb < 4; ++tb) {
                            if (ks2 == 1 && tb < 2) continue;
                            const bf16x8 pf = *(const LAS bf16x8*)(PT + (16 * tb + l16) * 128 + (((4 * ks2 + q4) ^ ((l16 >> 1) & 7)) * 16));
                            o[0][tb] = mfma16(vf[0][ks2], pf, o[0][tb]); o[1][tb] = mfma16(vf[1][ks2], pf, o[1][tb]); }
                    bf16_t* Oc = Odst + (size_t)HG_ROWLOW(kc) * D;
#pragma unroll
                    for (int vs = 0; vs < 2; ++vs)
#pragma unroll
                        for (int tb = 0; tb < 4; ++tb) { u32x2 w; w.x = cvtpk(o[vs][tb][0], o[vs][tb][1]); w.y = cvtpk(o[vs][tb][2], o[vs][tb][3]);
                            *(u32x2*)(Oc + (ooff0 + (unsigned)((DIR ? -16 : 16) * tb * D) + 16 * vs)) = w; }
                }
#pragma unroll
                for (int mb = 0; mb < 8; ++mb) {
#pragma unroll
                    for (int ks2 = 0; ks2 < 2; ++ks2) { const bf16x8 kt = *(const LAS bf16x8*)(KTT + (16 * mb + l16) * 128 + (((4 * ks2 + q4) ^ ((l16 >> 1) & 7)) * 16));
                        S[0][mb] = mfma16(kt, vf[0][ks2], S[0][mb]); S[1][mb] = mfma16(kt, vf[1][ks2], S[1][mb]); }
                    const f32x4 dl = *(const LAS f32x4*)(DL + 16 * mb + 4 * q4); S[0][mb] *= dl; S[1][mb] *= dl;
                }
            }
            HG_BAR();
        }
        __builtin_amdgcn_s_setprio(0);
    }
#undef HG_BAR
#undef HG_ROWLOW
}
template <int HX>
__device__ __forceinline__ void phase_hgrn_mfma(const Params& P, unsigned char* lds_, bf16_t* OF, bf16_t* OB) {
    for (int it = blockIdx.x; it < 256; it += gridDim.x) {
        const int b = it >> 4, h = (it >> 1) & 7, dir = it & 1;
        if (dir) hgrn_item_ws<1, HX>(P, lds_, OB, b, h); else hgrn_item_ws<0, HX>(P, lds_, OF, b, h);
        __syncthreads();
    }
}

__device__ __forceinline__ void phase_readout(const Params& P, bf16_t* OF, const bf16_t* OB) {
    const int tid = threadIdx.x, lane = tid & 63, wave = tid >> 6;
    const int gw = blockIdx.x * NWAVES + wave, NGW = gridDim.x * NWAVES;
    const bf16_t* R = (const bf16_t*)(P.ws + WS_R1);
    float hw[16];
#pragma unroll
    for (int i = 0; i < 16; ++i) hw[i] = P.hg_norm_w[(lane * 16 + i) & 127];
    const int per = (NLAT + NGW - 1) / NGW, rbeg = gw * per, rend = min(rbeg + per, NLAT);
    if (rbeg >= rend) return;
    u32x4 c0[6], c1[6], c2[6];
#define RO_LOAD(dst, row) do { if ((row) < rend) { dst[0] = *(const u32x4*)(OF + (size_t)(row) * D + lane * 16); dst[1] = *(const u32x4*)(OF + (size_t)(row) * D + lane * 16 + 8); \
        dst[2] = *(const u32x4*)(OB + (size_t)(row) * D + lane * 16); dst[3] = *(const u32x4*)(OB + (size_t)(row) * D + lane * 16 + 8); \
        dst[4] = *(const u32x4*)(R + (size_t)(row) * N1 + 4096 + lane * 16); dst[5] = *(const u32x4*)(R + (size_t)(row) * N1 + 4096 + lane * 16 + 8); } } while (0)
#define RO_ROW(c, row) do { if ((row) < rend) { \
        float o[16], g[16], t[16]; \
        unpack8(c[0], o); unpack8(c[1], o + 8); unpack8(c[2], t); unpack8(c[3], t + 8); unpack8(c[4], g); unpack8(c[5], g + 8); \
        float ss = 0.f; \
        _Pragma("unroll") for (int i = 0; i < 16; ++i) { o[i] += t[i]; ss += o[i] * o[i]; } \
        ss += __shfl_xor(ss, 1); ss += __shfl_xor(ss, 2); ss += __shfl_xor(ss, 4);        \
        const float rstd = 1.f / sqrtf(ss * (1.f / 128.f) + EPS); \
        float y[16]; \
        _Pragma("unroll") for (int i = 0; i < 16; ++i) y[i] = o[i] * rstd * hw[i] * g[i] * __builtin_amdgcn_rcpf(1.f + __expf(-g[i])); \
        u32x4 w0, w1; \
        w0.x = cvtpk(y[0], y[1]); w0.y = cvtpk(y[2], y[3]); w0.z = cvtpk(y[4], y[5]); w0.w = cvtpk(y[6], y[7]); \
        w1.x = cvtpk(y[8], y[9]); w1.y = cvtpk(y[10], y[11]); w1.z = cvtpk(y[12], y[13]); w1.w = cvtpk(y[14], y[15]); \
        *(u32x4*)(OF + (size_t)(row) * D + lane * 16) = w0; *(u32x4*)(OF + (size_t)(row) * D + lane * 16 + 8) = w1; } } while (0)
    RO_LOAD(c0, rbeg); RO_LOAD(c1, rbeg + 1);
    for (int row = rbeg; row < rend; row += 3) {
        RO_LOAD(c2, row + 2); RO_ROW(c0, row);
        RO_LOAD(c0, row + 3); RO_ROW(c1, row + 1);
        RO_LOAD(c1, row + 4); RO_ROW(c2, row + 2);
    }
#undef RO_ROW
#undef RO_LOAD
}

__device__ __forceinline__ void phase_final(const Params& P, const bf16_t* D0, const bf16_t* D1) {
    const int tid = threadIdx.x, lane = tid & 63, wave = tid >> 6;
    const int gw = blockIdx.x * NWAVES + wave, NGW = gridDim.x * NWAVES;
    const int per = (NLAT + NGW - 1) / NGW, rbeg = gw * per, rend = min(rbeg + per, NLAT);
    if (rbeg >= rend) return;
    f32x4 w[4], v0[4], v1[4], v2[4]; u32x2 a0[4], b0[4], a1[4], b1[4], a2[4], b2[4];
#define FIN_LOAD(vv, aa, bb, row) do { if ((row) < rend) { _Pragma("unroll") for (int j = 0; j < 4; ++j) { const size_t o_ = (size_t)(row) * D + lane * 4 + 256 * j; \
        vv[j] = *(const f32x4*)(P.x + o_); aa[j] = *(const u32x2*)(D0 + o_); bb[j] = *(const u32x2*)(D1 + o_); } } } while (0)
#define FIN_ROW(vv, aa, bb, row) do { if ((row) < rend) { float ss = 0.f; \
        _Pragma("unroll") for (int j = 0; j < 4; ++j) { \
            vv[j].x += __uint_as_float(aa[j].x << 16) + __uint_as_float(bb[j].x << 16); vv[j].y += __uint_as_float(aa[j].x & 0xffff0000u) + __uint_as_float(bb[j].x & 0xffff0000u); \
            vv[j].z += __uint_as_float(aa[j].y << 16) + __uint_as_float(bb[j].y << 16); vv[j].w += __uint_as_float(aa[j].y & 0xffff0000u) + __uint_as_float(bb[j].y & 0xffff0000u); \
            ss += (vv[j].x * vv[j].x + vv[j].y * vv[j].y) + (vv[j].z * vv[j].z + vv[j].w * vv[j].w); } \
        const float rstd = 1.f / sqrtf(wave_sum(ss) * (1.f / D) + EPS); \
        _Pragma("unroll") for (int j = 0; j < 4; ++j) *(f32x4*)(P.out + (size_t)(row) * D + lane * 4 + 256 * j) = (vv[j] * rstd) * w[j]; } } while (0)
#pragma unroll
    for (int j = 0; j < 4; ++j) w[j] = *(const f32x4*)(P.final_norm_w + lane * 4 + 256 * j);
    FIN_LOAD(v0, a0, b0, rbeg); FIN_LOAD(v1, a1, b1, rbeg + 1);
    for (int row = rbeg; row < rend; row += 3) {
        FIN_LOAD(v2, a2, b2, row + 2); FIN_ROW(v0, a0, b0, row);
        FIN_LOAD(v0, a0, b0, row + 3); FIN_ROW(v1, a1, b1, row + 1);
        FIN_LOAD(v1, a1, b1, row + 4); FIN_ROW(v2, a2, b2, row + 2);
    }
#undef FIN_ROW
#undef FIN_LOAD
}

#define XB_TMO      128
#define XB_XCNT(j)  (256  + 64 * (j))
#define XB_XSUB(j)  (1280 + 64 * (j))
#define XB_XGEN(j)  (2304 + 64 * (j))
#define XB_TOP      3328
#define XB_TOPGEN   3392
#define XCD_BAR_WORDS 3456
#define XB_SPIN_CAP (1u << 22)

__device__ __forceinline__ unsigned xb_ld(unsigned* p)              { return __hip_atomic_load(p, __ATOMIC_RELAXED, __HIP_MEMORY_SCOPE_AGENT); }
__device__ __forceinline__ unsigned xb_add(unsigned* p, unsigned v) { return __hip_atomic_fetch_add(p, v, __ATOMIC_RELAXED, __HIP_MEMORY_SCOPE_AGENT); }
__device__ __forceinline__ unsigned xb_xcc_id() { return (unsigned)__builtin_amdgcn_s_getreg((3 << 11) | 20) & 0xFu; }
#define XB_SPIN(cond, bar) do { unsigned _sp = 0; while (cond) { __builtin_amdgcn_s_sleep(1); \
    if ((++_sp & 255u) == 0u) { if (xb_ld(&(bar)[XB_TMO])) break; if (_sp > XB_SPIN_CAP) { atomicAdd(&(bar)[XB_TMO], 1u); break; } } } } while (0)

struct XcdBarrier {
    unsigned* bar; unsigned x;
    volatile LAS unsigned* st;
};

__device__ __forceinline__ XcdBarrier xcd_barrier_post(unsigned* bar, volatile LAS unsigned* st) {
    XcdBarrier b; b.bar = bar; b.x = xb_xcc_id(); b.st = st;
    if (threadIdx.x == 0) (void)xb_add(&bar[XB_XCNT(b.x)], 1u);
    return b;
}
__device__ __forceinline__ void xcd_barrier_complete(unsigned* bar, unsigned x, unsigned& nloc, unsigned& nx) {
    const unsigned G = gridDim.x * gridDim.y * gridDim.z;
    unsigned sum, cnt, mine, sp = 0u;
    for (;;) {
        sum = 0u; cnt = 0u; mine = 0u;
#pragma unroll
        for (unsigned j = 0; j < 16; ++j) { const unsigned c = xb_ld(&bar[XB_XCNT(j)]); sum += c; cnt += (c > 0u) ? 1u : 0u; mine = (j == x) ? c : mine; }
        if (sum == G) break;
        __builtin_amdgcn_s_sleep(1);
        if ((++sp & 255u) == 0u) { if (xb_ld(&bar[XB_TMO])) break; if (sp > XB_SPIN_CAP) { atomicAdd(&bar[XB_TMO], 1u); break; } }
    }
    nloc = mine > 0u ? mine : 1u; nx = cnt > 0u ? cnt : 1u;
}

__device__ __forceinline__ void xcd_barrier(const XcdBarrier& b) {
    asm volatile("s_waitcnt vmcnt(0)" ::: "memory");
    __syncthreads();
    if (threadIdx.x == 0) {
        unsigned* bar = b.bar;
        __builtin_amdgcn_s_waitcnt(0);
        unsigned nloc = b.st[0], nx = b.st[1];
        if (nloc == 0u) { xcd_barrier_complete(bar, b.x, nloc, nx); b.st[0] = nloc; b.st[1] = nx; }
        const unsigned old = xb_add(&bar[XB_XSUB(b.x)], 1u);
        const unsigned gen = old / nloc;
        if (old + 1u == (gen + 1u) * nloc) {
            __builtin_amdgcn_fence(__ATOMIC_RELEASE, "agent");
            asm volatile("s_waitcnt vmcnt(0)" ::: "memory");
            const unsigned og = xb_add(&bar[XB_TOP], 1u);
            const unsigned tg = og / nx;
            if (og + 1u == (tg + 1u) * nx) xb_add(&bar[XB_TOPGEN], 1u);
            else XB_SPIN(xb_ld(&bar[XB_TOPGEN]) == tg, bar);
            __builtin_amdgcn_fence(__ATOMIC_ACQUIRE, "agent");
            xb_add(&bar[XB_XGEN(b.x)], 1u);
            asm volatile("s_waitcnt vmcnt(0)" ::: "memory");
        } else {
            XB_SPIN(xb_ld(&bar[XB_XGEN(b.x)]) == gen, bar);
            __builtin_amdgcn_fence(__ATOMIC_ACQUIRE, "agent");
            asm volatile("s_waitcnt vmcnt(0)" ::: "memory");
        }
    }
    __syncthreads();
}

constexpr int NPHASE = 11;
__global__ void __launch_bounds__(NTHREADS, 2) fwd_megakernel(Params P) {
    extern __shared__ __attribute__((aligned(16))) unsigned char lds[];
    cg::grid_group grid = cg::this_grid();
    unsigned char* ws = P.ws;
    bf16_t* H = (bf16_t*)P.out;
    bf16_t* OF = (bf16_t*)P.out;
    bf16_t* OB = (bf16_t*)P.out + (size_t)NLAT * D;
    bf16_t* D0 = (bf16_t*)(ws + WS_X1);
    bf16_t* D1 = D0 + (size_t)MTOT * D;
    const int lo = P.ph_lo, hi = P.ph_hi;
    volatile LAS unsigned* bst = (volatile LAS unsigned*)((LAS unsigned char*)lds + LDS_BYTES - 64);
    if (threadIdx.x == 0) { bst[0] = 0u; bst[1] = 0u; }
    __syncthreads();
    if (lo > hi) grid.sync();
    const XcdBarrier xbar = xcd_barrier_post((unsigned*)ws, bst);
#define IN(k) (lo <= (k) && (k) < hi)
#define SEAM(k) do { if (IN(k) && IN((k) + 1)) xcd_barrier(xbar); STAMP(k); } while (0)
#if defined(DIAG_A)
    volatile unsigned long long* tsL = (volatile unsigned long long*)(lds + LDS_BYTES - 256);
#define STAMP(k) do { if (blockIdx.x == 0 && threadIdx.x == 0) tsL[(k) + 1] = __builtin_amdgcn_s_memrealtime(); } while (0)
    if (blockIdx.x == 0 && threadIdx.x == 0) tsL[0] = __builtin_amdgcn_s_memrealtime();
#else
#define STAMP(k) do {} while (0)
#endif
    if (IN(0)) phase_prologue(P, lds);
    SEAM(0);
    if (IN(1)) phase_modulate(P, 0, P.x, P.ctx, H, nullptr);
    SEAM(1);
    if (IN(2)) { pg8::Gemm g{H, (const bf16_t*)(ws + WS_W0T), MTOT, N0, D}; pg8::StaticOrder S; S.init(MTOT, N0, (int)gridDim.x, (int)blockIdx.x);
        pg8::EpiQKVZ E{(bf16_t*)(ws + WS_R1)}; pg8::gemm_phase<pg8::EpiQKVZ, pg8::StaticOrder, true, true>((PG8_LAS unsigned char*)lds, g, S, E); }
    SEAM(2);
    if (IN(3)) phase_na_mfma(P, lds, H);
    SEAM(3);
    if (IN(4)) { pg8::Gemm g{H, (const bf16_t*)(ws + WS_WO0T), MTOT, D, D}; pg8::StaticOrder S; S.init(MTOT, D, (int)gridDim.x, (int)blockIdx.x);
        pg8::EpiRes E{D0, (const float*)(ws + WS_MOD)}; pg8::gemm_phase<pg8::EpiRes, pg8::StaticOrder, true, true>((PG8_LAS unsigned char*)lds, g, S, E); }
    SEAM(4);
    if (IN(5)) phase_modulate(P, 1, P.x, P.ctx, H, D0);
    SEAM(5);
    if (IN(6)) {
        { pg8::Gemm g{H, (const bf16_t*)(ws + WS_W1T), NLAT, N1, D}; pg8::StaticOrder S; S.init(NLAT, N1, (int)gridDim.x, (int)blockIdx.x);
          pg8::EpiHG E{(unsigned short*)(ws + WS_R1), (const float*)(ws + WS_LB), 0, 0}; pg8::gemm_phase<pg8::EpiHG, pg8::StaticOrder, true, true>((PG8_LAS unsigned char*)lds, g, S, E); }
        { pg8::Gemm g{H + (size_t)NLAT * D, (const bf16_t*)(ws + WS_W1T) + (size_t)1024 * D, NCTX, 3072, D}; pg8::StaticOrder S; S.init(NCTX, 3072, (int)gridDim.x, (int)blockIdx.x);
          pg8::EpiHG E{(unsigned short*)(ws + WS_R1), (const float*)(ws + WS_LB), NLAT, 4}; pg8::gemm_phase<pg8::EpiHG, pg8::StaticOrder, true, true>((PG8_LAS unsigned char*)lds, g, S, E); }
    }
    SEAM(6);
#if defined(HG_XMODE)
    if (IN(7)) { phase_hgrn_mfma<HG_XMODE>(P, lds, OF, OB); xcd_barrier(xbar);
        if (blockIdx.x == 0 && threadIdx.x == 0) tsL[20] = __builtin_amdgcn_s_memrealtime(); }
#endif
    if (IN(7)) phase_hgrn_mfma<0>(P, lds, OF, OB);
    SEAM(7);
    if (IN(8)) phase_readout(P, OF, OB);
    SEAM(8);
    if (IN(9)) { pg8::Gemm g{OF, (const bf16_t*)(ws + WS_WO1T), NLAT, D, D}; pg8::StaticOrder S; S.init(NLAT, D, (int)gridDim.x, (int)blockIdx.x);
        pg8::EpiRes E{D1, (const float*)(ws + WS_MOD) + 17 * 3072}; pg8::gemm_phase<pg8::EpiRes, pg8::StaticOrder, true, true>((PG8_LAS unsigned char*)lds, g, S, E); }
    SEAM(9);
    if (IN(10)) phase_final(P, D0, D1);
#if defined(DIAG_A)
    if (blockIdx.x == 0 && threadIdx.x == 0) {
        const unsigned long long ta = (tsL[DIAG_A + 1] - tsL[DIAG_A]) / 100ull, tb = (tsL[DIAG_B + 1] - tsL[DIAG_B]) / 100ull;
#if defined(HG_XMODE)
        const unsigned long long spin = (tsL[20] - tsL[7]) * 50ull + 0ull * tb + 0ull * ta, t0 = __builtin_amdgcn_s_memrealtime();
#else
        const unsigned long long spin = (tsL[DIAG_A + 1] - tsL[DIAG_A]) * 50ull + 0ull * tb + 0ull * ta, t0 = __builtin_amdgcn_s_memrealtime();
#endif
        while (__builtin_amdgcn_s_memrealtime() - t0 < spin) __builtin_amdgcn_s_sleep(32);
    }
#endif
#undef IN
#undef SEAM
#undef STAMP
}

extern "C" void kernel_launch(void* const* d_in, const int* in_sizes, int n_in, void* d_out, int out_size, void* d_ws, size_t ws_size, hipStream_t stream) {
    static int grid = 0;
    if (grid == 0) {
        if (n_in != 15 || out_size != NLAT * D || ws_size < WS_END) { fprintf(stderr, "kernel_launch: unexpected sizes n_in %d out %d ws %zu\n", n_in, out_size, ws_size); grid = -1; return; }
        int dev = 0, cus = 0, per_cu = 0;
        (void)hipGetDevice(&dev);
        (void)hipDeviceGetAttribute(&cus, hipDeviceAttributeMultiprocessorCount, dev);
        (void)hipFuncSetAttribute((const void*)fwd_megakernel, hipFuncAttributeMaxDynamicSharedMemorySize, LDS_BYTES);
        (void)hipOccupancyMaxActiveBlocksPerMultiprocessor(&per_cu, (const void*)fwd_megakernel, NTHREADS, LDS_BYTES);
        if (per_cu < 1) per_cu = 1;
        (void)hipGetLastError();
        grid = cus * per_cu;
    }
    if (grid < 0) return;
    Params p{};
    p.x = (const float*)d_in[0]; p.c = (const float*)d_in[1]; p.ctx = (const float*)d_in[2]; p.c_ctx = (const float*)d_in[3];
    p.ada_w = (const float*)d_in[4]; p.ada_b = (const float*)d_in[5]; p.norm_w = (const float*)d_in[6]; p.na_w_in = (const float*)d_in[7];
    p.na_rpb = (const float*)d_in[8]; p.na_w_out = (const float*)d_in[9]; p.hg_w_in = (const float*)d_in[10]; p.hg_lower = (const float*)d_in[11];
    p.hg_norm_w = (const float*)d_in[12]; p.hg_w_out = (const float*)d_in[13]; p.final_norm_w = (const float*)d_in[14];
    p.out = (float*)d_out; p.ws = (unsigned char*)d_ws; p.ph_lo = 0; p.ph_hi = NPHASE;
    if (hipMemsetAsync(d_ws, 0, 65536, stream) != hipSuccess) { fprintf(stderr, "kernel_launch: memset failed\n"); return; }
    void* args[] = {&p};
    hipError_t e = hipLaunchCooperativeKernel((const void*)fwd_megakernel, dim3(grid), dim3(NTHREADS), args, LDS_BYTES, stream);
    if (e != hipSuccess) fprintf(stderr, "cooperative launch failed: %s (grid %d)\n", hipGetErrorString(e), grid);
}
```
